# Optimizing an MI355X kernel written in HIP

```python
import math
import jax, jax.numpy as jnp
from jax import lax
import numpy as np

D_MODEL = 2048
BATCH = 32
SEQ = 256
DEPTH = 4
DEC_BATCH = 4
DEC_SEQ = 2048
PAST_LEN = 512

GRID_W = 64
N_BRANCH = 4
BRANCH_W = D_MODEL // 2
GQA_HEAD_DIM = 128
GQA_Q_HEADS = BRANCH_W // GQA_HEAD_DIM
GQA_KV_HEADS = 2
GQA_GROUP = GQA_Q_HEADS // GQA_KV_HEADS
SSD_INNER = BRANCH_W
SSD_HEAD_DIM = 64
SSD_HEADS = SSD_INNER // SSD_HEAD_DIM
SSD_GROUPS = 2
SSD_STATE = 128
SSD_CONV = 5
SSD_CHUNK = 128
SSD_CONV_CH = SSD_INNER + 2 * SSD_GROUPS * SSD_STATE
MLA_HEADS = 8
MLA_NOPE = 128
MLA_ROPE = 64
MLA_V = BRANCH_W // MLA_HEADS
MLA_Q_LORA = 512
MLA_KV_LORA = 256
S5_WIDTH = BRANCH_W
S5_GROUP_CH = 16
S5_GROUPS = S5_WIDTH // S5_GROUP_CH
S5_STATE = 64
FFN_HIDDEN = -(-8 * D_MODEL // (3 * 256)) * 256
Q_BLOCK = 128
ROPE_THETA = 10000.0
NORM_EPS = 1e-6
IN_SPLITS = (N_BRANCH * D_MODEL, GQA_Q_HEADS * GQA_HEAD_DIM, GQA_KV_HEADS * GQA_HEAD_DIM,
             GQA_KV_HEADS * GQA_HEAD_DIM, SSD_INNER, SSD_CONV_CH, 2 * SSD_HEADS,
             MLA_Q_LORA, MLA_KV_LORA + MLA_ROPE, S5_WIDTH)
IN_COLS = sum(IN_SPLITS)

kernel_name = 'hybrid_gqa_ssd_mla_s5_diffusion_step'


def rms_norm(x, g):
    xf = x.astype(jnp.float32)
    y = xf * lax.rsqrt(jnp.mean(xf * xf, axis=-1, keepdims=True) + NORM_EPS)
    return (y * g.astype(jnp.float32)).astype(x.dtype)


def axial_rope_tables(seq_len, dim):
    rows = seq_len // GRID_W
    t = jnp.arange(rows * GRID_W)
    row = (t // GRID_W).astype(jnp.float32)
    col = (t % GRID_W).astype(jnp.float32)
    nf = dim // 4
    inv = ROPE_THETA ** (-jnp.arange(nf, dtype=jnp.float32) / nf)
    ang = jnp.stack([row[:, None] * inv, col[:, None] * inv], axis=1)
    return jnp.cos(ang), jnp.sin(ang)


def apply_axial_rope(x, cos, sin):
    shp = x.shape
    xr = x.astype(jnp.float32).reshape(shp[:-1] + (2, 2, shp[-1] // 4))
    x0, x1 = xr[..., 0, :], xr[..., 1, :]
    cs, sn = cos[:, None], sin[:, None]
    out = jnp.stack([x0 * cs - x1 * sn, x0 * sn + x1 * cs], axis=-2)
    return out.reshape(shp).astype(x.dtype)


def block_attention(q, k, v, scale):
    bsz, lq, g, r, dk = q.shape
    dv = v.shape[-1]
    nb = lq // Q_BLOCK
    qb = jnp.moveaxis(q.reshape(bsz, nb, Q_BLOCK, g, r, dk), 1, 0)

    def one_block(qblk):
        s = jnp.einsum('bqgrd,bkgd->bgrqk', qblk, k).astype(jnp.float32) * scale
        p = jax.nn.softmax(s, axis=-1).astype(v.dtype)
        return jnp.einsum('bgrqk,bkge->bqgre', p, v)

    o = lax.map(one_block, qb)
    return jnp.moveaxis(o, 0, 1).reshape(bsz, lq, g, r, dv)


def dwconv_centred(x, w, bias):
    ch = x.shape[-1]
    pad = w.shape[0] // 2
    out = lax.conv_general_dilated(x, w[:, None, :], window_strides=(1,), padding=((pad, pad),),
                                   dimension_numbers=('NWC', 'WIO', 'NWC'), feature_group_count=ch)
    return out + bias


def segsum(x):
    t = x.shape[-1]
    xr = jnp.broadcast_to(x[..., :, None], x.shape + (t,))
    low = jnp.tril(jnp.ones((t, t), dtype=bool), -1)
    cs = jnp.cumsum(jnp.where(low, xr, 0.0), axis=-2)
    return jnp.where(jnp.tril(jnp.ones((t, t), dtype=bool)), cs, -jnp.inf)


def ssd_scan(x, dt, a_head, bm, cm, h0):
    bsz, l, nh, hp = x.shape
    ng, ns = bm.shape[-2:]
    r = nh // ng
    nc = l // SSD_CHUNK
    xs = (x * dt[..., None]).reshape(bsz, nc, SSD_CHUNK, ng, r, hp)
    da = jnp.moveaxis((dt * a_head).reshape(bsz, nc, SSD_CHUNK, ng, r), 2, -1)
    bc = bm.reshape(bsz, nc, SSD_CHUNK, ng, ns)
    cc = cm.reshape(bsz, nc, SSD_CHUNK, ng, ns)
    a_cum = jnp.cumsum(da, axis=-1)
    cb = jnp.einsum('bclgn,bcsgn->bcgls', cc, bc)
    att = cb[:, :, :, None] * jnp.exp(segsum(da))
    y_diag = jnp.einsum('bcgrls,bcsgrp->bclgrp', att, xs)
    decay_states = jnp.exp(a_cum[..., -1:] - a_cum)
    states = jnp.einsum('bcsgn,bcgrs,bcsgrp->bcgrpn', bc, decay_states, xs)
    states = jnp.concatenate([h0.astype(jnp.float32).reshape(bsz, 1, ng, r, hp, ns), states], axis=1)
    chunk_a = jnp.pad(jnp.moveaxis(a_cum[..., -1], 1, -1), ((0, 0), (0, 0), (0, 0), (1, 0)))
    new_states = jnp.einsum('bgrzc,bcgrpn->bzgrpn', jnp.exp(segsum(chunk_a)), states)
    y_off = jnp.einsum('bclgn,bcgrpn,bcgrl->bclgrp', cc, new_states[:, :-1], jnp.exp(a_cum))
    y = (y_diag + y_off).reshape(bsz, l, nh, hp)
    return y, new_states[:, -1].reshape(bsz, nh, hp, ns)


def complex_linear_combine(e1, e2):
    a1r, a1i, b1r, b1i = e1
    a2r, a2i, b2r, b2i = e2
    return (a2r * a1r - a2i * a1i, a2r * a1i + a2i * a1r,
            a2r * b1r - a2i * b1i + b2r, a2r * b1i + a2i * b1r + b2i)


def gqa_mixer(q, k, v, lp, rope, ctx_kv):
    bsz, l, _ = q.shape
    q = rms_norm(q.reshape(bsz, l, GQA_Q_HEADS, GQA_HEAD_DIM), lp['gqa_qn_g'])
    k = rms_norm(k.reshape(bsz, l, GQA_KV_HEADS, GQA_HEAD_DIM), lp['gqa_kn_g'])
    v = v.reshape(bsz, l, GQA_KV_HEADS, GQA_HEAD_DIM)
    own = (k, v)
    if ctx_kv is not None:
        cos, sin = rope
        q = apply_axial_rope(q, cos, sin)
        k = jnp.concatenate([apply_axial_rope(k, cos, sin), ctx_kv[0]], axis=1)
        v = jnp.concatenate([v, ctx_kv[1]], axis=1)
    o = block_attention(q.reshape(bsz, l, GQA_KV_HEADS, GQA_GROUP, GQA_HEAD_DIM), k, v, GQA_HEAD_DIM ** -0.5)
    return o.reshape(bsz, l, GQA_Q_HEADS * GQA_HEAD_DIM), own


def ssd_mixer(z, xbc, dt_raw, lp, h0):
    bsz, l, _ = z.shape
    xbc = jax.nn.silu(dwconv_centred(xbc, lp['ssd_conv_w'], lp['ssd_conv_b']))
    xs, bm, cm = jnp.split(xbc, [SSD_INNER, SSD_INNER + SSD_GROUPS * SSD_STATE], axis=-1)
    xs = xs.reshape(bsz, l, SSD_HEADS, SSD_HEAD_DIM).astype(jnp.float32)
    bm = bm.reshape(bsz, l, SSD_GROUPS, SSD_STATE).astype(jnp.float32)
    cm = cm.reshape(bsz, l, SSD_GROUPS, SSD_STATE).astype(jnp.float32)
    dt = jax.nn.softplus(dt_raw.astype(jnp.float32).reshape(bsz, l, 2, SSD_HEADS)
                         + lp['ssd_dt_bias'].astype(jnp.float32))
    a = -jnp.exp(lp['ssd_a_log'].astype(jnp.float32))
    rev = lambda t: jnp.flip(t, axis=1)
    y_f, h_f = ssd_scan(xs, dt[:, :, 0], a[0], bm, cm, h0[:, 0])
    y_b, h_b = ssd_scan(rev(xs), rev(dt[:, :, 1]), a[1], rev(bm), rev(cm), h0[:, 1])
    y = y_f + rev(y_b) + lp['ssd_d'].astype(jnp.float32)[:, None] * xs
    y = y.reshape(bsz, l, SSD_INNER) * jax.nn.silu(z.astype(jnp.float32))
    return rms_norm(y, lp['ssd_norm_g']).astype(z.dtype), jnp.stack([h_f, h_b], axis=1)


def mla_mixer(qd, kvd, lp, rope, ctx):
    bsz, l, _ = qd.shape
    q = (rms_norm(qd, lp['mla_qn_g']) @ lp['mla_w_uq']).reshape(bsz, l, MLA_HEADS, MLA_NOPE + MLA_ROPE)
    q_nope, q_pe = jnp.split(q, [MLA_NOPE], axis=-1)
    ckv, kpe = jnp.split(kvd, [MLA_KV_LORA], axis=-1)
    ckv = rms_norm(ckv, lp['mla_kvn_g'])
    own = (ckv, kpe)
    if ctx is not None:
        cos, sin = rope
        q_pe = apply_axial_rope(q_pe, cos, sin)
        kpe = apply_axial_rope(kpe[:, :, None, :], cos, sin)[:, :, 0]
        ckv = jnp.concatenate([ckv, ctx[0]], axis=1)
        kpe = jnp.concatenate([kpe, ctx[1]], axis=1)
    lk = ckv.shape[1]
    kv = (ckv @ lp['mla_w_ukv']).reshape(bsz, lk, MLA_HEADS, MLA_NOPE + MLA_V)
    k_nope, v = jnp.split(kv, [MLA_NOPE], axis=-1)
    k = jnp.concatenate([k_nope, jnp.broadcast_to(kpe[:, :, None, :], (bsz, lk, MLA_HEADS, MLA_ROPE))], axis=-1)
    q = jnp.concatenate([q_nope, q_pe], axis=-1)[:, :, :, None, :]
    o = block_attention(q, k, v, (MLA_NOPE + MLA_ROPE) ** -0.5)
    return o.reshape(bsz, l, MLA_HEADS * MLA_V), own


def s5_mixer(u, lp, h0):
    bsz, l, _ = u.shape
    f32 = jnp.float32
    uf = u.astype(f32)
    ug = uf.reshape(bsz, l, S5_GROUPS, S5_GROUP_CH)
    bu_re = jnp.einsum('blgh,gph->lbgp', ug, lp['s5_b_re'].astype(f32))
    bu_im = jnp.einsum('blgh,gph->lbgp', ug, lp['s5_b_im'].astype(f32))
    lam_re = lp['s5_lam_re'].astype(f32)
    lam_im = lp['s5_lam_im'].astype(f32)
    step = jnp.exp(lp['s5_log_step'].astype(f32))[..., None]
    mag = jnp.exp(lam_re * step)
    ab_re = mag * jnp.cos(lam_im * step)
    ab_im = mag * jnp.sin(lam_im * step)
    den = lam_re * lam_re + lam_im * lam_im
    k_re = ((ab_re - 1.0) * lam_re + ab_im * lam_im) / den
    k_im = (ab_im * lam_re - (ab_re - 1.0) * lam_im) / den
    h0 = h0.astype(f32)
    sums_re, sums_im, finals = [], [], []
    for d in range(2):
        b_re = k_re[d] * bu_re - k_im[d] * bu_im
        b_im = k_re[d] * bu_im + k_im[d] * bu_re
        first = 0 if d == 0 else l - 1
        last = l - 1 if d == 0 else 0
        h0_re, h0_im = h0[:, d, 0], h0[:, d, 1]
        b_re = b_re.at[first].add(ab_re[d] * h0_re - ab_im[d] * h0_im)
        b_im = b_im.at[first].add(ab_re[d] * h0_im + ab_im[d] * h0_re)
        a_re = jnp.broadcast_to(ab_re[d], (l, 1, S5_GROUPS, S5_STATE))
        a_im = jnp.broadcast_to(ab_im[d], (l, 1, S5_GROUPS, S5_STATE))
        _, _, h_re, h_im = lax.associative_scan(complex_linear_combine, (a_re, a_im, b_re, b_im), reverse=(d == 1))
        sums_re.append(h_re)
        sums_im.append(h_im)
        finals.append(jnp.stack([h_re[last], h_im[last]], axis=1))
    h_re = sums_re[0] + sums_re[1]
    h_im = sums_im[0] + sums_im[1]
    y = (jnp.einsum('lbgp,ghp->blgh', h_re, lp['s5_c_re'].astype(f32))
         - jnp.einsum('lbgp,ghp->blgh', h_im, lp['s5_c_im'].astype(f32))).reshape(bsz, l, S5_WIDTH)
    y = jax.nn.gelu(y + lp['s5_d'].astype(f32) * uf)
    val, gate = jnp.split(y @ lp['s5_w_glu'].astype(f32), 2, axis=-1)
    return (val * jax.nn.sigmoid(gate)).astype(u.dtype), jnp.stack(finals, axis=1)


def token_mixers(h, lp, cache, rope_a, rope_c):
    bsz, l, _ = h.shape
    bounds, acc = [], 0
    for w in IN_SPLITS[:-1]:
        acc += w
        bounds.append(acc)
    (gate_pre, gq, gk, gv, sz, sxbc, sdt, mqd, mkvd, s5u) = jnp.split(h @ lp['w_in'], bounds, axis=-1)
    if cache is None:
        ctx_gqa, ctx_mla = None, None
        ssd_h0 = jnp.zeros((bsz, 2, SSD_HEADS, SSD_HEAD_DIM, SSD_STATE), jnp.float32)
        s5_h0 = jnp.zeros((bsz, 2, 2, S5_GROUPS, S5_STATE), jnp.float32)
    else:
        ctx_gqa = (cache[0], cache[1])
        ctx_mla = (cache[2], cache[3])
        ssd_h0, s5_h0 = cache[4], cache[5]
    o_a, (kk, vv) = gqa_mixer(gq, gk, gv, lp, rope_a, ctx_gqa)
    o_b, ssd_state = ssd_mixer(sz, sxbc, sdt, lp, ssd_h0)
    o_c, (ckv, kpe) = mla_mixer(mqd, mkvd, lp, rope_c, ctx_mla)
    o_d, s5_state = s5_mixer(s5u, lp, s5_h0)
    branches = jnp.stack([o_a, o_b, o_c, o_d], axis=2)
    gates = jax.nn.sigmoid(gate_pre.astype(jnp.float32)).reshape(bsz, l, N_BRANCH, D_MODEL).astype(h.dtype)
    proj = jnp.einsum('blnw,nwd->blnd', branches, lp['w_branch'])
    mixed = jnp.sum(gates * proj, axis=2) @ lp['w_out']
    return mixed, (kk, vv, ckv, kpe, ssd_state, s5_state)


def trunk_layer(x, cond_mod, lp, cache, rope_a, rope_c):
    sh1, sc1, g1, sh2, sc2, g2 = jnp.split(cond_mod, 6, axis=-1)
    h = rms_norm(x, lp['norm1_g']) * (1.0 + sc1) + sh1
    mixed, ctx = token_mixers(h, lp, cache, rope_a, rope_c)
    x = x + g1 * mixed
    h = rms_norm(x, lp['norm2_g']) * (1.0 + sc2) + sh2
    gate, up = jnp.split(h @ lp['w_ffn_in'], 2, axis=-1)
    x = x + g2 * ((jax.nn.silu(gate) * up) @ lp['w_ffn_out'])
    return x, ctx


def setup_inputs(seed: int = 0) -> dict:
    key = jax.random.key(seed)
    ks = iter(jax.random.split(key, 64))
    f32 = jnp.float32
    nrm = lambda shape, scale: scale * jax.random.normal(next(ks), shape, f32)
    gain = lambda shape: 1.0 + 0.01 * jax.random.normal(next(ks), shape, f32)
    unif = lambda shape, lo, hi: jax.random.uniform(next(ks), shape, f32, lo, hi)
    dt0 = jnp.exp(unif((DEPTH, 2, SSD_HEADS), math.log(1e-3), math.log(1e-1)))
    return {
        'x_prompt': nrm((BATCH, SEQ, D_MODEL), 1.0),
        'x_sample': nrm((DEC_BATCH, DEC_SEQ, D_MODEL), 1.0),
        'cache_gqa_k': nrm((DEC_BATCH, DEPTH, PAST_LEN, GQA_KV_HEADS, GQA_HEAD_DIM), 1.0),
        'cache_gqa_v': nrm((DEC_BATCH, DEPTH, PAST_LEN, GQA_KV_HEADS, GQA_HEAD_DIM), 1.0),
        'cache_mla_ckv': nrm((DEC_BATCH, DEPTH, PAST_LEN, MLA_KV_LORA), 1.0),
        'cache_mla_kpe': nrm((DEC_BATCH, DEPTH, PAST_LEN, MLA_ROPE), 1.0),
        'state_ssd': nrm((DEC_BATCH, DEPTH, 2, SSD_HEADS, SSD_HEAD_DIM, SSD_STATE), 0.1),
        'state_s5': nrm((DEC_BATCH, DEPTH, 2, 2, S5_GROUPS, S5_STATE), 0.1),
        'c': nrm((DEC_BATCH, D_MODEL), 1.0),
        'c_ctx': nrm((D_MODEL,), 1.0),
        'norm1_g': gain((DEPTH, D_MODEL)),
        'norm2_g': gain((DEPTH, D_MODEL)),
        'w_mod': nrm((DEPTH, D_MODEL, 6 * D_MODEL), 0.5 * D_MODEL ** -0.5),
        'b_mod': nrm((DEPTH, 6 * D_MODEL), 0.02),
        'w_in': nrm((DEPTH, D_MODEL, IN_COLS), D_MODEL ** -0.5),
        'gqa_qn_g': gain((DEPTH, GQA_HEAD_DIM)),
        'gqa_kn_g': gain((DEPTH, GQA_HEAD_DIM)),
        'ssd_conv_w': nrm((DEPTH, SSD_CONV, SSD_CONV_CH), SSD_CONV ** -0.5),
        'ssd_conv_b': nrm((DEPTH, SSD_CONV_CH), 0.02),
        'ssd_a_log': jnp.log(unif((DEPTH, 2, SSD_HEADS), 1.0, 16.0)),
        'ssd_dt_bias': dt0 + jnp.log(-jnp.expm1(-dt0)),
        'ssd_d': gain((DEPTH, SSD_HEADS)),
        'ssd_norm_g': gain((DEPTH, SSD_INNER)),
        'mla_qn_g': gain((DEPTH, MLA_Q_LORA)),
        'mla_w_uq': nrm((DEPTH, MLA_Q_LORA, MLA_HEADS * (MLA_NOPE + MLA_ROPE)), MLA_Q_LORA ** -0.5),
        'mla_kvn_g': gain((DEPTH, MLA_KV_LORA)),
        'mla_w_ukv': nrm((DEPTH, MLA_KV_LORA, MLA_HEADS * (MLA_NOPE + MLA_V)), MLA_KV_LORA ** -0.5),
        's5_lam_re': -0.5 + nrm((DEPTH, 2, S5_GROUPS, S5_STATE), 0.01),
        's5_lam_im': math.pi * jnp.arange(S5_STATE, dtype=f32) + nrm((DEPTH, 2, S5_GROUPS, S5_STATE), 0.01),
        's5_log_step': unif((DEPTH, 2, S5_GROUPS), math.log(1e-3), math.log(1e-1)),
        's5_b_re': nrm((DEPTH, S5_GROUPS, S5_STATE, S5_GROUP_CH), (2 * S5_GROUP_CH) ** -0.5),
        's5_b_im': nrm((DEPTH, S5_GROUPS, S5_STATE, S5_GROUP_CH), (2 * S5_GROUP_CH) ** -0.5),
        's5_c_re': nrm((DEPTH, S5_GROUPS, S5_GROUP_CH, S5_STATE), S5_STATE ** -0.5),
        's5_c_im': nrm((DEPTH, S5_GROUPS, S5_GROUP_CH, S5_STATE), S5_STATE ** -0.5),
        's5_d': nrm((DEPTH, S5_WIDTH), 0.5),
        's5_w_glu': nrm((DEPTH, S5_WIDTH, 2 * S5_WIDTH), S5_WIDTH ** -0.5),
        'w_branch': nrm((DEPTH, N_BRANCH, BRANCH_W, D_MODEL), BRANCH_W ** -0.5),
        'w_out': nrm((DEPTH, D_MODEL, D_MODEL), D_MODEL ** -0.5),
        'w_ffn_in': nrm((DEPTH, D_MODEL, 2 * FFN_HIDDEN), D_MODEL ** -0.5),
        'w_ffn_out': nrm((DEPTH, FFN_HIDDEN, D_MODEL), FFN_HIDDEN ** -0.5),
        'final_g': gain((D_MODEL,)),
    }


def reference(x_prompt, x_sample, cache_gqa_k, cache_gqa_v, cache_mla_ckv, cache_mla_kpe, state_ssd, state_s5,
              c, c_ctx, norm1_g, norm2_g, w_mod, b_mod, w_in, gqa_qn_g, gqa_kn_g, ssd_conv_w, ssd_conv_b,
              ssd_a_log, ssd_dt_bias, ssd_d, ssd_norm_g, mla_qn_g, mla_w_uq, mla_kvn_g, mla_w_ukv,
              s5_lam_re, s5_lam_im, s5_log_step, s5_b_re, s5_b_im, s5_c_re, s5_c_im, s5_d, s5_w_glu,
              w_branch, w_out, w_ffn_in, w_ffn_out, final_g):
    layer_w = dict(norm1_g=norm1_g, norm2_g=norm2_g, w_mod=w_mod, b_mod=b_mod, w_in=w_in,
                   gqa_qn_g=gqa_qn_g, gqa_kn_g=gqa_kn_g, ssd_conv_w=ssd_conv_w, ssd_conv_b=ssd_conv_b,
                   ssd_a_log=ssd_a_log, ssd_dt_bias=ssd_dt_bias, ssd_d=ssd_d, ssd_norm_g=ssd_norm_g,
                   mla_qn_g=mla_qn_g, mla_w_uq=mla_w_uq, mla_kvn_g=mla_kvn_g, mla_w_ukv=mla_w_ukv,
                   s5_lam_re=s5_lam_re, s5_lam_im=s5_lam_im, s5_log_step=s5_log_step, s5_b_re=s5_b_re,
                   s5_b_im=s5_b_im, s5_c_re=s5_c_re, s5_c_im=s5_c_im, s5_d=s5_d, s5_w_glu=s5_w_glu,
                   w_branch=w_branch, w_out=w_out, w_ffn_in=w_ffn_in, w_ffn_out=w_ffn_out)
    lat_len = x_sample.shape[1]
    rope_a = axial_rope_tables(lat_len, GQA_HEAD_DIM)
    rope_c = axial_rope_tables(lat_len, MLA_ROPE)
    xc, xl = x_prompt, x_sample
    outs = ([], [], [], [], [], [])
    for i in range(DEPTH):
        lp = {name: w[i] for name, w in layer_w.items()}
        mod_ctx = (jax.nn.silu(c_ctx) @ lp['w_mod'] + lp['b_mod'])[None, None, :]
        mod_lat = (jax.nn.silu(c) @ lp['w_mod'] + lp['b_mod'])[:, None, :]
        xc, ctx = trunk_layer(xc, mod_ctx, lp, None, None, None)
        for lst, t in zip(outs, ctx):
            lst.append(t)
        cache_l = (cache_gqa_k[:, i], cache_gqa_v[:, i], cache_mla_ckv[:, i], cache_mla_kpe[:, i],
                   state_ssd[:, i], state_s5[:, i])
        xl, _ = trunk_layer(xl, mod_lat, lp, cache_l, rope_a, rope_c)
    y_prompt = rms_norm(xc, final_g)
    y_sample = rms_norm(xl, final_g)
    new_gqa_k = jnp.stack(outs[0], axis=1)
    new_gqa_v = jnp.stack(outs[1], axis=1)
    new_mla_ckv = jnp.stack(outs[2], axis=1)
    new_mla_kpe = jnp.stack(outs[3], axis=1)
    new_ssd = jnp.stack(outs[4], axis=1)
    new_s5 = jnp.stack(outs[5], axis=1)
    return (y_prompt, y_sample, new_gqa_k, new_gqa_v, new_mla_ckv, new_mla_kpe, new_ssd, new_s5)
```

```cpp
#include <hip/hip_runtime.h>
#include <cstdio>
#include <cstdint>
#include <cmath>
#define MK_N_LAUNCHES 1
#define REP_MASK 0u
namespace pg8 {
#define PG8_LAS __attribute__((address_space(3)))
typedef unsigned short bf16_t;
typedef short bf16x8 __attribute__((ext_vector_type(8)));
typedef float f32x4 __attribute__((ext_vector_type(4)));
typedef unsigned u32x4 __attribute__((ext_vector_type(4)));
constexpr int BM = 256, BK = 64, HALF = 128, HTB = HALF * BK * 2  , STAGE_BYTES = 8 * HTB, NXCD = 8, WGM = 8;

__host__ __device__ __forceinline__ int lds_byte(int r, int c) { const int st = (r >> 4) * 2 + (c >> 5), rr = r & 15, cc = c & 31, ob = rr * 64 + cc * 2; return st * 1024 + (ob ^ (((ob >> 9) & 1) << 5)); }
__host__ __device__ __forceinline__ void stage_rc(int b, int& R, int& C) { const int st = b / 1024, sb = b % 1024, swz = sb ^ (((sb >> 9) & 1) << 5); R = (st >> 1) * 16 + swz / 64; C = (st & 1) * 32 + (swz % 64) / 2; }
__host__ __device__ __forceinline__ int perm32(int rho) { const int n = rho >> 4, i = rho & 15; return 8 * (i >> 2) + 4 * n + (i & 3); }

struct Unit { int pm, pn; };
struct Gemm { const bf16_t* A; const bf16_t* Bt; int M, N, K; };

struct StaticOrder {
    int nM, nN, nwg, G, c;
    __host__ __device__ void init(int M, int N, int G_, int c_) { nM = M / BM; nN = N / BM; nwg = nM * nN; G = G_; c = c_; }
    __host__ __device__ bool next(int i, Unit& u) const {
        const long L = (long)i * G + c; if (L >= nwg) return false;
        int wgid = (int)L; { const int q = nwg / NXCD, r = nwg % NXCD, xcd = wgid % NXCD, off = wgid / NXCD; wgid = (xcd < r ? xcd * (q + 1) : r * (q + 1) + (xcd - r) * q) + off; }
        const int nig = WGM * nN, gid = wgid / nig, fm = gid * WGM, gsz = (nM - fm) < WGM ? (nM - fm) : WGM;
        u.pm = fm + ((wgid % nig) % gsz); u.pn = (wgid % nig) / gsz; return true;
    }
    __device__ __forceinline__ void a_ready(const Unit&) const {}
    __device__ __forceinline__ void done(const Unit&) const {}
};
__device__ __forceinline__ unsigned cvt_pk_bf16(float lo, float hi) { typedef float f32x2_t_ __attribute__((ext_vector_type(2))); typedef __bf16 bf16x2_t_ __attribute__((ext_vector_type(2))); const f32x2_t_ v_ = {lo, hi}; const bf16x2_t_ b_ = __builtin_convertvector(v_, bf16x2_t_); return __builtin_bit_cast(unsigned, b_); }
__device__ __forceinline__ float bf_lo(unsigned w) { return __uint_as_float(w << 16); }
__device__ __forceinline__ float bf_hi(unsigned w) { return __uint_as_float(w & 0xffff0000u); }
__device__ __forceinline__ float sigmoid_f(float x) { return __builtin_amdgcn_rcpf(1.0f + __expf(-x)); }
__device__ __forceinline__ u32x4 pack8(const f32x4 a, const f32x4 b) { u32x4 w; w.x = cvt_pk_bf16(a[0], a[1]); w.y = cvt_pk_bf16(a[2], a[3]); w.z = cvt_pk_bf16(b[0], b[1]); w.w = cvt_pk_bf16(b[2], b[3]); return w; }

struct EpiInProj {
    static constexpr bool PERM = true, AFTER_DRAIN = false;
    __device__ __forceinline__ bool keep(const Unit&) const { return false; }
    bf16_t* O; int ldc; int nsig;
    __device__ __forceinline__ void operator()(const f32x4 (&acc)[2][2][4][2], const Unit& u, int wr, int wc, int fr, int fq) const {
        const int row0 = u.pm * BM + wr * 64 + fr, col0 = u.pn * BM + wc * 32 + 8 * fq; const bool sg = u.pn < nsig;
#pragma unroll
        for (int ai = 0; ai < 2; ++ai)
#pragma unroll
            for (int m = 0; m < 4; ++m) { bf16_t* rowp = O + (size_t)(row0 + ai * HALF + m * 16) * ldc + col0;
#pragma unroll
                for (int bj = 0; bj < 2; ++bj) { f32x4 v0 = acc[ai][bj][m][0], v1 = acc[ai][bj][m][1];
                    if (sg) {
#pragma unroll
                        for (int j = 0; j < 4; ++j) { v0[j] = sigmoid_f(v0[j]); v1[j] = sigmoid_f(v1[j]); } }
                    *(u32x4*)(rowp + bj * HALF) = pack8(v0, v1); } }
    }
};
struct EpiMlaQ {
    static constexpr bool PERM = false, AFTER_DRAIN = false;
    __device__ __forceinline__ bool keep(const Unit&) const { return false; }
    bf16_t* O; const float2* tab;
    __device__ __forceinline__ void operator()(const f32x4 (&acc)[2][2][4][2], const Unit& u, int wr, int wc, int fr, int fq) const {
        const int row0 = u.pm * BM + wr * 64 + fr; const bool lat = u.pm >= 32;
#pragma unroll
        for (int bj = 0; bj < 2; ++bj) {
            const int cg = u.pn * BM + bj * HALF + wc * 32;
            const int w = cg % 192; const bool rp = lat && (w >= 128); const int axis = (w - 128) >> 5;
#pragma unroll
            for (int ai = 0; ai < 2; ++ai)
#pragma unroll
                for (int m = 0; m < 4; ++m) { const int row = row0 + ai * HALF + m * 16; f32x4 x0 = acc[ai][bj][m][0], x1 = acc[ai][bj][m][1];
                    if (rp) { const int t = (row - 8192) & 2047; const int pos = axis ? (t & 63) : (t >> 6); const float2* tp = tab + pos * 16 + 4 * fq;
#pragma unroll
                        for (int j = 0; j < 4; ++j) { const float2 cs = tp[j]; const float a = x0[j], b = x1[j]; x0[j] = a * cs.x - b * cs.y; x1[j] = a * cs.y + b * cs.x; } }
                    bf16_t* p = O + (size_t)row * 1536 + cg + 4 * fq;
                    uint2 w0; w0.x = cvt_pk_bf16(x0[0], x0[1]); w0.y = cvt_pk_bf16(x0[2], x0[3]); uint2 w1; w1.x = cvt_pk_bf16(x1[0], x1[1]); w1.y = cvt_pk_bf16(x1[2], x1[3]);
                    *(uint2*)p = w0; *(uint2*)(p + 16) = w1; } }
    }
};
struct EpiMlaKV {
    static constexpr bool PERM = true, AFTER_DRAIN = false;
    __device__ __forceinline__ bool keep(const Unit&) const { return false; }
    bf16_t* Km; bf16_t* Vm;
    __device__ __forceinline__ void operator()(const f32x4 (&acc)[2][2][4][2], const Unit& u, int wr, int wc, int fr, int fq) const {
        const int row0 = u.pm * BM + wr * 64 + fr, c0 = wc * 32 + 8 * fq;
#pragma unroll
        for (int ai = 0; ai < 2; ++ai)
#pragma unroll
            for (int m = 0; m < 4; ++m) { const size_t row = (size_t)(row0 + ai * HALF + m * 16);
                *(u32x4*)(Km + row * 1536 + u.pn * 192 + c0) = pack8(acc[ai][0][m][0], acc[ai][0][m][1]);
                *(u32x4*)(Vm + row * 1024 + u.pn * 128 + c0) = pack8(acc[ai][1][m][0], acc[ai][1][m][1]); }
    }
};
template <int MODE> struct EpiGated {
    static constexpr bool PERM = true, AFTER_DRAIN = false;
    __device__ __forceinline__ bool keep(const Unit&) const { return false; }
    bf16_t* O; int ldc;
    __device__ __forceinline__ void operator()(const f32x4 (&acc)[2][2][4][2], const Unit& u, int wr, int wc, int fr, int fq) const {
        const int row0 = u.pm * BM + wr * 64 + fr, col0 = u.pn * HALF + wc * 32 + 8 * fq;
#pragma unroll
        for (int ai = 0; ai < 2; ++ai)
#pragma unroll
            for (int m = 0; m < 4; ++m) { f32x4 o[2];
#pragma unroll
                for (int n = 0; n < 2; ++n)
#pragma unroll
                    for (int j = 0; j < 4; ++j) { const float a = acc[ai][0][m][n][j], b = acc[ai][1][m][n][j]; o[n][j] = MODE == 0 ? a * sigmoid_f(b) : a * sigmoid_f(a) * b; }
                *(u32x4*)(O + (size_t)(row0 + ai * HALF + m * 16) * ldc + col0) = pack8(o[0], o[1]); }
    }
};
struct EpiBranch {
    static constexpr bool PERM = true, AFTER_DRAIN = false;
    const bf16_t* G; int ldg; bf16_t* GS;
    __device__ __forceinline__ bool keep(const Unit& u) const { return (u.pm >> 6) < 3; }
    __device__ __forceinline__ void operator()(f32x4 (&acc)[2][2][4][2], const Unit& u, int wr, int wc, int fr, int fq) const {
        const int br = u.pm >> 6, pm = u.pm & 63, pn = u.pn & 7;
        const int row0 = pm * BM + wr * 64 + fr, col0 = pn * BM + wc * 32 + 8 * fq;
#pragma unroll
        for (int ai = 0; ai < 2; ++ai) {
            u32x4 gc[4][2], gn[4][2];
#pragma unroll
            for (int m = 0; m < 4; ++m)
#pragma unroll
                for (int bj = 0; bj < 2; ++bj) { const bf16_t* gp = G + (size_t)(row0 + ai * HALF + m * 16) * ldg + br * 2048 + col0 + bj * HALF; gc[m][bj] = *(const u32x4*)gp; if (br < 3) gn[m][bj] = *(const u32x4*)(gp + 2048); }
#pragma unroll
            for (int m = 0; m < 4; ++m)
#pragma unroll
                for (int bj = 0; bj < 2; ++bj) { float c[8], n[8]; const u32x4 a = gc[m][bj];
                    c[0] = bf_lo(a.x); c[1] = bf_hi(a.x); c[2] = bf_lo(a.y); c[3] = bf_hi(a.y); c[4] = bf_lo(a.z); c[5] = bf_hi(a.z); c[6] = bf_lo(a.w); c[7] = bf_hi(a.w);
                    if (br < 3) { const u32x4 b = gn[m][bj]; n[0] = bf_lo(b.x); n[1] = bf_hi(b.x); n[2] = bf_lo(b.y); n[3] = bf_hi(b.y); n[4] = bf_lo(b.z); n[5] = bf_hi(b.z); n[6] = bf_lo(b.w); n[7] = bf_hi(b.w); }
#pragma unroll
                    for (int j = 0; j < 8; ++j) { float f = fmaxf(c[j], 1e-6f); if (br < 3) f *= __builtin_amdgcn_rcpf(fmaxf(n[j], 1e-6f)); acc[ai][bj][m][j >> 2][j & 3] *= f; }
                    if (br == 3) *(u32x4*)(GS + (size_t)(row0 + ai * HALF + m * 16) * 2048 + col0 + bj * HALF) = pack8(acc[ai][bj][m][0], acc[ai][bj][m][1]); }
        }
    }
};
struct EpiResid {
    static constexpr bool PERM = false, AFTER_DRAIN = false;
    __device__ __forceinline__ bool keep(const Unit&) const { return false; }
    float* X; const float* mod; int goff; float scale;
    __device__ __forceinline__ void operator()(const f32x4 (&acc)[2][2][4][2], const Unit& u, int wr, int wc, int fr, int fq) const {
        const int row0 = u.pm * BM + wr * 64 + fr, col0 = u.pn * BM + wc * 32 + 4 * fq;
        const int mrow = u.pm < 32 ? 0 : 1 + ((u.pm - 32) >> 3); const float* gp = mod + mrow * 12288 + goff + col0;
        f32x4 gv[2][2];
#pragma unroll
        for (int bj = 0; bj < 2; ++bj)
#pragma unroll
            for (int n = 0; n < 2; ++n) gv[bj][n] = *(const f32x4*)(gp + bj * HALF + n * 16) * scale;
#pragma unroll
        for (int ai = 0; ai < 2; ++ai) { f32x4 xv[4][2][2];
#pragma unroll
            for (int m = 0; m < 4; ++m)
#pragma unroll
                for (int bj = 0; bj < 2; ++bj)
#pragma unroll
                    for (int n = 0; n < 2; ++n) xv[m][bj][n] = *(const f32x4*)(X + (size_t)(row0 + ai * HALF + m * 16) * 2048 + col0 + bj * HALF + n * 16);
#pragma unroll
            for (int m = 0; m < 4; ++m)
#pragma unroll
                for (int bj = 0; bj < 2; ++bj)
#pragma unroll
                    for (int n = 0; n < 2; ++n) *(f32x4*)(X + (size_t)(row0 + ai * HALF + m * 16) * 2048 + col0 + bj * HALF + n * 16) = xv[m][bj][n] + gv[bj][n] * acc[ai][bj][m][n];
            asm volatile("" ::: "memory"); }
    }
};
struct BranchOrder {
    StaticOrder so;
    __device__ bool next(int i, Unit& u) const { Unit t; if (!so.next(i >> 2, t)) return false; const int br = i & 3; u.pm = br * 64 + t.pm; u.pn = br * 8 + t.pn; return true; }
    __device__ __forceinline__ void a_ready(const Unit&) const {}
    __device__ __forceinline__ void done(const Unit&) const {}
};
template <class Epi, class Sched, bool ALIGN_EPI = false, bool SP2 = false>
__device__ __forceinline__ void gemm_phase(PG8_LAS unsigned char* lds, const Gemm g, const Sched& S, const Epi& E) {
    int tid_ = threadIdx.x; asm volatile("" : "+v"(tid_));
    const int tid = tid_, wid = __builtin_amdgcn_readfirstlane(tid >> 6), lane = tid & 63, wr = wid >> 2, wc = wid & 3, fr = lane & 15, fq = lane >> 4;
    const int K = g.K, nt = K / BK;
    unsigned voffA[2], voffB[2];
#pragma unroll
    for (int i = 0; i < 2; ++i) { int R, C; stage_rc(tid * 16 + i * 8192, R, C); const int Rb = Epi::PERM ? ((R & ~31) + perm32(R & 31)) : R;
        voffA[i] = (unsigned)(R * K + C) * 2u; voffB[i] = (unsigned)(Rb * K + C) * 2u; }
    const size_t kstep = (size_t)(BK * 2);
    const size_t hstep = (size_t)HALF * K * 2;
    const size_t tstep = 2 * hstep;
    const unsigned ldsw = (unsigned)wid * 1024u;
    const int aoff = lds_byte(wr * 64 + fr, fq * 8), boff = lds_byte(wc * 32 + fr, fq * 8);
#define PG8_SA(b, h) (((b) * 2 + (h)) * HTB)
#define PG8_SB(b, h) ((4 + (b) * 2 + (h)) * HTB)
#define PG8_STAGE(bufoff, gbase, voff) do { _Pragma("unroll") for (int _i = 0; _i < 2; ++_i) \
        __builtin_amdgcn_global_load_lds((const unsigned*)((const char*)(gbase) + (voff)[_i]), (PG8_LAS unsigned*)(lds + (bufoff) + ldsw + _i * 8192), 16, 0, 0); } while (0)
#define PG8_LDA(dst, b, h) do { _Pragma("unroll") for (int m = 0; m < 4; ++m) _Pragma("unroll") for (int k = 0; k < 2; ++k) dst[m][k] = *(const PG8_LAS bf16x8*)(lds + PG8_SA(b, h) + aoff + m * 2048 + k * 1024); } while (0)
#define PG8_LDB(dst, b, h) do { _Pragma("unroll") for (int n = 0; n < 2; ++n) _Pragma("unroll") for (int k = 0; k < 2; ++k) dst[n][k] = *(const PG8_LAS bf16x8*)(lds + PG8_SB(b, h) + boff + n * 2048 + k * 1024); } while (0)
#define PG8_MMA(ai, bj, At, Bt) do { __builtin_amdgcn_s_setprio(1); _Pragma("unroll") for (int m = 0; m < 4; ++m) _Pragma("unroll") for (int n = 0; n < 2; ++n) _Pragma("unroll") for (int k = 0; k < 2; ++k) \
        acc[ai][bj][m][n] = __builtin_amdgcn_mfma_f32_16x16x32_bf16(Bt[n][k], At[m][k], acc[ai][bj][m][n], 0, 0, 0); __builtin_amdgcn_s_setprio(0); } while (0)
#define PG8_WAIT_V(n) asm volatile("s_waitcnt vmcnt(" #n ")" ::: "memory")
#define PG8_WAIT_L(n) asm volatile("s_waitcnt lgkmcnt(" #n ")" ::: "memory")
#define PG8_BAR __builtin_amdgcn_s_barrier()
#define PG8_SCHED __builtin_amdgcn_sched_barrier(0)
    Unit cur, nxt; int ui = 0;
    if (!S.next(0, cur)) return;
    f32x4 acc[2][2][4][2];
#pragma unroll
    for (int a = 0; a < 2; ++a)
#pragma unroll
        for (int b = 0; b < 2; ++b)
#pragma unroll
            for (int m = 0; m < 4; ++m)
#pragma unroll
                for (int n = 0; n < 2; ++n) acc[a][b][m][n] = (f32x4){0.f, 0.f, 0.f, 0.f};
    bf16x8 At[4][2], B0[2][2], B1[2][2];
    const char* cA = (const char*)g.A + (size_t)cur.pm * tstep; const char* cB = (const char*)g.Bt + (size_t)cur.pn * tstep;
    S.a_ready(cur);
    if constexpr (SP2) {
        PG8_STAGE(PG8_SB(0, 0), cB, voffB); PG8_STAGE(PG8_SB(0, 1), cB + hstep, voffB); PG8_STAGE(PG8_SA(0, 0), cA, voffA); PG8_STAGE(PG8_SA(0, 1), cA + hstep, voffA);
        if (wr == 1) PG8_BAR;
        PG8_WAIT_V(2); PG8_BAR;
        PG8_STAGE(PG8_SB(1, 0), cB + kstep, voffB); PG8_STAGE(PG8_SA(1, 0), cA + kstep, voffA); PG8_STAGE(PG8_SB(1, 1), cB + hstep + kstep, voffB);
        PG8_WAIT_V(6); PG8_BAR;
    } else {
        PG8_STAGE(PG8_SB(0, 0), cB, voffB); PG8_STAGE(PG8_SA(0, 0), cA, voffA); PG8_STAGE(PG8_SB(0, 1), cB + hstep, voffB); PG8_STAGE(PG8_SA(0, 1), cA + hstep, voffA);
        if (wr == 1) PG8_BAR;
        PG8_WAIT_V(4); PG8_BAR;
        PG8_STAGE(PG8_SB(1, 0), cB + kstep, voffB); PG8_STAGE(PG8_SA(1, 0), cA + kstep, voffA); PG8_STAGE(PG8_SB(1, 1), cB + hstep + kstep, voffB);
        PG8_WAIT_V(6); PG8_BAR;
    }
    for (;;) {
        const bool has_next = S.next(ui + 1, nxt);
        const char* nA = has_next ? (const char*)g.A + (size_t)nxt.pm * tstep : cA; const char* nB = has_next ? (const char*)g.Bt + (size_t)nxt.pn * tstep : cB;
#pragma clang loop unroll(disable)
        for (int t = 0; t < nt; t += 2) {
            const bool last = (t == nt - 2);
            const char* a1 = cA + (size_t)(t + 1) * kstep;
            const char* a2 = last ? nA : cA + (size_t)(t + 2) * kstep; const char* b2 = last ? nB : cB + (size_t)(t + 2) * kstep;
            const char* a3 = a2 + kstep; const char* b3 = b2 + kstep;
            if (last && has_next) S.a_ready(nxt);
            if constexpr (SP2) {
            PG8_LDB(B0, 0, 0); PG8_LDB(B1, 0, 1); PG8_SCHED; PG8_LDA(At, 0, 0); PG8_STAGE(PG8_SA(1, 1), a1 + hstep, voffA);
            PG8_WAIT_V(8); PG8_WAIT_L(0); PG8_BAR; PG8_MMA(0, 0, At, B0); PG8_MMA(0, 1, At, B1); PG8_BAR; PG8_SCHED;
            PG8_LDA(At, 0, 1); PG8_STAGE(PG8_SB(0, 0), b2, voffB); PG8_STAGE(PG8_SB(0, 1), b2 + hstep, voffB); PG8_STAGE(PG8_SA(0, 0), a2, voffA);
            PG8_WAIT_V(8); PG8_WAIT_L(0); PG8_BAR; PG8_MMA(1, 0, At, B0); PG8_MMA(1, 1, At, B1); PG8_BAR; PG8_SCHED;
            PG8_LDB(B0, 1, 0); PG8_LDB(B1, 1, 1); PG8_SCHED; PG8_LDA(At, 1, 0); PG8_STAGE(PG8_SA(0, 1), a2 + hstep, voffA);
            PG8_WAIT_V(8); PG8_WAIT_L(0); PG8_BAR; PG8_MMA(0, 0, At, B0); PG8_MMA(0, 1, At, B1); PG8_BAR; PG8_SCHED;
            PG8_LDA(At, 1, 1); PG8_STAGE(PG8_SB(1, 0), b3, voffB); PG8_STAGE(PG8_SB(1, 1), b3 + hstep, voffB); PG8_STAGE(PG8_SA(1, 0), a3, voffA);
            PG8_WAIT_V(8); PG8_WAIT_L(0); PG8_BAR; PG8_MMA(1, 0, At, B0); PG8_MMA(1, 1, At, B1); PG8_BAR; PG8_SCHED;
            } else {
            PG8_LDB(B0, 0, 0); PG8_SCHED; PG8_LDA(At, 0, 0); PG8_STAGE(PG8_SA(1, 1), a1 + hstep, voffA);
            PG8_WAIT_L(8); PG8_BAR; PG8_WAIT_L(0); PG8_MMA(0, 0, At, B0); PG8_BAR; PG8_SCHED;
            PG8_LDB(B1, 0, 1); PG8_STAGE(PG8_SB(0, 0), b2, voffB);
            PG8_BAR; PG8_WAIT_L(0); PG8_MMA(0, 1, At, B1); PG8_BAR;
            PG8_LDA(At, 0, 1); PG8_STAGE(PG8_SA(0, 0), a2, voffA);
            PG8_BAR; PG8_WAIT_L(0); PG8_MMA(1, 0, At, B0); PG8_BAR; PG8_SCHED;
            PG8_STAGE(PG8_SB(0, 1), b2 + hstep, voffB);
            PG8_WAIT_V(6); PG8_BAR; PG8_MMA(1, 1, At, B1); PG8_BAR;
            PG8_LDB(B0, 1, 0); PG8_SCHED; PG8_LDA(At, 1, 0); PG8_STAGE(PG8_SA(0, 1), a2 + hstep, voffA);
            PG8_WAIT_L(8); PG8_BAR; PG8_WAIT_L(0); PG8_MMA(0, 0, At, B0); PG8_BAR; PG8_SCHED;
            PG8_LDB(B1, 1, 1); PG8_STAGE(PG8_SB(1, 0), b3, voffB);
            PG8_BAR; PG8_WAIT_L(0); PG8_MMA(0, 1, At, B1); PG8_BAR;
            PG8_LDA(At, 1, 1); PG8_STAGE(PG8_SA(1, 0), a3, voffA);
            PG8_BAR; PG8_WAIT_L(0); PG8_MMA(1, 0, At, B0); PG8_BAR; PG8_SCHED;
            PG8_STAGE(PG8_SB(1, 1), b3 + hstep, voffB);
            PG8_WAIT_V(6); PG8_BAR; PG8_MMA(1, 1, At, B1); PG8_BAR;
            }
        }
        if constexpr (ALIGN_EPI) { if (wr == 0) PG8_BAR; }
        if constexpr (!Epi::AFTER_DRAIN) { E(acc, cur, wr, wc, fr, fq); S.done(cur); }
        if (!has_next) break;
        if (!E.keep(cur)) {
#pragma unroll
        for (int a = 0; a < 2; ++a)
#pragma unroll
            for (int b = 0; b < 2; ++b)
#pragma unroll
                for (int m = 0; m < 4; ++m)
#pragma unroll
                    for (int n = 0; n < 2; ++n) acc[a][b][m][n] = (f32x4){0.f, 0.f, 0.f, 0.f};
        }
        cur = nxt; cA = nA; cB = nB; ++ui;
        if constexpr (ALIGN_EPI) { if (wr == 1) PG8_BAR; }
    }
    PG8_WAIT_V(0);
    if constexpr (!ALIGN_EPI) { if (wr == 0) PG8_BAR; }
    PG8_BAR;
    if constexpr (Epi::AFTER_DRAIN) { E.fused(acc, cur, wr, wc, fr, fq, lds, wid, lane); S.done(cur); }
#undef PG8_SA
#undef PG8_SB
#undef PG8_STAGE
#undef PG8_LDA
#undef PG8_LDB
#undef PG8_MMA
#undef PG8_WAIT_V
#undef PG8_WAIT_L
#undef PG8_BAR
#undef PG8_SCHED
}
}
namespace att {
using bf16x8 = __attribute__((ext_vector_type(8))) short;
using s16x4  = __attribute__((ext_vector_type(4))) short;
using f32x16 = __attribute__((ext_vector_type(16))) float;
using u32x4  = __attribute__((ext_vector_type(4))) unsigned;
constexpr int NW = 8, QBLK = 32, KVBLK = 64, DV = 128;
constexpr float THR = 8.f;
#ifndef QKT_GRP
#define QKT_GRP 4
#endif
#define ATT_SBAR() __builtin_amdgcn_sched_barrier(0)
template <int DK> struct Cfg {
  static constexpr float SCALE = DK == 128 ? 0.088388347648318440f : 0.072168783648703220f;
  static constexpr int KROW = DK * 2;
  static constexpr int SHM_V = KVBLK * DV * 2, SHM_K = KVBLK * DK * 2;
  static constexpr int SHM = 2 * SHM_V + 2 * SHM_K + NW * 64 * 4;
  static constexpr int NKC = DK / 64;
};
__device__ __forceinline__ int crow(int r, int hi) { return (r & 3) + 8 * (r >> 2) + 4 * hi; }
__device__ __forceinline__ unsigned cvtpk(float lo, float hi) { typedef float f32x2_t_ __attribute__((ext_vector_type(2))); typedef __bf16 bf16x2_t_ __attribute__((ext_vector_type(2))); const f32x2_t_ v_ = {lo, hi}; const bf16x2_t_ b_ = __builtin_convertvector(v_, bf16x2_t_); return __builtin_bit_cast(unsigned, b_); }
template <int DK> __device__ __forceinline__ int kswz(int row, int colB) { return row * (DK * 2) + (colB ^ ((row & 7) << 4)); }

template <int DK> __device__ __forceinline__ void partialSM(f32x16& p0, f32x16& p1, float& m_reg, float& mn, float& alpha) {
  constexpr float SCALE = Cfg<DK>::SCALE; constexpr float C = SCALE * 1.4426950408889634f;
  float pmax = p0[0]; for (int r = 1; r < 16; ++r) pmax = fmaxf(pmax, p0[r]); for (int r = 0; r < 16; ++r) pmax = fmaxf(pmax, p1[r]);
  { auto rr = __builtin_amdgcn_permlane32_swap(__float_as_uint(pmax), __float_as_uint(pmax), false, false);
    pmax = fmaxf(__uint_as_float(rr[0]), __uint_as_float(rr[1])); }
  if (__builtin_expect(__all(pmax - m_reg <= THR / SCALE), 1)) { mn = m_reg; alpha = 1.f; }
  else { mn = fmaxf(m_reg, pmax); alpha = __builtin_amdgcn_exp2f((m_reg - mn) * C); m_reg = mn; }
  float mnC = -mn * C;
  for (int r = 0; r < 16; ++r) p0[r] = fmaf(p0[r], C, mnC); for (int r = 0; r < 16; ++r) p1[r] = fmaf(p1[r], C, mnC);
  for (int r = 0; r < 16; ++r) p0[r] = __builtin_amdgcn_exp2f(p0[r]);
}
__device__ __forceinline__ void finishSM(f32x16& p0, f32x16& p1, float alpha, float& l_reg, bf16x8& pa0, bf16x8& pa1, bf16x8& pa2, bf16x8& pa3) {
  for (int r = 0; r < 16; ++r) p1[r] = __builtin_amdgcn_exp2f(p1[r]);
  float ps = 0; for (int r = 0; r < 16; ++r) ps += p0[r]; for (int r = 0; r < 16; ++r) ps += p1[r];
  { auto rr = __builtin_amdgcn_permlane32_swap(__float_as_uint(ps), __float_as_uint(ps), false, false);
    ps = __uint_as_float(rr[0]) + __uint_as_float(rr[1]); }
  l_reg = l_reg * alpha + ps;
#define ATT_PK4(P, BASE, OUT) do { unsigned a0 = cvtpk(P[BASE + 0], P[BASE + 1]), a1 = cvtpk(P[BASE + 2], P[BASE + 3]);   \
    unsigned b0 = cvtpk(P[BASE + 4], P[BASE + 5]), b1 = cvtpk(P[BASE + 6], P[BASE + 7]);                              \
    auto r0 = __builtin_amdgcn_permlane32_swap(a0, b0, false, false); auto r1 = __builtin_amdgcn_permlane32_swap(a1, b1, false, false); \
    u32x4 w = {r0[0], r1[0], r0[1], r1[1]}; OUT = *reinterpret_cast<bf16x8*>(&w); } while (0)
  ATT_PK4(p0, 0, pa0); ATT_PK4(p0, 8, pa1); ATT_PK4(p1, 0, pa2); ATT_PK4(p1, 8, pa3);
#undef ATT_PK4
}
template <int DK> __device__ __forceinline__ void qkt(f32x16& p0, f32x16& p1, const char* Ks, const bf16x8* qr, int r32, int hi) {
  p0 = f32x16{}; p1 = f32x16{};
#pragma unroll
  for (int d0 = 0; d0 < DK / 16; ++d0) { int cb = (d0 * 16 + hi * 8) * 2;
    bf16x8 b0 = *reinterpret_cast<const bf16x8*>(Ks + kswz<DK>(r32, cb));
    bf16x8 b1 = *reinterpret_cast<const bf16x8*>(Ks + kswz<DK>(32 + r32, cb));
    const bf16x8 q = qr[d0];
    p0 = __builtin_amdgcn_mfma_f32_32x32x16_bf16(b0, q, p0, 0, 0, 0);
    p1 = __builtin_amdgcn_mfma_f32_32x32x16_bf16(b1, q, p1, 0, 0, 0);
  }
}
__device__ __forceinline__ int v_st(int k, int c) { const int kk = (k & ~0xC) | ((k & 4) << 1) | ((k & 8) >> 1); return ((kk >> 3) * 4 + (c >> 5)) * 512 + ((kk & 7) * 32 + (c & 31)) * 2; }
__device__ __forceinline__ int v_rd_base(int lane) { return ((lane & 3) << 3) | (((lane >> 2) & 3) << 6) | (((lane >> 4) & 1) << 5) | (((lane >> 5) & 1) << 8); }
constexpr int v_rd_off(int d0, int ks, int half) { return d0 * 512 + ks * 4096 + half * 2048; }
template <int OFF> __device__ __forceinline__ s16x4 tr_read(int vb) {
  s16x4 r; asm volatile("ds_read_b64_tr_b16 %0, %1 offset:%2" : "=&v"(r) : "v"(vb), "i"(OFF) : "memory"); return r;
}
template <int D0> __device__ __forceinline__ void pv_one(f32x16& od, int vb, bf16x8 pa0, bf16x8 pa1, bf16x8 pa2, bf16x8 pa3) {
  const s16x4 l0 = tr_read<v_rd_off(D0, 0, 0)>(vb), h0 = tr_read<v_rd_off(D0, 0, 1)>(vb), l1 = tr_read<v_rd_off(D0, 1, 0)>(vb), h1 = tr_read<v_rd_off(D0, 1, 1)>(vb);
  const s16x4 l2 = tr_read<v_rd_off(D0, 2, 0)>(vb), h2 = tr_read<v_rd_off(D0, 2, 1)>(vb), l3 = tr_read<v_rd_off(D0, 3, 0)>(vb), h3 = tr_read<v_rd_off(D0, 3, 1)>(vb);
  asm volatile("s_waitcnt lgkmcnt(0)" ::: "memory"); ATT_SBAR();
#define ATT_PK(L, H) (bf16x8){L[0], L[1], L[2], L[3], H[0], H[1], H[2], H[3]}
  od = __builtin_amdgcn_mfma_f32_32x32x16_bf16(pa0, ATT_PK(l0, h0), od, 0, 0, 0);
  od = __builtin_amdgcn_mfma_f32_32x32x16_bf16(pa1, ATT_PK(l1, h1), od, 0, 0, 0);
  od = __builtin_amdgcn_mfma_f32_32x32x16_bf16(pa2, ATT_PK(l2, h2), od, 0, 0, 0);
  od = __builtin_amdgcn_mfma_f32_32x32x16_bf16(pa3, ATT_PK(l3, h3), od, 0, 0, 0);
#undef ATT_PK
}
__device__ __forceinline__ void pv_d0(f32x16* o, int vb, bf16x8 pa0, bf16x8 pa1, bf16x8 pa2, bf16x8 pa3) {
  pv_one<0>(o[0], vb, pa0, pa1, pa2, pa3); pv_one<1>(o[1], vb, pa0, pa1, pa2, pa3); pv_one<2>(o[2], vb, pa0, pa1, pa2, pa3); pv_one<3>(o[3], vb, pa0, pa1, pa2, pa3);
}
template <int DK, int SDEPTH, int ldq, int ldk, int ldv, int ldo>
__device__ __forceinline__ void attn_body(const unsigned short* __restrict__ Qb, const unsigned short* __restrict__ Kh, const unsigned short* __restrict__ Vh,
                                          unsigned short* __restrict__ Ob, int seq, char* lds) {
  using C_ = Cfg<DK>; constexpr int SHM_V = C_::SHM_V, SHM_K = C_::SHM_K, NKC = C_::NKC, CPR = DK / 8;
  int tid_ = threadIdx.x; asm volatile("" : "+v"(tid_));
  const int tid = tid_, wid = tid >> 6, lane = tid & 63, r32 = lane & 31, hi = lane >> 5;
  char* V_lds = lds; char* K_lds = lds + 2 * SHM_V;
  float* ws = (float*)(lds + 2 * SHM_V + 2 * SHM_K) + wid * 64; float* li_l = ws; float* al_l = ws + 32;
  float m_reg = -1e30f, l_reg = 0; f32x16 o[4] = {}; bf16x8 qr[DK / 16];
  const unsigned short* Qw = Qb + (long)(wid * QBLK + r32) * ldq + hi * 8;
#pragma unroll
  for (int d0 = 0; d0 < DK / 16; ++d0) qr[d0] = *reinterpret_cast<const bf16x8*>(Qw + d0 * 16);
  const int sr = tid >> 4, sc = (tid & 15) * 8, vst0 = v_st(sr, sc), vst1 = v_st(32 + sr, sc);
  unsigned kgo[NKC], klo[NKC];
#pragma unroll
  for (int i = 0; i < NKC; ++i) { const int c = tid + 512 * i, kr_ = c / CPR, kc_ = (c % CPR) * 8; kgo[i] = (unsigned)(kr_ * ldk + kc_) * 2u; klo[i] = (unsigned)kswz<DK>(kr_, kc_ * 2); }
  const unsigned vgo0 = (unsigned)(sr * ldv + sc) * 2u, vgo1 = (unsigned)((32 + sr) * ldv + sc) * 2u;
  const int vb0 = (int)(uintptr_t)V_lds + v_rd_base(lane);
  struct { bf16x8 vs0, vs1; bf16x8 ks[NKC]; } sr_[SDEPTH];
#define ATT_SLOAD(i, k0) do { const char* _vt = (const char*)Vh + (size_t)(k0) * (ldv * 2); const char* _kt = (const char*)Kh + (size_t)(k0) * (ldk * 2); \
    sr_[i].vs0 = *reinterpret_cast<const bf16x8*>(_vt + vgo0); sr_[i].vs1 = *reinterpret_cast<const bf16x8*>(_vt + vgo1); \
    _Pragma("unroll") for (int _c = 0; _c < NKC; ++_c) sr_[i].ks[_c] = *reinterpret_cast<const bf16x8*>(_kt + kgo[_c]); } while (0)
#define ATT_SWRITE(b, i) do { *(bf16x8*)(V_lds + (b) * SHM_V + vst0) = sr_[i].vs0; *(bf16x8*)(V_lds + (b) * SHM_V + vst1) = sr_[i].vs1; \
    _Pragma("unroll") for (int _c = 0; _c < NKC; ++_c) *(bf16x8*)(K_lds + (b) * SHM_K + klo[_c]) = sr_[i].ks[_c]; } while (0)
#define ATT_SWAIT() do { if constexpr (SDEPTH == 2) asm volatile("s_waitcnt vmcnt(%0)" :: "n"(2 + NKC) : "memory"); else asm volatile("s_waitcnt vmcnt(0)" ::: "memory"); } while (0)
#define ATT_RESC(a) do { if (__any((a) < 1.f)) { if (hi == 0) al_l[r32] = (a); asm volatile("s_waitcnt lgkmcnt(0)" ::: "memory"); \
    for (int d = 0; d < 4; ++d) for (int r = 0; r < 16; ++r) o[d][r] *= al_l[crow(r, hi)]; } } while (0)
  f32x16 pA0, pA1, pB0, pB1; float mnA, mnB, alA, alB; bf16x8 pa0, pa1, pa2, pa3; const int NT = seq / KVBLK;
  constexpr int SE = 0, SO = SDEPTH - 1;
  ATT_SLOAD(SE, 0); asm volatile("s_waitcnt vmcnt(0)" ::: "memory"); ATT_SWRITE(0, SE); __syncthreads();
  qkt<DK>(pA0, pA1, K_lds, qr, r32, hi); partialSM<DK>(pA0, pA1, m_reg, mnA, alA);
  ATT_SLOAD(SO, KVBLK); if constexpr (SDEPTH == 2) { if (2 < NT) ATT_SLOAD(SE, 2 * KVBLK); }
  ATT_SWAIT(); ATT_SWRITE(1, SO); __syncthreads();
  for (int j = 1; j + 1 < NT; j += 2) {
    ATT_SBAR(); qkt<DK>(pB0, pB1, K_lds + SHM_K, qr, r32, hi);
    finishSM(pA0, pA1, alA, l_reg, pa0, pa1, pa2, pa3); ATT_SBAR();
    ATT_SLOAD(SO, (j + SDEPTH) * KVBLK); ATT_SBAR();
    pv_d0(o, vb0, pa0, pa1, pa2, pa3); partialSM<DK>(pB0, pB1, m_reg, mnB, alB);
    __syncthreads(); ATT_SWAIT(); ATT_SWRITE(0, SE);
    ATT_RESC(alB); __syncthreads();
    ATT_SBAR(); qkt<DK>(pA0, pA1, K_lds, qr, r32, hi);
    finishSM(pB0, pB1, alB, l_reg, pa0, pa1, pa2, pa3); ATT_SBAR();
    if (SDEPTH == 1 || j + 3 < NT) ATT_SLOAD(SE, (j + 1 + SDEPTH) * KVBLK); ATT_SBAR();
    pv_d0(o, vb0 + SHM_V, pa0, pa1, pa2, pa3); partialSM<DK>(pA0, pA1, m_reg, mnA, alA);
    __syncthreads(); if (SDEPTH == 1 || j + 3 < NT) ATT_SWAIT(); else asm volatile("s_waitcnt vmcnt(0)" ::: "memory"); ATT_SWRITE(1, SO);
    ATT_RESC(alA); __syncthreads();
  }
  ATT_SBAR(); qkt<DK>(pB0, pB1, K_lds + SHM_K, qr, r32, hi);
  finishSM(pA0, pA1, alA, l_reg, pa0, pa1, pa2, pa3); ATT_SBAR();
  pv_d0(o, vb0, pa0, pa1, pa2, pa3); partialSM<DK>(pB0, pB1, m_reg, mnB, alB);
  __syncthreads(); ATT_RESC(alB);
  finishSM(pB0, pB1, alB, l_reg, pa0, pa1, pa2, pa3); ATT_SBAR();
  pv_d0(o, vb0 + SHM_V, pa0, pa1, pa2, pa3);
  if (hi == 0) li_l[r32] = l_reg; asm volatile("s_waitcnt lgkmcnt(0)" ::: "memory");
  float rli[16];
#pragma unroll
  for (int r = 0; r < 16; ++r) rli[r] = __builtin_amdgcn_rcpf(li_l[crow(r, hi)]);
  unsigned short* Ow = Ob + (long)(wid * QBLK) * ldo;
#pragma unroll
  for (int r = 0; r < 16; ++r) { int orow = crow(r, hi);
#pragma unroll
    for (int d0 = 0; d0 < 4; ++d0) { const float v = o[d0][r] * rli[r]; unsigned u = __float_as_uint(v); u += 0x7fffu + ((u >> 16) & 1u); Ow[(long)orow * ldo + d0 * 32 + r32] = (unsigned short)(u >> 16); } }
  __syncthreads();
#undef ATT_SLOAD
#undef ATT_SWRITE
#undef ATT_SWAIT
#undef ATT_RESC
}
template <int DK, int ldq, int ldk, int ldv, int ldo, class CV>
__device__ __forceinline__ void attn_body_simple(const unsigned short* __restrict__ Qb, const unsigned short* __restrict__ Kh, const unsigned short* __restrict__ Vh,
                                                 unsigned short* __restrict__ Ob, int seq, char* lds, CV& cv) {
  using C_ = Cfg<DK>; constexpr int SHM_V = C_::SHM_V, SHM_K = C_::SHM_K, NKC = C_::NKC, CPR = DK / 8;
  int tid_ = threadIdx.x; asm volatile("" : "+v"(tid_));
  const int tid = tid_, wid = tid >> 6, lane = tid & 63, r32 = lane & 31, hi = lane >> 5;
  char* V_lds = lds; char* K_lds = lds + 2 * SHM_V;
  float* ws = (float*)(lds + 2 * SHM_V + 2 * SHM_K) + wid * 64; float* li_l = ws; float* al_l = ws + 32;
  float m_reg = -1e30f, l_reg = 0; f32x16 o[4] = {}; bf16x8 qr[DK / 16];
  const unsigned short* Qw = Qb + (long)(wid * QBLK + r32) * ldq + hi * 8;
#pragma unroll
  for (int d0 = 0; d0 < DK / 16; ++d0) qr[d0] = *reinterpret_cast<const bf16x8*>(Qw + d0 * 16);
  const int sr = tid >> 4, sc = (tid & 15) * 8, vst0 = v_st(sr, sc), vst1 = v_st(32 + sr, sc);
  unsigned kgo[NKC], klo[NKC];
#pragma unroll
  for (int i = 0; i < NKC; ++i) { const int c = tid + 512 * i, kr_ = c / CPR, kc_ = (c % CPR) * 8; kgo[i] = (unsigned)(kr_ * ldk + kc_) * 2u; klo[i] = (unsigned)kswz<DK>(kr_, kc_ * 2); }
  const unsigned vgo0 = (unsigned)(sr * ldv + sc) * 2u, vgo1 = (unsigned)((32 + sr) * ldv + sc) * 2u;
  const int vb0 = (int)(uintptr_t)V_lds + v_rd_base(lane);
  bf16x8 vs0, vs1, ks[NKC];
#define ATS_LOAD(k0) do { const char* _vt = (const char*)Vh + (size_t)(k0) * (ldv * 2); const char* _kt = (const char*)Kh + (size_t)(k0) * (ldk * 2); \
    vs0 = *reinterpret_cast<const bf16x8*>(_vt + vgo0); vs1 = *reinterpret_cast<const bf16x8*>(_vt + vgo1); \
    _Pragma("unroll") for (int _c = 0; _c < NKC; ++_c) ks[_c] = *reinterpret_cast<const bf16x8*>(_kt + kgo[_c]); } while (0)
#define ATS_WRITE(b) do { *(bf16x8*)(V_lds + (b) * SHM_V + vst0) = vs0; *(bf16x8*)(V_lds + (b) * SHM_V + vst1) = vs1; \
    _Pragma("unroll") for (int _c = 0; _c < NKC; ++_c) *(bf16x8*)(K_lds + (b) * SHM_K + klo[_c]) = ks[_c]; } while (0)
  const int NT = seq / KVBLK; float cw[32];
#define ATT_STAGE_BAR() do { asm volatile("s_waitcnt lgkmcnt(0)" ::: "memory"); __builtin_amdgcn_s_barrier(); ATT_SBAR(); } while (0)
  const bool lead = wid < 4;
  ATS_LOAD(0); asm volatile("s_waitcnt vmcnt(0)" ::: "memory"); ATS_WRITE(0); __syncthreads();
  if (!lead) ATT_STAGE_BAR();
  for (int j = 0; j < NT; ++j) {
    const int b = j & 1;
    cv.end(cw);
    if (j + 1 < NT) ATS_LOAD((j + 1) * KVBLK);
    if ((j & 1) == 0) cv.begin(cw);
    ATT_STAGE_BAR();
    f32x16 p0, p1; float mn, al; bf16x8 pa0, pa1, pa2, pa3;
    qkt<DK>(p0, p1, K_lds + b * SHM_K, qr, r32, hi);
    ATT_STAGE_BAR();
    partialSM<DK>(p0, p1, m_reg, mn, al);
    if (__any(al < 1.f)) { if (hi == 0) al_l[r32] = al; asm volatile("s_waitcnt lgkmcnt(0)" ::: "memory");
      for (int d = 0; d < 4; ++d) for (int r = 0; r < 16; ++r) o[d][r] *= al_l[crow(r, hi)]; }
    finishSM(p0, p1, al, l_reg, pa0, pa1, pa2, pa3);
    ATT_STAGE_BAR();
    pv_d0(o, vb0 + b * SHM_V, pa0, pa1, pa2, pa3);
    if (j + 1 < NT) { if (cv.pending()) asm volatile("s_waitcnt vmcnt(32)" ::: "memory"); else asm volatile("s_waitcnt vmcnt(0)" ::: "memory"); ATS_WRITE(b ^ 1); }
    ATT_STAGE_BAR();
  }
  if (lead) ATT_STAGE_BAR();
  cv.end(cw);
  if (hi == 0) li_l[r32] = l_reg; asm volatile("s_waitcnt lgkmcnt(0)" ::: "memory");
  float rli[16];
#pragma unroll
  for (int r = 0; r < 16; ++r) rli[r] = __builtin_amdgcn_rcpf(li_l[crow(r, hi)]);
  unsigned short* Ow = Ob + (long)(wid * QBLK) * ldo;
#pragma unroll
  for (int r = 0; r < 16; ++r) { int orow = crow(r, hi);
#pragma unroll
    for (int d0 = 0; d0 < 4; ++d0) { const float v = o[d0][r] * rli[r]; unsigned u = __float_as_uint(v); u += 0x7fffu + ((u >> 16) & 1u); Ow[(long)orow * ldo + d0 * 32 + r32] = (unsigned short)(u >> 16); } }
  __syncthreads();
#undef ATS_LOAD
#undef ATS_WRITE
}
}
namespace ssd {
typedef short bf16x8 __attribute__((ext_vector_type(8)));
typedef short v4i16_t __attribute__((ext_vector_type(4)));
typedef float f32x4 __attribute__((ext_vector_type(4)));
typedef unsigned u32x2v __attribute__((ext_vector_type(2)));
typedef unsigned u32x4v __attribute__((ext_vector_type(4)));
#define SSD_LAS __attribute__((address_space(3)))
constexpr int T = 128, LD_B = 136, LD_X = 72, LD_A = 136, LD_S = 136;
constexpr int OFF_B = 0, OFF_X = OFF_B + T * LD_B * 2, OFF_XW = OFF_X + T * LD_X * 2, OFF_A = OFF_XW + T * LD_X * 2, OFF_S = OFF_A + T * LD_A * 2, OFF_E = OFF_S + 64 * LD_S * 2, OFF_W = OFF_E + 512, OFF_DT = OFF_W + 512, OFF_MISC = OFF_DT + 512, LDS_BYTES = OFF_MISC + 64;
static_assert(LDS_BYTES <= 131072, "ssd LDS");
__device__ __forceinline__ unsigned cvt_pk(float lo, float hi) { typedef float f32x2_t_ __attribute__((ext_vector_type(2))); typedef __bf16 bf16x2_t_ __attribute__((ext_vector_type(2))); const f32x2_t_ v_ = {lo, hi}; const bf16x2_t_ b_ = __builtin_convertvector(v_, bf16x2_t_); return __builtin_bit_cast(unsigned, b_); }
__device__ __forceinline__ bf16x8 tr8(const SSD_LAS unsigned char* p, int rowstride_bytes) {
    const v4i16_t a = __builtin_amdgcn_ds_read_tr16_b64_v4i16((SSD_LAS v4i16_t*)p);
    const v4i16_t b = __builtin_amdgcn_ds_read_tr16_b64_v4i16((SSD_LAS v4i16_t*)(p + 4 * rowstride_bytes));
    return (bf16x8){a[0], a[1], a[2], a[3], b[0], b[1], b[2], b[3]};
}
__device__ __forceinline__ void ssd_unit(SSD_LAS unsigned char* lds, const unsigned short* __restrict__ XBC, const float* __restrict__ DT, unsigned short* __restrict__ Y,
                                         int row0, int nc, int h, int dir, float a_h, const float* __restrict__ h0, float* __restrict__ hout) {
    int tid_ = threadIdx.x; asm volatile("" : "+v"(tid_));
    const int tid = tid_, w = tid >> 6, lane = tid & 63, li = lane & 15, g = lane >> 4, grp = h >> 3;
    SSD_LAS float* Es = (SSD_LAS float*)(lds + OFF_E); SSD_LAS float* Ws = (SSD_LAS float*)(lds + OFF_W); SSD_LAS float* Dts = (SSD_LAS float*)(lds + OFF_DT); SSD_LAS float* Misc = (SSD_LAS float*)(lds + OFF_MISC);
    f32x4 st[4];
#pragma unroll
    for (int pt = 0; pt < 4; ++pt) st[pt] = h0 ? *(const f32x4*)(h0 + (size_t)(16 * pt + li) * 128 + 16 * w + 4 * g) : (f32x4){0.f, 0.f, 0.f, 0.f};
#pragma unroll
    for (int pt = 0; pt < 4; ++pt) { u32x2v pk; pk.x = cvt_pk(st[pt][0], st[pt][1]); pk.y = cvt_pk(st[pt][2], st[pt][3]); *(SSD_LAS u32x2v*)(lds + OFF_S + ((16 * pt + li) * LD_S + 16 * w + 4 * g) * 2) = pk; }
    u32x4v bv[4]; u32x4v xv[2]; float dtv = 0.f;
#define SSD_PREFETCH(tq) do { _Pragma("unroll") for (int i = 0; i < 4; ++i) { const int ch = tid + 512 * i, r = ch >> 4, cc = (ch & 15) * 8; bv[i] = *(const u32x4v*)(XBC + (size_t)((tq) + r) * 1536 + 1024 + grp * 128 + cc); } \
        _Pragma("unroll") for (int i = 0; i < 2; ++i) { const int ch = tid + 512 * i, r = ch >> 3, cc = (ch & 7) * 8; xv[i] = *(const u32x4v*)(XBC + (size_t)((tq) + r) * 1536 + h * 64 + cc); } \
        dtv = DT[(size_t)((tq) + (tid & 127)) * 32 + dir * 16 + h]; } while (0)
    SSD_PREFETCH(row0 + (dir ? nc - 1 : 0) * T);
    for (int ci = 0; ci < nc; ++ci) {
        const int c = dir ? nc - 1 - ci : ci; const int t0 = row0 + c * T;
        bf16x8 cf[4];
#pragma unroll
        for (int k = 0; k < 4; ++k) cf[k] = *(const bf16x8*)(XBC + (size_t)(t0 + 16 * w + li) * 1536 + 1280 + grp * 128 + 32 * k + 8 * g);
        if (tid < 128) {
            const float da = dtv * a_h; float p = da;
#pragma unroll
            for (int o = 1; o < 64; o <<= 1) { const float q = __shfl_up(p, o); if (lane >= o) p += q; }
            if (lane == 63) Misc[w] = p;
            Dts[tid] = dtv; Es[tid] = p; Ws[tid] = da;
        }
        __syncthreads();
        if (tid < 128) {
            const float tot0 = Misc[0], tot = tot0 + Misc[1]; float P = Es[tid] + (w == 1 ? tot0 : 0.f); const float da = Ws[tid];
            const float E = dir ? tot - P + da : P;
            Es[tid] = E; Ws[tid] = __expf(tot - E) * Dts[tid];
            if (tid == 0) Misc[2] = tot;
        }
        __syncthreads();
#pragma unroll
        for (int i = 0; i < 4; ++i) { const int ch = tid + 512 * i, r = ch >> 4, cc = (ch & 15) * 8; *(SSD_LAS u32x4v*)(lds + OFF_B + (r * LD_B + cc) * 2) = bv[i]; }
#pragma unroll
        for (int i = 0; i < 2; ++i) { const int ch = tid + 512 * i, r = ch >> 3, cc = (ch & 7) * 8; *(SSD_LAS u32x4v*)(lds + OFF_X + (r * LD_X + cc) * 2) = xv[i];
            const float ws = Ws[r]; u32x4v o; const unsigned* xi = (const unsigned*)&xv[i]; unsigned* oo = (unsigned*)&o;
#pragma unroll
            for (int q = 0; q < 4; ++q) oo[q] = cvt_pk(__uint_as_float(xi[q] << 16) * ws, __uint_as_float(xi[q] & 0xffff0000u) * ws);
            *(SSD_LAS u32x4v*)(lds + OFF_XW + (r * LD_X + cc) * 2) = o; }
        if (ci + 1 < nc) SSD_PREFETCH(row0 + (dir ? nc - 2 - ci : ci + 1) * T);
        __syncthreads();
#define SSD_SB() __builtin_amdgcn_sched_barrier(0)
        const int l = 16 * w + li; const float El = Es[l];
#pragma unroll
        for (int sp = 0; sp < 8; sp += 2) {
            bf16x8 a[2][4]; float es[2][4], ds[2][4];
#pragma unroll
            for (int t = 0; t < 2; ++t) {
#pragma unroll
                for (int k = 0; k < 4; ++k) a[t][k] = *(const SSD_LAS bf16x8*)(lds + OFF_B + ((16 * (sp + t) + li) * LD_B + 32 * k + 8 * g) * 2);
                const f32x4 e4 = *(const SSD_LAS f32x4*)(Es + 16 * (sp + t) + 4 * g), d4 = *(const SSD_LAS f32x4*)(Dts + 16 * (sp + t) + 4 * g);
#pragma unroll
                for (int j = 0; j < 4; ++j) { es[t][j] = e4[j]; ds[t][j] = d4[j]; } }
            SSD_SB();
            f32x4 acc[2] = {{0.f, 0.f, 0.f, 0.f}, {0.f, 0.f, 0.f, 0.f}};
#pragma unroll
            for (int k = 0; k < 4; ++k)
#pragma unroll
                for (int t = 0; t < 2; ++t) acc[t] = __builtin_amdgcn_mfma_f32_16x16x32_bf16(a[t][k], cf[k], acc[t], 0, 0, 0);
#pragma unroll
            for (int t = 0; t < 2; ++t) { float v[4];
#pragma unroll
                for (int j = 0; j < 4; ++j) { const int s_ = 16 * (sp + t) + 4 * g + j; const bool ok = dir ? (s_ >= l) : (s_ <= l); const float e = __expf(El - es[t][j]) * ds[t][j]; v[j] = ok ? acc[t][j] * e : 0.f; }
                u32x2v pk; pk.x = cvt_pk(v[0], v[1]); pk.y = cvt_pk(v[2], v[3]);
                *(SSD_LAS u32x2v*)(lds + OFF_A + (l * LD_A + 16 * (sp + t) + 4 * g) * 2) = pk; }
            SSD_SB();
        }
        asm volatile("s_waitcnt lgkmcnt(0)" ::: "memory");
        float el4[4];
        { const f32x4 e4 = *(const SSD_LAS f32x4*)(Es + 16 * w + 4 * g);
#pragma unroll
          for (int j = 0; j < 4; ++j) el4[j] = __expf(e4[j]); }
        unsigned short* yrow = Y + (size_t)(t0 + 16 * w + 4 * g) * 1024 + h * 64 + li;
        bf16x8 af[4];
#pragma unroll
        for (int k = 0; k < 4; ++k) af[k] = *(const SSD_LAS bf16x8*)(lds + OFF_A + (l * LD_A + 32 * k + 8 * g) * 2);
#pragma unroll
        for (int pt = 0; pt < 4; ++pt) {
            bf16x8 xb[4], sb[4];
#pragma unroll
            for (int k = 0; k < 4; ++k) { xb[k] = tr8(lds + OFF_X + ((32 * k + 8 * g + (li >> 2)) * LD_X + 16 * pt + 4 * (li & 3)) * 2, LD_X * 2);
                sb[k] = *(const SSD_LAS bf16x8*)(lds + OFF_S + ((16 * pt + li) * LD_S + 32 * k + 8 * g) * 2); }
            SSD_SB();
            f32x4 ya = {0.f, 0.f, 0.f, 0.f}, yb = {0.f, 0.f, 0.f, 0.f};
#pragma unroll
            for (int k = 0; k < 4; ++k) { ya = __builtin_amdgcn_mfma_f32_16x16x32_bf16(af[k], xb[k], ya, 0, 0, 0); yb = __builtin_amdgcn_mfma_f32_16x16x32_bf16(cf[k], sb[k], yb, 0, 0, 0); }
#pragma unroll
            for (int j = 0; j < 4; ++j) { const float yv = ya[j] + el4[j] * yb[j]; unsigned u = __float_as_uint(yv); u += 0x7fffu + ((u >> 16) & 1u); yrow[(size_t)j * 1024 + 16 * pt] = (unsigned short)(u >> 16); }
            SSD_SB();
        }
        __syncthreads();
        const float etot = __expf(Misc[2]);
        bf16x8 ba[4];
#pragma unroll
        for (int k = 0; k < 4; ++k) ba[k] = tr8(lds + OFF_B + ((32 * k + 8 * g + (li >> 2)) * LD_B + 16 * w + 4 * (li & 3)) * 2, LD_B * 2);
#pragma unroll
        for (int pt = 0; pt < 4; ++pt) { bf16x8 xw[4];
#pragma unroll
            for (int k = 0; k < 4; ++k) xw[k] = tr8(lds + OFF_XW + ((32 * k + 8 * g + (li >> 2)) * LD_X + 16 * pt + 4 * (li & 3)) * 2, LD_X * 2);
            SSD_SB();
            st[pt] *= etot;
#pragma unroll
            for (int k = 0; k < 4; ++k) st[pt] = __builtin_amdgcn_mfma_f32_16x16x32_bf16(ba[k], xw[k], st[pt], 0, 0, 0);
            u32x2v pk; pk.x = cvt_pk(st[pt][0], st[pt][1]); pk.y = cvt_pk(st[pt][2], st[pt][3]); *(SSD_LAS u32x2v*)(lds + OFF_S + ((16 * pt + li) * LD_S + 16 * w + 4 * g) * 2) = pk;
            SSD_SB(); }
        __syncthreads();
    }
#undef SSD_SB
#undef SSD_PREFETCH
    if (hout) {
#pragma unroll
        for (int pt = 0; pt < 4; ++pt) *(f32x4*)(hout + (size_t)(16 * pt + li) * 128 + 16 * w + 4 * g) = st[pt];
    }
}
}
namespace s5 {
typedef short bf16x8 __attribute__((ext_vector_type(8)));
typedef short bf16x4 __attribute__((ext_vector_type(4)));
typedef float f32x4 __attribute__((ext_vector_type(4)));
typedef float f32x2 __attribute__((ext_vector_type(2)));
typedef unsigned u32x2 __attribute__((ext_vector_type(2)));
typedef unsigned u32x4 __attribute__((ext_vector_type(4)));
#define S5_LAS __attribute__((address_space(3)))
constexpr int LD_BU = 136, LD_HS = 136;
constexpr int OFF_HS = 16 * LD_BU * 2, OFF_YL = OFF_HS + 16 * LD_HS * 2;
constexpr int WAVE_LDS = OFF_YL + 16 * 16 * 16 * 2;
constexpr int CD_BYTES = 1024 + 4096, CG_BYTES = 4096;
__device__ __forceinline__ unsigned short f2bf(float f) { unsigned u = __float_as_uint(f); u += 0x7fffu + ((u >> 16) & 1u); return (unsigned short)(u >> 16); }
__device__ __forceinline__ unsigned pk(float lo, float hi) { typedef float f2_ __attribute__((ext_vector_type(2))); typedef __bf16 b2_ __attribute__((ext_vector_type(2))); const f2_ v = {lo, hi}; const b2_ b = __builtin_convertvector(v, b2_); return __builtin_bit_cast(unsigned, b); }

__device__ __forceinline__ void make_consts(unsigned char* cd, unsigned char* cg  , const float* lam_re, const float* lam_im, float stepsz, const float* b_re, const float* b_im, const float* c_re, const float* c_im, int lane) {
    const int li = lane & 15, g = lane >> 4;
    float ar, ai, kr, ki;
    { const float lr = lam_re[lane], lm = lam_im[lane]; const float mag = expf(lr * stepsz); float sn, cs; sincosf(lm * stepsz, &sn, &cs); ar = mag * cs; ai = mag * sn;
      const float den = lr * lr + lm * lm; kr = ((ar - 1.0f) * lr + ai * lm) / den; ki = (ai * lr - (ar - 1.0f) * lm) / den; }
    float zr = ar, zi = ai;
#pragma unroll
    for (int i = 0; i < 8; ++i) { const float nr = zr * zr - zi * zi, ni = 2.0f * zr * zi; zr = nr; zi = ni; }
    float* cf = (float*)cd; cf[lane] = ar; cf[64 + lane] = ai; cf[128 + lane] = zr; cf[192 + lane] = zi;
#pragma unroll
    for (int ct = 0; ct < 8; ++ct) { const int k = 16 * ct + li, p = k >> 1; const bool im = k & 1; const float kkr = __shfl(kr, p), kki = __shfl(ki, p);
        const f32x4 br = *(const f32x4*)(b_re + p * 16 + 4 * g), bi = *(const f32x4*)(b_im + p * 16 + 4 * g); float v[4];
#pragma unroll
        for (int j = 0; j < 4; ++j) v[j] = im ? kkr * bi[j] + kki * br[j] : kkr * br[j] - kki * bi[j];
        u32x2 w; w.x = pk(v[0], v[1]); w.y = pk(v[2], v[3]); *(u32x2*)(cd + 1024 + (ct * 64 + lane) * 8) = w; }
    if (cg) {
#pragma unroll
        for (int kk = 0; kk < 4; ++kk) { const f32x4 vr = *(const f32x4*)(c_re + li * 64 + 16 * kk + 4 * g), vi = *(const f32x4*)(c_im + li * 64 + 16 * kk + 4 * g);
            u32x4 w; w.x = pk(vr[0], -vi[0]); w.y = pk(vr[1], -vi[1]); w.z = pk(vr[2], -vi[2]); w.w = pk(vr[3], -vi[3]); *(u32x4*)(cg + (kk * 64 + lane) * 16) = w; } }
}
struct Ctx {
    float ar, ai;
    bf16x4 bfr[8];
    bf16x8 cfr[4];
};
__device__ __forceinline__ void load_ctx(Ctx& c, const unsigned char* cd, const unsigned char* cg, int lane, bool with_c) {
    const float* cf = (const float*)cd; c.ar = cf[lane]; c.ai = cf[64 + lane];
#pragma unroll
    for (int ct = 0; ct < 8; ++ct) c.bfr[ct] = __builtin_bit_cast(bf16x4, *(const u32x2*)(cd + 1024 + (ct * 64 + lane) * 8));
    if (with_c) {
#pragma unroll
        for (int kk = 0; kk < 4; ++kk) c.cfr[kk] = __builtin_bit_cast(bf16x8, *(const u32x4*)(cg + (kk * 64 + lane) * 16)); }
}
template <bool NEWT, bool CURT, bool HSW, bool OLDT, bool POST>
__device__ __forceinline__ void step(const Ctx& c, S5_LAS unsigned char* BU, S5_LAS unsigned char* HS, S5_LAS unsigned char* YL  , int lane, int li, int g, int dir, const u32x2 unew, float& hr, float& hi,
                                     const unsigned short* __restrict__ uold, int ldu, unsigned short* __restrict__ outp, float dch) {
    unsigned bu[16]; bf16x8 hf[4]; f32x4 acc[8]; unsigned hs[16]; unsigned short yprev[4]; unsigned short uo[4];
    if (CURT) {
#pragma unroll
        for (int i = 0; i < 16; ++i) { const int t = dir ? 15 - i : i; bu[i] = *(const S5_LAS unsigned*)(BU + t * (LD_BU * 2) + lane * 4); } }
    if (OLDT) {
#pragma unroll
        for (int kk = 0; kk < 4; ++kk) hf[kk] = *(const S5_LAS bf16x8*)(HS + li * (LD_HS * 2) + (32 * kk + 8 * g) * 2);
        if (POST) {
#pragma unroll
            for (int j = 0; j < 4; ++j) { yprev[j] = *(const S5_LAS unsigned short*)(YL + ((4 * g + j) * 16 + li) * 2); uo[j] = uold[(size_t)(4 * g + j) * ldu + li]; } } }
    if (NEWT) { const bf16x4 uf = __builtin_bit_cast(bf16x4, unew);
#pragma unroll
        for (int ct = 0; ct < 8; ++ct) { acc[ct] = (f32x4){0.f, 0.f, 0.f, 0.f}; acc[ct] = __builtin_amdgcn_mfma_f32_16x16x16bf16_1k(c.bfr[ct], uf, acc[ct], 0, 0, 0); } }
    if (CURT) {
#pragma unroll
        for (int i = 0; i < 16; ++i) { const float br = __uint_as_float(bu[i] << 16), bi = __uint_as_float(bu[i] & 0xffff0000u);
            const float nr = c.ar * hr - c.ai * hi + br, ni = c.ar * hi + c.ai * hr + bi; hr = nr; hi = ni; if (HSW) hs[i] = pk(hr, hi); } }
    if (OLDT) { f32x4 y = {0.f, 0.f, 0.f, 0.f};
#pragma unroll
        for (int kk = 0; kk < 4; ++kk) y = __builtin_amdgcn_mfma_f32_16x16x32_bf16(hf[kk], c.cfr[kk], y, 0, 0, 0);
        if (!POST) {
#pragma unroll
            for (int j = 0; j < 4; ++j) *(S5_LAS unsigned short*)(YL + ((4 * g + j) * 16 + li) * 2) = f2bf(y[j]); }
        else {
#pragma unroll
            for (int j = 0; j < 4; ++j) { const float v = y[j] + __uint_as_float((unsigned)yprev[j] << 16) + dch * __uint_as_float((unsigned)uo[j] << 16); const float tt = 0.7978845608028654f * (v + 0.044715f * v * v * v);
                outp[(size_t)(4 * g + j) * 1024 + li] = f2bf(v * (1.0f - 1.0f / (1.0f + __expf(2.0f * tt)))); } } }
    if (NEWT) {
#pragma unroll
        for (int ct = 0; ct < 8; ++ct) { u32x2 w; w.x = pk(acc[ct][0], acc[ct][1]); w.y = pk(acc[ct][2], acc[ct][3]); *(S5_LAS u32x2*)(BU + (li * LD_BU + 16 * ct + 4 * g) * 2) = w; } }
    if (CURT && HSW) {
#pragma unroll
        for (int i = 0; i < 16; ++i) { const int t = dir ? 15 - i : i; *(S5_LAS unsigned*)(HS + t * (LD_HS * 2) + lane * 4) = hs[i]; } }
}
template <bool POST>
__device__ __forceinline__ void s5_pass(const Ctx& c, S5_LAS unsigned char* wl, int lane, int dir, const unsigned short* __restrict__ U, int ldu, unsigned short* __restrict__ OUT, float dch, float& hr, float& hi) {
    const int li = lane & 15, g = lane >> 4; constexpr int L = 256, ntile = 16;
    S5_LAS unsigned char* BU = wl; S5_LAS unsigned char* HS = wl + OFF_HS; S5_LAS unsigned char* YL = wl + OFF_YL;
#define S5_TB(ti) (dir ? L - 16 * ((ti) + 1) : 16 * (ti))
#define S5_ULOAD(ti) (*(const u32x2*)(U + (size_t)(S5_TB(ti) + li) * ldu + 4 * g))
#define S5_ARGS(ti) YL + S5_TB(ti) * 32, lane, li, g, dir
#define S5_ARGS2(ti) U + (size_t)S5_TB(ti) * ldu, ldu, OUT + (size_t)S5_TB(ti) * 1024, dch
    u32x2 u0 = S5_ULOAD(0), u1 = S5_ULOAD(1), u2 = S5_ULOAD(2);
    step<true, false, true, false, POST>(c, BU, HS, S5_ARGS(0), u0, hr, hi, S5_ARGS2(0));
    step<true, true, true, false, POST>(c, BU, HS, S5_ARGS(0), u1, hr, hi, S5_ARGS2(0));
    u0 = u2; u1 = S5_ULOAD(3); u2 = S5_ULOAD(4);
#pragma clang loop unroll(disable)
    for (int ti = 2; ti < ntile; ++ti) {
        const u32x2 uc = u0; u0 = u1; u1 = u2; if (ti + 3 < ntile) u2 = S5_ULOAD(ti + 3);
        step<true, true, true, true, POST>(c, BU, HS, S5_ARGS(ti - 2), uc, hr, hi, S5_ARGS2(ti - 2));
    }
    step<false, true, true, true, POST>(c, BU, HS, S5_ARGS(ntile - 2), u0, hr, hi, S5_ARGS2(ntile - 2));
    step<false, false, true, true, POST>(c, BU, HS, S5_ARGS(ntile - 1), u0, hr, hi, S5_ARGS2(ntile - 1));
#undef S5_ARGS
#undef S5_ARGS2
}
__device__ __forceinline__ void s5_epass(const Ctx& c, S5_LAS unsigned char* wl, int lane, int dir, const unsigned short* __restrict__ U, int ldu, float& hr, float& hi) {
    const int li = lane & 15, g = lane >> 4; constexpr int L = 256, ntile = 16;
    S5_LAS unsigned char* BU = wl; S5_LAS unsigned char* HS = wl + OFF_HS;
    u32x2 uu[16];
#pragma unroll
    for (int ti = 0; ti < 16; ++ti) uu[ti] = S5_ULOAD(ti);
    step<true, false, false, false, false>(c, BU, HS, HS, lane, li, g, dir, uu[0], hr, hi, nullptr, 0, nullptr, 0.f);
#pragma unroll
    for (int ti = 1; ti < ntile; ++ti) step<true, true, false, false, false>(c, BU, HS, HS, lane, li, g, dir, uu[ti], hr, hi, nullptr, 0, nullptr, 0.f);
    step<false, true, false, false, false>(c, BU, HS, HS, lane, li, g, dir, uu[0], hr, hi, nullptr, 0, nullptr, 0.f);
#undef S5_ULOAD
#undef S5_TB
}
}
typedef unsigned short bf16;
typedef float f32x4 __attribute__((ext_vector_type(4)));
typedef unsigned u32x4 __attribute__((ext_vector_type(4)));
typedef unsigned u32x2 __attribute__((ext_vector_type(2)));
#define LAS __attribute__((address_space(3)))
constexpr int NWAVES = 8, NTHREADS = 512;
constexpr int DM = 2048, MROWS = 16384, MCTX = 8192, KROWS = 18432, NLAYER = 4;
constexpr int NIN = 14336;
constexpr int C_GATE = 0, C_GQ = 8192, C_GK = 9216, C_GV = 9472, C_SZ = 9728, C_XBC = 10752, C_S5U = 12288, C_MQD = 13312, C_CKV = 13824, C_KPE = 14080, C_SDT = 14144, C_END = 14176;
constexpr int FFN = 5632;
constexpr float EPS = 1e-6f;
constexpr size_t MiB = 1u << 20;
constexpr size_t WS_CTL = 0, CTL_ZERO_BYTES = 1 * MiB;
constexpr size_t WS_MOD = 1 * MiB;
constexpr size_t WS_TAB = 2 * MiB;
constexpr size_t WS_X = 4 * MiB;
constexpr size_t WS_H = 132 * MiB;
constexpr size_t WS_PROJ = 196 * MiB;
constexpr size_t WS_W = 644 * MiB;
constexpr size_t W_IN = 0, W_UQ = W_IN + (size_t)NIN * 2048 * 2, W_UKV = W_UQ + (size_t)1536 * 512 * 2, W_GLU = W_UKV + (size_t)2048 * 256 * 2, W_BR = W_GLU + (size_t)2048 * 1024 * 2,
                 W_OUT = W_BR + (size_t)4 * 2048 * 1024 * 2, W_FI = W_OUT + (size_t)2048 * 2048 * 2, W_FO = W_FI + (size_t)11264 * 2048 * 2, W_END = W_FO + (size_t)2048 * 5632 * 2;
static_assert(W_END <= 154 * MiB, "weights region");
constexpr size_t WS_Q = 798 * MiB, WS_KG = 830 * MiB, WS_VG = 839 * MiB, WS_AQ = 848 * MiB, WS_ACKV = 864 * MiB, WS_QM = 873 * MiB, WS_KM = 921 * MiB, WS_VM = 975 * MiB,
                 WS_XBC = 1011 * MiB, WS_DT = 1059 * MiB, WS_YF = 1061 * MiB, WS_YB = 1125 * MiB, WS_SF = 1189 * MiB, WS_SB = 1253 * MiB, WS_S5PRE = 1317 * MiB,
                 WS_O = 1349 * MiB, WS_GSF = 1477 * MiB, WS_GS = 1605 * MiB, WS_END = 1669 * MiB;
constexpr size_t WS_S5C = WS_GSF, WS_S5G = WS_GSF + 4 * MiB, WS_S5E = WS_GSF + 8 * MiB;
constexpr int CW_BAR = 4096;
constexpr size_t O_YP = 0, O_YS = 16777216, O_GK = 33554432, O_GV = 41943040, O_CKV = 50331648, O_KPE = 58720256, O_SSD = 60817408, O_S5 = 94371840, O_TOTAL = 96468992;
constexpr int RING_BYTES = 131072, LDSCTL_OFF = 135168  , MISC_OFF = LDSCTL_OFF + 320, LDS_BYTES = 147456;

#define VM_WAIT() asm volatile("s_waitcnt vmcnt(0)" ::: "memory")
__device__ __forceinline__ unsigned f2bf(float f) { unsigned u = __float_as_uint(f); return (u + 0x7fffu + ((u >> 16) & 1u)) >> 16; }
__device__ __forceinline__ unsigned pk2(float lo, float hi) { typedef float f32x2_t_ __attribute__((ext_vector_type(2))); typedef __bf16 bf16x2_t_ __attribute__((ext_vector_type(2))); const f32x2_t_ v_ = {lo, hi}; const bf16x2_t_ b_ = __builtin_convertvector(v_, bf16x2_t_); return __builtin_bit_cast(unsigned, b_); }
__device__ __forceinline__ float bflo(unsigned w) { return __uint_as_float(w << 16); }
__device__ __forceinline__ float bfhi(unsigned w) { return __uint_as_float(w & 0xffff0000u); }
__device__ __forceinline__ void unpack8(const u32x4 w, float* f) { f[0] = bflo(w.x); f[1] = bfhi(w.x); f[2] = bflo(w.y); f[3] = bfhi(w.y); f[4] = bflo(w.z); f[5] = bfhi(w.z); f[6] = bflo(w.w); f[7] = bfhi(w.w); }
__device__ __forceinline__ u32x4 pack8f(const float* f) { u32x4 w; w.x = pk2(f[0], f[1]); w.y = pk2(f[2], f[3]); w.z = pk2(f[4], f[5]); w.w = pk2(f[6], f[7]); return w; }
__device__ __forceinline__ float wave_sum(float v) {
#pragma unroll
    for (int o = 1; o < 64; o <<= 1) v += __shfl_xor(v, o);
    return v;
}
__device__ __forceinline__ float sigm(float x) { return 1.0f / (1.0f + __expf(-x)); }

struct Args { const float* in[41]; float* out; unsigned char* ws; int ph_lo, ph_hi, li, pad; };
struct Frame {
    LAS unsigned char* lds; int tid, lane, wave, G, bid, gw, NGW;
    const float* const* in; float* out; unsigned char* ws;
    const float* const* in0; float* out0; unsigned char* ws0;
};
enum { I_XP = 0, I_XS, I_CGK, I_CGV, I_CCKV, I_CKPE, I_SSSD, I_SS5, I_C, I_CCTX, I_N1G, I_N2G, I_WMOD, I_BMOD, I_WIN, I_QNG, I_KNG, I_CONVW, I_CONVB, I_ALOG, I_DTB, I_SSDD, I_SSDNG,
       I_MQNG, I_WUQ, I_MKVNG, I_WUKV, I_LRE, I_LIM, I_LSTEP, I_BRE, I_BIM, I_CRE, I_CIM, I_S5D, I_WGLU, I_WBR, I_WOUT, I_WFI, I_WFO, I_FING };

__device__ __forceinline__ void transpose_item(const float* W, int K, int N, bf16* WT, int dst_row0, int k0, int n0, LAS float* scr, int lane) {
#pragma unroll 8
    for (int i = 0; i < 32; ++i) { const int kk = 2 * i + (lane >> 5); scr[kk * 33 + (lane & 31)] = W[(size_t)(k0 + kk) * N + n0 + (lane & 31)]; }
    asm volatile("s_waitcnt lgkmcnt(0)" ::: "memory");
    const int c = lane & 7;
#pragma unroll
    for (int j = 0; j < 4; ++j) { const int n = (lane >> 3) + 8 * j; const LAS float* s = scr + (8 * c) * 33 + n;
        u32x4 o; o.x = pk2(s[0 * 33], s[1 * 33]); o.y = pk2(s[2 * 33], s[3 * 33]); o.z = pk2(s[4 * 33], s[5 * 33]); o.w = pk2(s[6 * 33], s[7 * 33]);
        *(u32x4*)(WT + (size_t)(dst_row0 + n) * K + k0 + 8 * c) = o; }
    asm volatile("s_waitcnt lgkmcnt(0)" ::: "memory");
}
__device__ __forceinline__ int map_in(int c) {
    if (c < 12288) return c; if (c < 12320) return C_SDT + (c - 12288); if (c < 12832) return C_MQD + (c - 12320); if (c < 13152) return C_CKV + (c - 12832); return C_S5U + (c - 13152);
}
__device__ __forceinline__ int map_pair(int c, int half) {
    return c < half ? 256 * (c >> 7) + (c & 127) : 256 * ((c - half) >> 7) + 128 + ((c - half) & 127);
}
__device__ __forceinline__ void phase_zero_pad(Frame& F) {
    bf16* Wi = (bf16*)((char*)(F.ws + WS_W) + W_IN); const u32x4 z = {0u, 0u, 0u, 0u};
    for (int r = F.gw; r < NIN - C_END; r += F.NGW) { u32x4* p = (u32x4*)(Wi + (size_t)(C_END + r) * 2048);
#pragma unroll
        for (int j = 0; j < 4; ++j) p[F.lane + 64 * j] = z; }
}
__device__ __forceinline__ void phase_prologue(Frame& F) {
    LAS float* sc = (LAS float*)F.lds;
    LAS float* part = (LAS float*)(F.lds + 40960);
    float* MOD = (float*)(F.ws + WS_MOD);
    for (int i = F.tid; i < 5 * 2048; i += NTHREADS) { const int v = i >> 11, k = i & 2047; const float x = v == 0 ? F.in[I_CCTX][k] : F.in[I_C][(v - 1) * 2048 + k]; sc[i] = x * sigm(x); }
    __syncthreads();
    for (int it = F.bid; it < 192; it += F.G) {
        const int l = it / 48, cg = it % 48; const float* W = F.in[I_WMOD] + (size_t)l * 2048 * 12288 + 256 * cg + 4 * F.lane;
        f32x4 acc[5];
#pragma unroll
        for (int v = 0; v < 5; ++v) acc[v] = (f32x4){0.f, 0.f, 0.f, 0.f};
        const int k0 = 256 * F.wave;
#pragma unroll 16
        for (int k = 0; k < 256; ++k) { const f32x4 w = *(const f32x4*)(W + (size_t)(k0 + k) * 12288);
#pragma unroll
            for (int v = 0; v < 5; ++v) acc[v] += sc[v * 2048 + k0 + k] * w; }
#pragma unroll
        for (int v = 0; v < 5; ++v) *(LAS f32x4*)(part + (F.wave * 5 + v) * 256 + 4 * F.lane) = acc[v];
        __syncthreads();
        for (int o = F.tid; o < 1280; o += NTHREADS) { const int v = o >> 8, col = o & 255; float s = F.in[I_BMOD][l * 12288 + 256 * cg + col];
#pragma unroll
            for (int w = 0; w < 8; ++w) s += part[(w * 5 + v) * 256 + col];
            MOD[((size_t)l * 5 + v) * 12288 + 256 * cg + col] = s; }
        __syncthreads();
    }
    for (int i = F.gw; i < NLAYER * 2 * 64; i += F.NGW) { const int layer = i >> 7, dir = (i >> 6) & 1, g = i & 63; const size_t pg = (size_t)(layer * 2 + dir) * 64 + g;
        s5::make_consts(F.ws + WS_S5C + (size_t)i * s5::CD_BYTES, dir == 0 ? F.ws + WS_S5G + ((size_t)layer * 64 + g) * s5::CG_BYTES : nullptr, F.in[I_LRE] + pg * 64, F.in[I_LIM] + pg * 64, expf(F.in[I_LSTEP][pg]),
                        F.in[I_BRE] + ((size_t)layer * 64 + g) * 1024, F.in[I_BIM] + ((size_t)layer * 64 + g) * 1024, F.in[I_CRE] + ((size_t)layer * 64 + g) * 1024, F.in[I_CIM] + ((size_t)layer * 64 + g) * 1024, F.lane); }
    if (F.bid == F.G - 1) {
        float2* tA = (float2*)(F.ws + WS_TAB); float2* tC = tA + 64 * 32;
        for (int i = F.tid; i < 64 * 32; i += NTHREADS) { const int pos = i >> 5, f = i & 31; const float a = (float)pos * expf(-(float)f * (9.210340371976184f / 32.0f)); float sn, cs; sincosf(a, &sn, &cs); tA[i] = make_float2(cs, sn); }
        for (int i = F.tid; i < 64 * 16; i += NTHREADS) { const int pos = i >> 4, f = i & 15; const float a = (float)pos * expf(-(float)f * (9.210340371976184f / 16.0f)); float sn, cs; sincosf(a, &sn, &cs); tC[i] = make_float2(cs, sn); }
    }
}
__device__ __forceinline__ void phase_norm(Frame& F, int layer, int which  , bool from_input) {
    float* X = (float*)(F.ws + WS_X); bf16* H = (bf16*)(F.ws + WS_H); const float* MOD = (const float*)(F.ws + WS_MOD) + (size_t)layer * 5 * 12288;
    const float* gw = F.in[which ? I_N2G : I_N1G] + layer * 2048;
    for (int m = F.gw; m < MROWS; m += F.NGW) {
        const float* src = from_input ? (m < MCTX ? F.in[I_XP] + (size_t)m * DM : F.in[I_XS] + (size_t)(m - MCTX) * DM) : X + (size_t)m * DM;
        const int mrow = m < MCTX ? 0 : 1 + ((m - MCTX) >> 11); const float* sh = MOD + mrow * 12288 + (which ? 3 : 0) * 2048; const float* scl = sh + 2048;
        f32x4 v[8]; float ss = 0.f;
#pragma unroll
        for (int j = 0; j < 8; ++j) { v[j] = *(const f32x4*)(src + 4 * F.lane + 256 * j); ss += v[j][0] * v[j][0] + v[j][1] * v[j][1] + v[j][2] * v[j][2] + v[j][3] * v[j][3]; }
        if (from_input) {
#pragma unroll
            for (int j = 0; j < 8; ++j) *(f32x4*)(X + (size_t)m * DM + 4 * F.lane + 256 * j) = v[j]; }
        const float rstd = rsqrtf(wave_sum(ss) * (1.0f / DM) + EPS);
#pragma unroll
        for (int j = 0; j < 8; ++j) { const int c = 4 * F.lane + 256 * j; const f32x4 g = *(const f32x4*)(gw + c), s1 = *(const f32x4*)(scl + c), s0 = *(const f32x4*)(sh + c);
            const f32x4 o = v[j] * rstd * g * (1.0f + s1) + s0; u32x2 w; w.x = pk2(o[0], o[1]); w.y = pk2(o[2], o[3]); *(u32x2*)(H + (size_t)m * DM + c) = w; }
    }
}
__device__ __forceinline__ void phase_final_norm(Frame& F) {
    const float* X = (const float*)(F.ws + WS_X); const float* gw = F.in[I_FING];
    for (int m = F.gw; m < MROWS; m += F.NGW) {
        f32x4 v[8]; float ss = 0.f;
#pragma unroll
        for (int j = 0; j < 8; ++j) { v[j] = *(const f32x4*)(X + (size_t)m * DM + 4 * F.lane + 256 * j); ss += v[j][0] * v[j][0] + v[j][1] * v[j][1] + v[j][2] * v[j][2] + v[j][3] * v[j][3]; }
        const float rstd = rsqrtf(wave_sum(ss) * (1.0f / DM) + EPS);
#pragma unroll
        for (int j = 0; j < 8; ++j) { const int c = 4 * F.lane + 256 * j; *(f32x4*)(F.out + O_YP + (size_t)m * DM + c) = v[j] * rstd * *(const f32x4*)(gw + c); }
    }
}
__device__ __forceinline__ void phase_prep(Frame& F, int layer) {
    const bf16* PROJ = (const bf16*)(F.ws + WS_PROJ);
    bf16* Q = (bf16*)(F.ws + WS_Q); bf16* KG = (bf16*)(F.ws + WS_KG); bf16* VG = (bf16*)(F.ws + WS_VG); bf16* AQ = (bf16*)(F.ws + WS_AQ); bf16* ACKV = (bf16*)(F.ws + WS_ACKV);
    bf16* KM = (bf16*)(F.ws + WS_KM); bf16* XBC = (bf16*)(F.ws + WS_XBC); float* DT = (float*)(F.ws + WS_DT);
    const float2* tA = (const float2*)(F.ws + WS_TAB); const float2* tC = tA + 64 * 32;
    const int lane = F.lane;
    for (int vr = F.gw; vr < KROWS; vr += F.NGW) {
        if (vr >= MROWS) {
            const int c = vr - MROWS, b = c >> 9, j = c & 511; const size_t kr = MCTX + (size_t)b * 2560 + 2048 + j; const size_t ci = ((size_t)b * 4 + layer) * 512 + j;
            { const f32x4 a = *(const f32x4*)(F.in[I_CGK] + ci * 256 + 4 * lane); u32x2 w; w.x = pk2(a[0], a[1]); w.y = pk2(a[2], a[3]); *(u32x2*)(KG + kr * 256 + 4 * lane) = w; }
            { const f32x4 a = *(const f32x4*)(F.in[I_CGV] + ci * 256 + 4 * lane); u32x2 w; w.x = pk2(a[0], a[1]); w.y = pk2(a[2], a[3]); *(u32x2*)(VG + kr * 256 + 4 * lane) = w; }
            { const f32x4 a = *(const f32x4*)(F.in[I_CCKV] + ci * 256 + 4 * lane); u32x2 w; w.x = pk2(a[0], a[1]); w.y = pk2(a[2], a[3]); *(u32x2*)(ACKV + kr * 256 + 4 * lane) = w; }
            { const bf16 kp = (bf16)f2bf(F.in[I_CKPE][ci * 64 + lane]);
#pragma unroll
              for (int hh = 0; hh < 8; ++hh) KM[kr * 1536 + hh * 192 + 128 + lane] = kp; }
            continue;
        }
        const int m = vr; const bool lat = m >= MCTX; const int bb = lat ? (m - MCTX) >> 11 : m >> 8; const int t = lat ? (m - MCTX) & 2047 : m & 255; const int L = lat ? 2048 : 256;
        const size_t kr = lat ? MCTX + (size_t)bb * 2560 + t : (size_t)m; const int rowpos = t >> 6, colpos = t & 63;
        const bf16* pr = PROJ + (size_t)m * NIN; const size_t orow = ((size_t)bb * 4 + layer) * 256 + t;
        const int j8 = lane & 7, ax = j8 >> 2, fo = (j8 & 3) * 8;
        const u32x4 ldq0 = *(const u32x4*)(pr + C_GQ + (lane >> 3) * 128 + ax * 64 + fo), ldq1 = *(const u32x4*)(pr + C_GQ + (lane >> 3) * 128 + ax * 64 + fo + 32);
        const u32x4 ldk0 = *(const u32x4*)(pr + C_GK + ((lane >> 3) & 1) * 128 + ax * 64 + fo), ldk1 = *(const u32x4*)(pr + C_GK + ((lane >> 3) & 1) * 128 + ax * 64 + fo + 32);
        const u32x4 ldv = *(const u32x4*)(pr + C_GV + 8 * (lane & 31));
        const u32x4 ldqd = *(const u32x4*)(pr + C_MQD + 8 * lane);
        const u32x4 ldck = *(const u32x4*)(pr + C_CKV + 8 * (lane & 31));
        const int axp = (lane >> 1) & 1, fop = (lane & 1) * 8;
        const u32x4 ldp0 = *(const u32x4*)(pr + C_KPE + axp * 32 + fop), ldp1 = *(const u32x4*)(pr + C_KPE + axp * 32 + fop + 16);
        u32x4 ldc[3][5];
#pragma unroll
        for (int i = 0; i < 3; ++i)
#pragma unroll
            for (int k = 0; k < 5; ++k) { const int tt = t + k - 2; const bool ok = tt >= 0 && tt < L; ldc[i][k] = *(const u32x4*)(pr + (ok ? (ptrdiff_t)(k - 2) * NIN : 0) + C_XBC + 8 * lane + 512 * i); if (!ok) ldc[i][k] = (u32x4){0u, 0u, 0u, 0u}; }
        const unsigned short lddt = pr[C_SDT + (lane & 31)];
        { const float2* tp = tA + (ax ? colpos : rowpos) * 32 + fo;
          { const int hq = lane >> 3; float x0[8], x1[8]; unpack8(ldq0, x0); unpack8(ldq1, x1);
            float ss = 0.f;
#pragma unroll
            for (int e = 0; e < 8; ++e) ss += x0[e] * x0[e] + x1[e] * x1[e];
            ss += __shfl_xor(ss, 1); ss += __shfl_xor(ss, 2); ss += __shfl_xor(ss, 4);
            const float rstd = rsqrtf(ss * (1.0f / 128.0f) + EPS); const float* gq = F.in[I_QNG] + layer * 128 + ax * 64 + fo;
#pragma unroll
            for (int e = 0; e < 8; ++e) { float a = x0[e] * rstd * gq[e], b = x1[e] * rstd * gq[32 + e]; if (lat) { const float2 cs = tp[e]; const float a2 = a * cs.x - b * cs.y; b = a * cs.y + b * cs.x; a = a2; } x0[e] = a; x1[e] = b; }
            bf16* q = Q + (size_t)m * 1024 + hq * 128 + ax * 64 + fo; *(u32x4*)q = pack8f(x0); *(u32x4*)(q + 32) = pack8f(x1); }
          { const int kh = (lane >> 3) & 1; float x0[8], x1[8]; unpack8(ldk0, x0); unpack8(ldk1, x1);
            float ss = 0.f;
#pragma unroll
            for (int e = 0; e < 8; ++e) ss += x0[e] * x0[e] + x1[e] * x1[e];
            ss += __shfl_xor(ss, 1); ss += __shfl_xor(ss, 2); ss += __shfl_xor(ss, 4);
            const float rstd = rsqrtf(ss * (1.0f / 128.0f) + EPS); const float* gk = F.in[I_KNG] + layer * 128 + ax * 64 + fo;
#pragma unroll
            for (int e = 0; e < 8; ++e) { x0[e] *= rstd * gk[e]; x1[e] *= rstd * gk[32 + e]; }
            if (lane < 16) {
            if (!lat) { float* o = F.out + O_GK + orow * 256 + kh * 128 + ax * 64 + fo; *(f32x4*)o = (f32x4){x0[0], x0[1], x0[2], x0[3]}; *(f32x4*)(o + 4) = (f32x4){x0[4], x0[5], x0[6], x0[7]};
                        *(f32x4*)(o + 32) = (f32x4){x1[0], x1[1], x1[2], x1[3]}; *(f32x4*)(o + 36) = (f32x4){x1[4], x1[5], x1[6], x1[7]}; }
            else {
#pragma unroll
                for (int e = 0; e < 8; ++e) { const float2 cs = tp[e]; const float a = x0[e], b = x1[e]; x0[e] = a * cs.x - b * cs.y; x1[e] = a * cs.y + b * cs.x; } }
            bf16* k = KG + kr * 256 + kh * 128 + ax * 64 + fo; *(u32x4*)k = pack8f(x0); *(u32x4*)(k + 32) = pack8f(x1); } }
          if (lane < 32) { *(u32x4*)(VG + kr * 256 + 8 * lane) = ldv;
            if (!lat) { float x[8]; unpack8(ldv, x); float* o = F.out + O_GV + orow * 256 + 8 * lane; *(f32x4*)o = (f32x4){x[0], x[1], x[2], x[3]}; *(f32x4*)(o + 4) = (f32x4){x[4], x[5], x[6], x[7]}; } }
        }
        { float x[8]; unpack8(ldqd, x); float ss = 0.f;
#pragma unroll
          for (int e = 0; e < 8; ++e) ss += x[e] * x[e];
          const float rstd = rsqrtf(wave_sum(ss) * (1.0f / 512.0f) + EPS); const float* g = F.in[I_MQNG] + layer * 512 + 8 * lane;
#pragma unroll
          for (int e = 0; e < 8; ++e) x[e] *= rstd * g[e];
          *(u32x4*)(AQ + (size_t)m * 512 + 8 * lane) = pack8f(x); }
        { float x[8]; float ss = 0.f; unpack8(ldck, x);
          if (lane < 32) {
#pragma unroll
            for (int e = 0; e < 8; ++e) ss += x[e] * x[e]; }
          ss = wave_sum(ss);
          if (lane < 32) { const float rstd = rsqrtf(ss * (1.0f / 256.0f) + EPS); const float* g = F.in[I_MKVNG] + layer * 256 + 8 * lane;
#pragma unroll
            for (int e = 0; e < 8; ++e) x[e] *= rstd * g[e];
            *(u32x4*)(ACKV + kr * 256 + 8 * lane) = pack8f(x);
            if (!lat) { float* o = F.out + O_CKV + orow * 256 + 8 * lane; *(f32x4*)o = (f32x4){x[0], x[1], x[2], x[3]}; *(f32x4*)(o + 4) = (f32x4){x[4], x[5], x[6], x[7]}; } }
          if (lane < 4) { float x0[8], x1[8]; unpack8(ldp0, x0); unpack8(ldp1, x1);
            if (!lat) { float* o = F.out + O_KPE + orow * 64 + axp * 32 + fop; *(f32x4*)o = (f32x4){x0[0], x0[1], x0[2], x0[3]}; *(f32x4*)(o + 4) = (f32x4){x0[4], x0[5], x0[6], x0[7]};
                        *(f32x4*)(o + 16) = (f32x4){x1[0], x1[1], x1[2], x1[3]}; *(f32x4*)(o + 20) = (f32x4){x1[4], x1[5], x1[6], x1[7]}; }
            else { const float2* tp = tC + (axp ? colpos : rowpos) * 16 + fop;
#pragma unroll
                for (int e = 0; e < 8; ++e) { const float2 cs = tp[e]; const float a = x0[e], b = x1[e]; x0[e] = a * cs.x - b * cs.y; x1[e] = a * cs.y + b * cs.x; } }
            const u32x4 w0 = pack8f(x0), w1 = pack8f(x1);
#pragma unroll
            for (int hh = 0; hh < 8; ++hh) { bf16* k = KM + kr * 1536 + hh * 192 + 128 + axp * 32 + fop; *(u32x4*)k = w0; *(u32x4*)(k + 16) = w1; } }
        }
        { const float* cw = F.in[I_CONVW] + (size_t)layer * 5 * 1536; const float* cb = F.in[I_CONVB] + layer * 1536;
#pragma unroll
          for (int i = 0; i < 3; ++i) { const int ch = 8 * lane + 512 * i; float acc[8];
            { const f32x4 b0 = *(const f32x4*)(cb + ch), b1 = *(const f32x4*)(cb + ch + 4); acc[0] = b0[0]; acc[1] = b0[1]; acc[2] = b0[2]; acc[3] = b0[3]; acc[4] = b1[0]; acc[5] = b1[1]; acc[6] = b1[2]; acc[7] = b1[3]; }
#pragma unroll
            for (int k = 0; k < 5; ++k) { float x[8]; unpack8(ldc[i][k], x);
                const f32x4 w0 = *(const f32x4*)(cw + k * 1536 + ch), w1 = *(const f32x4*)(cw + k * 1536 + ch + 4);
                acc[0] += w0[0] * x[0]; acc[1] += w0[1] * x[1]; acc[2] += w0[2] * x[2]; acc[3] += w0[3] * x[3]; acc[4] += w1[0] * x[4]; acc[5] += w1[1] * x[5]; acc[6] += w1[2] * x[6]; acc[7] += w1[3] * x[7]; }
#pragma unroll
            for (int e = 0; e < 8; ++e) acc[e] = acc[e] * sigm(acc[e]);
            *(u32x4*)(XBC + (size_t)m * 1536 + ch) = pack8f(acc); }
          if (lane < 32) { const float raw = __uint_as_float((unsigned)lddt << 16) + F.in[I_DTB][layer * 32 + lane]; const float ey = __expf(raw); DT[(size_t)m * 32 + lane] = raw > 20.f ? raw : (ey < 1e-3f ? ey * (1.0f - 0.5f * ey) : __logf(1.0f + ey)); }
        }
    }
    { LAS unsigned char* wl = F.lds + F.wave * s5::WAVE_LDS; float* S5E = (float*)(F.ws + WS_S5E);
      for (int e = F.gw; e < 4096; e += F.NGW) { const int b = e >> 10, seg = (e >> 7) & 7, g = (e >> 1) & 63, dir = e & 1;
        s5::Ctx c; s5::load_ctx(c, F.ws + WS_S5C + (size_t)((layer * 2 + dir) * 64 + g) * s5::CD_BYTES, nullptr, lane, false);
        float hr = 0.f, hi = 0.f;
        s5::s5_epass(c, wl, lane, dir, PROJ + (size_t)(MCTX + b * 2048 + seg * 256) * NIN + C_S5U + g * 16, NIN, hr, hi);
        float* eo = S5E + ((((size_t)b * 8 + seg) * 64 + g) * 2 + dir) * 128; eo[lane] = hr; eo[64 + lane] = hi; } }
}
__device__ __forceinline__ void phase_ssd_finish(Frame& F, int layer) {
    const bf16* PROJ = (const bf16*)(F.ws + WS_PROJ); const bf16* XBC = (const bf16*)(F.ws + WS_XBC); const bf16* YF = (const bf16*)(F.ws + WS_YF); const bf16* YB = (const bf16*)(F.ws + WS_YB);
    bf16* OB = (bf16*)(F.ws + WS_O) + (size_t)1 * MROWS * 1024; const int lane = F.lane;
    const float dh = F.in[I_SSDD][layer * 16 + (lane >> 2)]; const float* g = F.in[I_SSDNG] + layer * 1024 + 16 * lane;
    for (int m = F.gw; m < MROWS; m += F.NGW) {
        float x[16], z[16], y[16]; unpack8(*(const u32x4*)(XBC + (size_t)m * 1536 + 16 * lane), x); unpack8(*(const u32x4*)(XBC + (size_t)m * 1536 + 16 * lane + 8), x + 8);
        unpack8(*(const u32x4*)(PROJ + (size_t)m * NIN + C_SZ + 16 * lane), z); unpack8(*(const u32x4*)(PROJ + (size_t)m * NIN + C_SZ + 16 * lane + 8), z + 8);
        float ss = 0.f; float yf[16], yb[16];
        unpack8(*(const u32x4*)(YF + (size_t)m * 1024 + 16 * lane), yf); unpack8(*(const u32x4*)(YF + (size_t)m * 1024 + 16 * lane + 8), yf + 8);
        unpack8(*(const u32x4*)(YB + (size_t)m * 1024 + 16 * lane), yb); unpack8(*(const u32x4*)(YB + (size_t)m * 1024 + 16 * lane + 8), yb + 8);
#pragma unroll
        for (int i = 0; i < 16; ++i) { const float v = (yf[i] + yb[i] + dh * x[i]) * (z[i] * sigm(z[i])); y[i] = v; ss += v * v; }
        const float rstd = rsqrtf(wave_sum(ss) * (1.0f / 1024.0f) + EPS);
#pragma unroll
        for (int i = 0; i < 16; ++i) y[i] *= rstd * g[i];
        *(u32x4*)(OB + (size_t)m * 1024 + 16 * lane) = pack8f(y); *(u32x4*)(OB + (size_t)m * 1024 + 16 * lane + 8) = pack8f(y + 8);
    }
}
struct ConvItem { const float* src; bf16* dst; int K, N, mode, half, k0, n0; };
__device__ __forceinline__ void conv_load(const ConvItem& c, int lane, float (&w)[32]) {
    const int n = c.n0 + lane; const float* p = c.src + (size_t)c.k0 * c.N + (n < c.N ? n : c.N - 1);
#pragma unroll
    for (int i = 0; i < 32; ++i) w[i] = p[(size_t)i * c.N];
}
__device__ __forceinline__ void conv_store(const ConvItem& c, int lane, const float (&w)[32]) {
    const int n = c.n0 + lane;
    if (n < c.N) { const int row = c.mode == 0 ? n : (c.mode == 1 ? map_in(n) : map_pair(n, c.half)); bf16* d = c.dst + (size_t)row * c.K + c.k0;
#pragma unroll
        for (int j = 0; j < 4; ++j) { u32x4 o; o.x = pk2(w[8 * j], w[8 * j + 1]); o.y = pk2(w[8 * j + 2], w[8 * j + 3]); o.z = pk2(w[8 * j + 4], w[8 * j + 5]); o.w = pk2(w[8 * j + 6], w[8 * j + 7]); *(u32x4*)(d + 8 * j) = o; } }
}
constexpr int CV_A0 = 64 * 176, CV_A1 = CV_A0 + 176 * 32, CV_A2 = CV_A1 + 64 * 32, CV_A3 = CV_A2 + 4 * 32 * 32, CV_A4 = CV_A3 + 32 * 32;
constexpr int CV_B0 = 64 * 222, CV_B1 = CV_B0 + 16 * 24, CV_B2 = CV_B1 + 8 * 32;
__device__ __forceinline__ ConvItem conv_decode(int set, int it, int layer, const float* const* in, unsigned char* ws) {
    ConvItem c; char* WB = (char*)(ws + WS_W);
    if (set == 0) {
        if (it < CV_A0) { c.src = in[I_WFI] + (size_t)layer * 2048 * 11264; c.dst = (bf16*)(WB + W_FI); c.K = 2048; c.N = 11264; c.mode = 2; c.half = 5632; c.k0 = 32 * (it / 176); c.n0 = 64 * (it % 176); }
        else if (it < CV_A1) { const int r = it - CV_A0; c.src = in[I_WFO] + (size_t)layer * 5632 * 2048; c.dst = (bf16*)(WB + W_FO); c.K = 5632; c.N = 2048; c.mode = 0; c.half = 0; c.k0 = 32 * (r / 32); c.n0 = 64 * (r % 32); }
        else if (it < CV_A2) { const int r = it - CV_A1; c.src = in[I_WOUT] + (size_t)layer * 2048 * 2048; c.dst = (bf16*)(WB + W_OUT); c.K = 2048; c.N = 2048; c.mode = 0; c.half = 0; c.k0 = 32 * (r / 32); c.n0 = 64 * (r % 32); }
        else if (it < CV_A3) { const int r = it - CV_A2, br = r >> 10, q = r & 1023; c.src = in[I_WBR] + ((size_t)layer * 4 + br) * 1024 * 2048; c.dst = (bf16*)(WB + W_BR) + (size_t)br * 2048 * 1024; c.K = 1024; c.N = 2048; c.mode = 0; c.half = 0; c.k0 = 32 * (q / 32); c.n0 = 64 * (q % 32); }
        else { const int r = it - CV_A3; c.src = in[I_WGLU] + (size_t)layer * 1024 * 2048; c.dst = (bf16*)(WB + W_GLU); c.K = 1024; c.N = 2048; c.mode = 2; c.half = 1024; c.k0 = 32 * (r / 32); c.n0 = 64 * (r % 32); }
    } else {
        if (it < CV_B0) { c.src = in[I_WIN] + (size_t)layer * 2048 * 14176; c.dst = (bf16*)(WB + W_IN); c.K = 2048; c.N = 14176; c.mode = 1; c.half = 0; c.k0 = 32 * (it / 222); c.n0 = 64 * (it % 222); }
        else if (it < CV_B1) { const int r = it - CV_B0; c.src = in[I_WUQ] + (size_t)layer * 512 * 1536; c.dst = (bf16*)(WB + W_UQ); c.K = 512; c.N = 1536; c.mode = 0; c.half = 0; c.k0 = 32 * (r / 24); c.n0 = 64 * (r % 24); }
        else { const int r = it - CV_B1; c.src = in[I_WUKV] + (size_t)layer * 256 * 2048; c.dst = (bf16*)(WB + W_UKV); c.K = 256; c.N = 2048; c.mode = 0; c.half = 0; c.k0 = 32 * (r / 32); c.n0 = 64 * (r % 32); }
    }
    return c;
}
__device__ __forceinline__ void conv_run(int set, int layer, int first, int stride, const float* const* in, unsigned char* ws, int lane) {
    const int total = set == 0 ? CV_A4 : CV_B2;
    for (int it = first; it < total; it += stride) { const ConvItem c = conv_decode(set, it, layer, in, ws); float w[32]; conv_load(c, lane, w); conv_store(c, lane, w); }
}
struct AttnConv {
    const float* const* in; unsigned char* ws; int layer, gw, NGW, total, cnt, lane;
    ConvItem c; bool on;
    __device__ __forceinline__ void begin(float (&w)[32]) {
        const int it = cnt * NGW + gw; on = it < total;
        if (on) { ++cnt; c = it < CV_A4 ? conv_decode(0, it, layer, in, ws) : conv_decode(1, it - CV_A4, layer + 1, in, ws); conv_load(c, lane, w); }
    }
    __device__ __forceinline__ void end(const float (&w)[32]) { if (on) { conv_store(c, lane, w); on = false; } }
    __device__ __forceinline__ bool pending() const { return on; }
    __device__ __forceinline__ void finish() { for (int it = cnt * NGW + gw; it < total; it += NGW) { const ConvItem ci = it < CV_A4 ? conv_decode(0, it, layer, in, ws) : conv_decode(1, it - CV_A4, layer + 1, in, ws); float w[32]; conv_load(ci, lane, w); conv_store(ci, lane, w); } }
};
struct NoConv { __device__ __forceinline__ void begin(float (&)[32]) {} __device__ __forceinline__ void end(const float (&)[32]) {} __device__ __forceinline__ bool pending() const { return false; } };
template <class Epi> struct EpiConv {
    static constexpr bool PERM = Epi::PERM, AFTER_DRAIN = false;
    Epi e; const float* const* in; unsigned char* ws; int layer, set, gw, NGW, total, first; mutable int cnt;
    __device__ __forceinline__ bool keep(const pg8::Unit& u) const { return e.keep(u); }
    template <class ACC> __device__ __forceinline__ void operator()(ACC& acc, const pg8::Unit& u, int wr, int wc, int fr, int fq) const {
        const int it = first + cnt * NGW + gw; ++cnt; const bool on = it < total; const int lane = threadIdx.x & 63;
        ConvItem c; float w[32];
        if (on) { c = conv_decode(set, it, layer, in, ws); conv_load(c, lane, w); }
        e(acc, u, wr, wc, fr, fq);
        if (on) conv_store(c, lane, w);
    }
};
#define XB_TMO      128
#define XB_XCNT(j)  (256  + 64 * (j))
#define XB_XSUB(j)  (1280 + 64 * (j))
#define XB_XGEN(j)  (2304 + 64 * (j))
#define XB_TOP      3328
#define XB_TOPGEN   3392
#define XCD_BAR_WORDS 3456
#define XB_SPIN_CAP (1u << 18)

__device__ __forceinline__ unsigned xb_ld(unsigned* p)              { return __hip_atomic_load(p, __ATOMIC_RELAXED, __HIP_MEMORY_SCOPE_AGENT); }
__device__ __forceinline__ unsigned xb_add(unsigned* p, unsigned v) { return __hip_atomic_fetch_add(p, v, __ATOMIC_RELAXED, __HIP_MEMORY_SCOPE_AGENT); }
__device__ __forceinline__ unsigned xb_xcc_id() { return (unsigned)__builtin_amdgcn_s_getreg((3 << 11) | 20) & 0xFu; }
#define XB_SPIN(cond, bar) do { unsigned _sp = 0; while (cond) { __builtin_amdgcn_s_sleep(1); \
    if ((++_sp & 255u) == 0u) { if (xb_ld(&(bar)[XB_TMO])) break; if (_sp > XB_SPIN_CAP) { atomicAdd(&(bar)[XB_TMO], 1u); break; } } } } while (0)

struct XcdBarrier {
    unsigned* bar; unsigned x;
    volatile LAS unsigned* st;
};

__device__ __forceinline__ XcdBarrier xcd_barrier_post(unsigned* bar, volatile LAS unsigned* st) {
    XcdBarrier b; b.bar = bar; b.x = xb_xcc_id(); b.st = st;
    if (threadIdx.x == 0) (void)xb_add(&bar[XB_XCNT(b.x)], 1u);
    return b;
}
__device__ __forceinline__ void xcd_barrier_complete(unsigned* bar, unsigned x, unsigned& nloc, unsigned& nx) {
    const unsigned G = gridDim.x * gridDim.y * gridDim.z;
    unsigned sum, cnt, mine, sp = 0u;
    for (;;) {
        sum = 0u; cnt = 0u; mine = 0u;
#pragma unroll
        for (unsigned j = 0; j < 16; ++j) { const unsigned c = xb_ld(&bar[XB_XCNT(j)]); sum += c; cnt += (c > 0u) ? 1u : 0u; mine = (j == x) ? c : mine; }
        if (sum == G) break;
        __builtin_amdgcn_s_sleep(1);
        if ((++sp & 255u) == 0u) { if (xb_ld(&bar[XB_TMO])) break; if (sp > XB_SPIN_CAP) { atomicAdd(&bar[XB_TMO], 1u); break; } }
    }
    nloc = mine > 0u ? mine : 1u; nx = cnt > 0u ? cnt : 1u;
}

__device__ __forceinline__ void xcd_barrier(const XcdBarrier& b) {
    asm volatile("s_waitcnt vmcnt(0)" ::: "memory");
    __syncthreads();
    if (threadIdx.x == 0) {
        unsigned* bar = b.bar;
        __builtin_amdgcn_s_waitcnt(0);
        unsigned nloc = b.st[0], nx = b.st[1];
        if (nloc == 0u) { xcd_barrier_complete(bar, b.x, nloc, nx); b.st[0] = nloc; b.st[1] = nx; }
        const unsigned old = xb_add(&bar[XB_XSUB(b.x)], 1u);
        const unsigned gen = old / nloc;
        if (old + 1u == (gen + 1u) * nloc) {
            __builtin_amdgcn_fence(__ATOMIC_RELEASE, "agent");
            asm volatile("s_waitcnt vmcnt(0)" ::: "memory");
            const unsigned og = xb_add(&bar[XB_TOP], 1u);
            const unsigned tg = og / nx;
            if (og + 1u == (tg + 1u) * nx) xb_add(&bar[XB_TOPGEN], 1u);
            else XB_SPIN(xb_ld(&bar[XB_TOPGEN]) == tg, bar);
            __builtin_amdgcn_fence(__ATOMIC_ACQUIRE, "agent");
            xb_add(&bar[XB_XGEN(b.x)], 1u);
            asm volatile("s_waitcnt vmcnt(0)" ::: "memory");
        } else {
            XB_SPIN(xb_ld(&bar[XB_XGEN(b.x)]) == gen, bar);
            __builtin_amdgcn_fence(__ATOMIC_ACQUIRE, "agent");
            asm volatile("s_waitcnt vmcnt(0)" ::: "memory");
        }
    }
    __syncthreads();
}
#ifndef MLA_SDEPTH
#define MLA_SDEPTH 1
#endif
constexpr int NPHASE = 42;
#ifndef MK_N_LAUNCHES
#define MK_N_LAUNCHES 1
#endif
__device__ __forceinline__ void run_attn_gqa(Frame& F, int layer) {
    AttnConv cv; cv.in = F.in; cv.ws = F.ws; cv.layer = layer; cv.gw = F.gw; cv.NGW = F.NGW; cv.total = CV_A4 + (layer + 1 < NLAYER ? CV_B0 : 0); cv.cnt = 0; cv.lane = F.lane; cv.on = false;
    const bf16* Q = (const bf16*)(F.ws + WS_Q); const bf16* KG = (const bf16*)(F.ws + WS_KG); const bf16* VG = (const bf16*)(F.ws + WS_VG); bf16* OA = (bf16*)(F.ws + WS_O);
    for (int u = F.bid; u < 512; u += F.G) {
        size_t qrow, krow; int hq, seq;
        if (u < 256) { const int b = u >> 6, qb = u & 7; hq = (u >> 3) & 7; qrow = MCTX + (size_t)b * 2048 + qb * 256; krow = MCTX + (size_t)b * 2560; seq = 2560; }
        else { const int v = u - 256, b = v >> 3; hq = v & 7; qrow = (size_t)b * 256; krow = qrow; seq = 256; }
        att::attn_body_simple<128, 1024, 256, 256, 1024>(Q + qrow * 1024 + hq * 128, KG + krow * 256 + (hq >> 2) * 128, VG + krow * 256 + (hq >> 2) * 128, OA + qrow * 1024 + hq * 128, seq, (char*)F.lds, cv);
    }
    cv.finish();
}
__device__ __forceinline__ void run_attn_mla(Frame& F) {
    const bf16* QM = (const bf16*)(F.ws + WS_QM); const bf16* KM = (const bf16*)(F.ws + WS_KM); const bf16* VM = (const bf16*)(F.ws + WS_VM); bf16* OC = (bf16*)(F.ws + WS_O) + (size_t)2 * MROWS * 1024;
    for (int u = F.bid; u < 512; u += F.G) {
        size_t qrow, krow; int hq, seq;
        if (u < 256) { const int b = u >> 6, qb = u & 7; hq = (u >> 3) & 7; qrow = MCTX + (size_t)b * 2048 + qb * 256; krow = MCTX + (size_t)b * 2560; seq = 2560; }
        else { const int v = u - 256, b = v >> 3; hq = v & 7; qrow = (size_t)b * 256; krow = qrow; seq = 256; }
        NoConv nc; att::attn_body_simple<192, 1536, 1536, 1024, 1024>(QM + qrow * 1536 + hq * 192, KM + krow * 1536 + hq * 192, VM + krow * 1024 + hq * 128, OC + qrow * 1024 + hq * 128, seq, (char*)F.lds, nc);
    }
}
__device__ __forceinline__ void run_ssd(Frame& F, int layer) {
    const bf16* XBC = (const bf16*)(F.ws + WS_XBC); const float* DT = (const float*)(F.ws + WS_DT); bf16* YF = (bf16*)(F.ws + WS_YF); bf16* YB = (bf16*)(F.ws + WS_YB);
    for (int u = F.bid; u < 128; u += F.G) { const int b = u >> 5, h = (u >> 1) & 15, dir = u & 1;
        const float a_h = -expf(F.in[I_ALOG][(layer * 2 + dir) * 16 + h]);
        ssd::ssd_unit(F.lds, XBC, DT, dir ? YB : YF, MCTX + b * 2048, 16, h, dir, a_h, F.in[I_SSSD] + ((((size_t)b * 4 + layer) * 2 + dir) * 16 + h) * 8192, nullptr); }
    const int c0 = F.G > 128 ? F.bid - 128 : F.bid, cs = F.G > 128 ? F.G - 128 : F.G;
    if (c0 >= 0) for (int v = c0; v < 1024; v += cs) { const int b = v >> 5, h = (v >> 1) & 15, dir = v & 1;
        const float a_h = -expf(F.in[I_ALOG][(layer * 2 + dir) * 16 + h]);
        ssd::ssd_unit(F.lds, XBC, DT, dir ? YB : YF, b * 256, 2, h, dir, a_h, nullptr, F.out + O_SSD + ((((size_t)b * 4 + layer) * 2 + dir) * 16 + h) * 8192); }
}
__device__ __forceinline__ void s5_entry_state(Frame& F, const unsigned char* cd, const float* S5E, int b, int seg, int g, int layer, int dir, int lane, float& hr, float& hi) {
    const float* h0 = F.in[I_SS5] + ((((size_t)b * 4 + layer) * 2 + dir) * 2) * 4096 + g * 64; hr = h0[lane]; hi = h0[4096 + lane];
    const float zr = ((const float*)cd)[128 + lane], zi = ((const float*)cd)[192 + lane];
    const int n = dir ? 7 - seg : seg;
    float er[7], ei[7];
#pragma unroll
    for (int q = 0; q < 7; ++q) { const int qq = q < n ? q : 0; const int sp = dir ? 7 - qq : qq; const float* e = S5E + ((((size_t)b * 8 + sp) * 64 + g) * 2 + dir) * 128; er[q] = e[lane]; ei[q] = e[64 + lane]; }
#pragma unroll
    for (int q = 0; q < 7; ++q) { const float nr = zr * hr - zi * hi + er[q], ni = zr * hi + zi * hr + ei[q]; if (q < n) { hr = nr; hi = ni; } }
}
__device__ __forceinline__ void run_s5(Frame& F, int layer) {
    const bf16* PROJ = (const bf16*)(F.ws + WS_PROJ); bf16* S5PRE = (bf16*)(F.ws + WS_S5PRE); const float* S5E = (const float*)(F.ws + WS_S5E);
    LAS unsigned char* wl = F.lds + F.wave * s5::WAVE_LDS;
    for (int u = F.gw; u < 4096; u += F.NGW) {
        int lane_ = F.lane; asm volatile("" : "+v"(lane_)); const int lane = lane_;
        const int s = u >> 6, g = u & 63; const bool lat = s >= 32; const int b = lat ? (s - 32) >> 3 : s, seg = lat ? (s - 32) & 7 : 0;
        const size_t row0 = lat ? MCTX + (size_t)b * 2048 + seg * 256 : (size_t)b * 256;
        const unsigned char* cd0 = F.ws + WS_S5C + (size_t)((layer * 2 + 0) * 64 + g) * s5::CD_BYTES; const unsigned char* cd1 = cd0 + 64 * s5::CD_BYTES; const unsigned char* cg = F.ws + WS_S5G + ((size_t)layer * 64 + g) * s5::CG_BYTES;
        const bf16* U = PROJ + row0 * NIN + C_S5U + g * 16; bf16* outp = S5PRE + row0 * 1024 + g * 16;
        const float dch = F.in[I_S5D][layer * 1024 + g * 16 + (lane & 15)];
        s5::Ctx c;
        float hfr = 0.f, hfi = 0.f, hbr = 0.f, hbi = 0.f;
        if (lat) { s5_entry_state(F, cd0, S5E, b, seg, g, layer, 0, lane, hfr, hfi); s5_entry_state(F, cd1, S5E, b, seg, g, layer, 1, lane, hbr, hbi); }
        { s5::load_ctx(c, cd0, cg, lane, true);
          s5::s5_pass<false>(c, wl, lane, 0, U, NIN, outp, dch, hfr, hfi);
          if (!lat) { float* ho = F.out + O_S5 + ((((size_t)b * 4 + layer) * 2 + 0) * 2) * 4096 + g * 64; ho[lane] = hfr; ho[4096 + lane] = hfi; } }
        { s5::load_ctx(c, cd1, cg, lane, false);
          s5::s5_pass<true>(c, wl, lane, 1, U, NIN, outp, dch, hbr, hbi);
          if (!lat) { float* ho = F.out + O_S5 + ((((size_t)b * 4 + layer) * 2 + 1) * 2) * 4096 + g * 64; ho[lane] = hbr; ho[4096 + lane] = hbi; } }
    }
}
__device__ __forceinline__ bool launder(Frame& F) {
    asm volatile("" : "+v"(F.tid), "+v"(F.lane)); return true; }
__global__ void __launch_bounds__(NTHREADS, 2) skel_fwd(Args args) {
    extern __shared__ __attribute__((aligned(16))) unsigned char lds_raw[];
    Frame F;
    F.lds = (LAS unsigned char*)lds_raw;
    F.tid = threadIdx.x; F.lane = F.tid & 63; F.wave = __builtin_amdgcn_readfirstlane(F.tid >> 6);
    F.G = gridDim.x; F.bid = blockIdx.x; F.gw = F.bid * NWAVES + F.wave; F.NGW = F.G * NWAVES;
    F.in0 = args.in; F.out0 = args.out; F.ws0 = args.ws; F.in = F.in0; F.out = F.out0; F.ws = F.ws0;
    for (int u = F.tid; u < (LDS_BYTES - LDSCTL_OFF) / 4; u += NTHREADS) ((LAS unsigned*)(F.lds + LDSCTL_OFF))[u] = 0u;
    __syncthreads();
    const int lo = args.ph_lo, hi = args.ph_hi;
    unsigned* barw = (unsigned*)(F.ws + WS_CTL) + CW_BAR + args.li * XCD_BAR_WORDS;
    XcdBarrier bar; bar.bar = barw; bar.x = 0; bar.st = nullptr;
    if (hi - lo > 1) bar = xcd_barrier_post(barw, (volatile LAS unsigned*)(F.lds + MISC_OFF) + 8);
#ifndef SUB_MASK
#define SUB_MASK 0xffu
#endif
#define SUBON(b) (((SUB_MASK) >> (b)) & 1u)
#ifndef REP_MASK
#define REP_MASK 0u
#endif
#define REP(b) for (int rep_ = 0; rep_ < 1 + (int)(((REP_MASK) >> (b)) & 1u); ++rep_)
#ifndef PH_MASK
#define PH_MASK 0xffffffffu
#endif
#define IN(k) (lo <= (k) && (k) < hi)
#define INJ(j) ((((PH_MASK) >> (j)) & 1u) && IN(pb + (j)) && launder(F))
#define SEAM(k) do { if (IN(k) && IN((k) + 1)) xcd_barrier(bar); } while (0)
    bf16* WB = (bf16*)(F.ws + WS_W);
    bf16* const Win = (bf16*)((char*)WB + W_IN); bf16* const Wuq = (bf16*)((char*)WB + W_UQ); bf16* const Wukv = (bf16*)((char*)WB + W_UKV); bf16* const Wglu = (bf16*)((char*)WB + W_GLU);
    bf16* const Wbr = (bf16*)((char*)WB + W_BR); bf16* const Wout = (bf16*)((char*)WB + W_OUT); bf16* const Wfi = (bf16*)((char*)WB + W_FI); bf16* const Wfo = (bf16*)((char*)WB + W_FO);
    bf16* const H = (bf16*)(F.ws + WS_H); bf16* const PROJ = (bf16*)(F.ws + WS_PROJ); float* const X = (float*)(F.ws + WS_X);

    if (((PH_MASK >> 11) & 1u) && IN(0)) { phase_prologue(F); conv_run(1, 0, F.gw, F.NGW, F.in, F.ws, F.lane); phase_zero_pad(F); } SEAM(0);
    for (int layer = 0; layer < NLAYER; ++layer) {
        const int pb = 1 + 10 * layer; const float* MODL = (const float*)(F.ws + WS_MOD) + (size_t)layer * 5 * 12288;
        if (INJ(0)) { REP(9) phase_norm(F, layer, 0, layer == 0); } SEAM(pb + 0);
        if (INJ(1)) { pg8::Gemm g{H, Win, MROWS, NIN, 2048}; pg8::StaticOrder S; S.init(MROWS, NIN, F.G, F.bid);
            pg8::EpiInProj E{PROJ, NIN, 32};
            pg8::gemm_phase<pg8::EpiInProj, pg8::StaticOrder, true, true>(F.lds, g, S, E); } SEAM(pb + 1);
        if (INJ(2)) { REP(10) phase_prep(F, layer); } SEAM(pb + 2);
        if (INJ(3)) {
            if (SUBON(0)) { pg8::Gemm g{(bf16*)(F.ws + WS_AQ), Wuq, MROWS, 1536, 512}; pg8::StaticOrder S; S.init(MROWS, 1536, F.G, F.bid); pg8::EpiMlaQ E{(bf16*)(F.ws + WS_QM), (const float2*)(F.ws + WS_TAB) + 64 * 32};
              REP(15) pg8::gemm_phase<pg8::EpiMlaQ, pg8::StaticOrder, true, true>(F.lds, g, S, E); }
            if (SUBON(1)) { pg8::Gemm g{(bf16*)(F.ws + WS_ACKV), Wukv, KROWS, 2048, 256}; pg8::StaticOrder S; S.init(KROWS, 2048, F.G, (F.bid + (F.G >> 2)) % F.G  ); pg8::EpiMlaKV E{(bf16*)(F.ws + WS_KM), (bf16*)(F.ws + WS_VM)};
              REP(15) pg8::gemm_phase<pg8::EpiMlaKV, pg8::StaticOrder, true, true>(F.lds, g, S, E); }
            if (SUBON(2)) run_attn_gqa(F, layer);
            if (SUBON(3)) REP(3) run_ssd(F, layer);
            if (SUBON(4)) REP(4) run_s5(F, layer);
        } SEAM(pb + 3);
        if (INJ(4)) { if (SUBON(5)) REP(5) run_attn_mla(F); if (SUBON(6)) REP(6) phase_ssd_finish(F, layer);
            { pg8::Gemm g{(bf16*)(F.ws + WS_S5PRE), Wglu, MROWS, 2048, 1024}; pg8::StaticOrder S; S.init(MROWS, 2048, F.G, F.bid); pg8::EpiGated<0> E{(bf16*)(F.ws + WS_O) + (size_t)3 * MROWS * 1024, 1024};
              REP(15) pg8::gemm_phase<pg8::EpiGated<0>, pg8::StaticOrder, true, true>(F.lds, g, S, E); } } SEAM(pb + 4);
        if (INJ(5)) { pg8::Gemm g{(bf16*)(F.ws + WS_O), Wbr, 4 * MROWS, 4 * 2048, 1024}; pg8::BranchOrder S; S.so.init(MROWS, 2048, F.G, F.bid); pg8::EpiBranch E{PROJ, NIN, (bf16*)(F.ws + WS_GS)};
            REP(13) pg8::gemm_phase<pg8::EpiBranch, pg8::BranchOrder, true, true>(F.lds, g, S, E); } SEAM(pb + 5);
        if (INJ(6)) { pg8::Gemm g{(bf16*)(F.ws + WS_GS), Wout, MROWS, 2048, 2048}; pg8::StaticOrder S; S.init(MROWS, 2048, F.G, F.bid); pg8::EpiResid E{X, MODL, 4096, 1.0f};
            if ((REP_MASK >> 14) & 1u) { pg8::EpiResid E0{X, MODL, 4096, 0.0f}; pg8::gemm_phase<pg8::EpiResid, pg8::StaticOrder, true, true>(F.lds, g, S, E0); }
            pg8::gemm_phase<pg8::EpiResid, pg8::StaticOrder, true, true>(F.lds, g, S, E); } SEAM(pb + 6);
        if (INJ(7)) { REP(9) phase_norm(F, layer, 1, false); } SEAM(pb + 7);
        if (INJ(8)) { pg8::Gemm g{H, Wfi, MROWS, 11264, 2048}; pg8::StaticOrder S; S.init(MROWS, 11264, F.G, F.bid);
            EpiConv<pg8::EpiGated<1>> E{pg8::EpiGated<1>{PROJ  , FFN}, F.in, F.ws, layer + 1, 1, F.gw, F.NGW, layer + 1 < NLAYER ? CV_B2 : 0, CV_B0, 0};
            pg8::gemm_phase<EpiConv<pg8::EpiGated<1>>, pg8::StaticOrder, true, true>(F.lds, g, S, E);
            if (layer + 1 < NLAYER) conv_run(1, layer + 1, CV_B0 + E.cnt * F.NGW + F.gw, F.NGW, F.in, F.ws, F.lane); } SEAM(pb + 8);
        if (INJ(9)) { pg8::Gemm g{PROJ, Wfo, MROWS, 2048, FFN}; pg8::StaticOrder S; S.init(MROWS, 2048, F.G, F.bid); pg8::EpiResid E{X, MODL, 10240, 1.0f};
            if ((REP_MASK >> 14) & 1u) { pg8::EpiResid E0{X, MODL, 10240, 0.0f}; pg8::gemm_phase<pg8::EpiResid, pg8::StaticOrder, true, true>(F.lds, g, S, E0); }
            pg8::gemm_phase<pg8::EpiResid, pg8::StaticOrder, true, true>(F.lds, g, S, E); } SEAM(pb + 9);
    }
    if (((PH_MASK >> 12) & 1u) && IN(41)) phase_final_norm(F);
#undef IN
#undef INJ
#undef SEAM
}

extern "C" void kernel_launch(void* const* d_in, const int* in_sizes, int n_in, void* d_out, int out_size, void* d_ws, size_t ws_size, hipStream_t stream) {
    static int grid = 0;
    if (grid == 0) {
        if (n_in != 41 || out_size != (int)O_TOTAL || ws_size < WS_END) { fprintf(stderr, "kernel_launch: expected 41 inputs, %zu outputs, >= %zu bytes of workspace; got n_in %d out %d ws %zu\n", (size_t)O_TOTAL, (size_t)WS_END, n_in, out_size, ws_size); grid = -1; return; }
        int dev = 0, cus = 0, per_cu = 0;
        if (hipGetDevice(&dev) != hipSuccess || hipDeviceGetAttribute(&cus, hipDeviceAttributeMultiprocessorCount, dev) != hipSuccess) { grid = -1; return; }
        if (hipFuncSetAttribute((const void*)skel_fwd, hipFuncAttributeMaxDynamicSharedMemorySize, LDS_BYTES) != hipSuccess) { fprintf(stderr, "kernel_launch: hipFuncSetAttribute failed\n"); grid = -1; return; }
        if (hipOccupancyMaxActiveBlocksPerMultiprocessor(&per_cu, (const void*)skel_fwd, NTHREADS, LDS_BYTES) != hipSuccess || per_cu < 1) fprintf(stderr, "kernel_launch: occupancy query reports %d\n", per_cu);
        (void)hipGetLastError();
        grid = cus;
    }
    if (grid < 0) return;
    if (hipMemsetAsync((char*)d_ws + WS_CTL, 0, CTL_ZERO_BYTES, stream) != hipSuccess) return;
    Args a{};
    for (int i = 0; i < 41; ++i) a.in[i] = (const float*)d_in[i];
    a.out = (float*)d_out; a.ws = (unsigned char*)d_ws;
    constexpr int NL = MK_N_LAUNCHES;
    for (int li = 0; li < NL; ++li) {
        a.li = li; a.ph_lo = (int)((long)NPHASE * li / NL); a.ph_hi = (int)((long)NPHASE * (li + 1) / NL);
        hipLaunchKernelGGL(skel_fwd, dim3(grid), dim3(NTHREADS), LDS_BYTES, stream, a);
        const hipError_t le = hipPeekAtLastError();
        if (le != hipSuccess) { fprintf(stderr, "kernel_launch: launch %d failed: %s\n", li, hipGetErrorName(le)); break; }
    }
}
```

```cpp
#include <hip/hip_runtime.h>
#include <cstdio>
#include <cstdint>
#include <cmath>
#define MK_N_LAUNCHES 1
#define REP_MASK 0u
namespace pg8 {
#define PG8_LAS __attribute__((address_space(3)))
typedef unsigned short bf16_t;
typedef short bf16x8 __attribute__((ext_vector_type(8)));
typedef float f32x4 __attribute__((ext_vector_type(4)));
typedef unsigned u32x4 __attribute__((ext_vector_type(4)));
constexpr int BM = 256, BK = 64, HALF = 128, HTB = HALF * BK * 2  , STAGE_BYTES = 8 * HTB, NXCD = 8, WGM = 8;

__host__ __device__ __forceinline__ int lds_byte(int r, int c) { const int st = (r >> 4) * 2 + (c >> 5), rr = r & 15, cc = c & 31, ob = rr * 64 + cc * 2; return st * 1024 + (ob ^ (((ob >> 9) & 1) << 5)); }
__host__ __device__ __forceinline__ void stage_rc(int b, int& R, int& C) { const int st = b / 1024, sb = b % 1024, swz = sb ^ (((sb >> 9) & 1) << 5); R = (st >> 1) * 16 + swz / 64; C = (st & 1) * 32 + (swz % 64) / 2; }
__host__ __device__ __forceinline__ int perm32(int rho) { const int n = rho >> 4, i = rho & 15; return 8 * (i >> 2) + 4 * n + (i & 3); }

struct Unit { int pm, pn; };
struct Gemm { const bf16_t* A; const bf16_t* Bt; int M, N, K; };

struct StaticOrder {
    int nM, nN, nwg, G, c;
    __host__ __device__ void init(int M, int N, int G_, int c_) { nM = M / BM; nN = N / BM; nwg = nM * nN; G = G_; c = c_; }
    __host__ __device__ bool next(int i, Unit& u) const {
        const long L = (long)i * G + c; if (L >= nwg) return false;
        int wgid = (int)L; { const int q = nwg / NXCD, r = nwg % NXCD, xcd = wgid % NXCD, off = wgid / NXCD; wgid = (xcd < r ? xcd * (q + 1) : r * (q + 1) + (xcd - r) * q) + off; }
        const int nig = WGM * nN, gid = wgid / nig, fm = gid * WGM, gsz = (nM - fm) < WGM ? (nM - fm) : WGM;
        u.pm = fm + ((wgid % nig) % gsz); u.pn = (wgid % nig) / gsz; return true;
    }
    __device__ __forceinline__ void a_ready(const Unit&) const {}
    __device__ __forceinline__ void done(const Unit&) const {}
};
__device__ __forceinline__ unsigned cvt_pk_bf16(float lo, float hi) { typedef float f32x2_t_ __attribute__((ext_vector_type(2))); typedef __bf16 bf16x2_t_ __attribute__((ext_vector_type(2))); const f32x2_t_ v_ = {lo, hi}; const bf16x2_t_ b_ = __builtin_convertvector(v_, bf16x2_t_); return __builtin_bit_cast(unsigned, b_); }
__device__ __forceinline__ float bf_lo(unsigned w) { return __uint_as_float(w << 16); }
__device__ __forceinline__ float bf_hi(unsigned w) { return __uint_as_float(w & 0xffff0000u); }
__device__ __forceinline__ float sigmoid_f(float x) { return __builtin_amdgcn_rcpf(1.0f + __expf(-x)); }
__device__ __forceinline__ u32x4 pack8(const f32x4 a, const f32x4 b) { u32x4 w; w.x = cvt_pk_bf16(a[0], a[1]); w.y = cvt_pk_bf16(a[2], a[3]); w.z = cvt_pk_bf16(b[0], b[1]); w.w = cvt_pk_bf16(b[2], b[3]); return w; }

struct EpiInProj {
    static constexpr bool PERM = true, AFTER_DRAIN = false;
    __device__ __forceinline__ bool keep(const Unit&) const { return false; }
    bf16_t* O; int ldc; int nsig;
    __device__ __forceinline__ void operator()(const f32x4 (&acc)[2][2][4][2], const Unit& u, int wr, int wc, int fr, int fq) const {
        const int row0 = u.pm * BM + wr * 64 + fr, col0 = u.pn * BM + wc * 32 + 8 * fq; const bool sg = u.pn < nsig;
#pragma unroll
        for (int ai = 0; ai < 2; ++ai)
#pragma unroll
            for (int m = 0; m < 4; ++m) { bf16_t* rowp = O + (size_t)(row0 + ai * HALF + m * 16) * ldc + col0;
#pragma unroll
                for (int bj = 0; bj < 2; ++bj) { f32x4 v0 = acc[ai][bj][m][0], v1 = acc[ai][bj][m][1];
                    if (sg) {
#pragma unroll
                        for (int j = 0; j < 4; ++j) { v0[j] = sigmoid_f(v0[j]); v1[j] = sigmoid_f(v1[j]); } }
                    *(u32x4*)(rowp + bj * HALF) = pack8(v0, v1); } }
    }
};
struct EpiMlaQ {
    static constexpr bool PERM = false, AFTER_DRAIN = false;
    __device__ __forceinline__ bool keep(const Unit&) const { return false; }
    bf16_t* O; const float2* tab;
    __device__ __forceinline__ void operator()(const f32x4 (&acc)[2][2][4][2], const Unit& u, int wr, int wc, int fr, int fq) const {
        const int row0 = u.pm * BM + wr * 64 + fr; const bool lat = u.pm >= 32;
#pragma unroll
        for (int bj = 0; bj < 2; ++bj) {
            const int cg = u.pn * BM + bj * HALF + wc * 32;
            const int w = cg % 192; const bool rp = lat && (w >= 128); const int axis = (w - 128) >> 5;
#pragma unroll
            for (int ai = 0; ai < 2; ++ai)
#pragma unroll
                for (int m = 0; m < 4; ++m) { const int row = row0 + ai * HALF + m * 16; f32x4 x0 = acc[ai][bj][m][0], x1 = acc[ai][bj][m][1];
                    if (rp) { const int t = (row - 8192) & 2047; const int pos = axis ? (t & 63) : (t >> 6); const float2* tp = tab + pos * 16 + 4 * fq;
#pragma unroll
                        for (int j = 0; j < 4; ++j) { const float2 cs = tp[j]; const float a = x0[j], b = x1[j]; x0[j] = a * cs.x - b * cs.y; x1[j] = a * cs.y + b * cs.x; } }
                    bf16_t* p = O + (size_t)row * 1536 + cg + 4 * fq;
                    uint2 w0; w0.x = cvt_pk_bf16(x0[0], x0[1]); w0.y = cvt_pk_bf16(x0[2], x0[3]); uint2 w1; w1.x = cvt_pk_bf16(x1[0], x1[1]); w1.y = cvt_pk_bf16(x1[2], x1[3]);
                    *(uint2*)p = w0; *(uint2*)(p + 16) = w1; } }
    }
};
struct EpiMlaKV {
    static constexpr bool PERM = true, AFTER_DRAIN = false;
    __device__ __forceinline__ bool keep(const Unit&) const { return false; }
    bf16_t* Km; bf16_t* Vm;
    __device__ __forceinline__ void operator()(const f32x4 (&acc)[2][2][4][2], const Unit& u, int wr, int wc, int fr, int fq) const {
        const int row0 = u.pm * BM + wr * 64 + fr, c0 = wc * 32 + 8 * fq;
#pragma unroll
        for (int ai = 0; ai < 2; ++ai)
#pragma unroll
            for (int m = 0; m < 4; ++m) { const size_t row = (size_t)(row0 + ai * HALF + m * 16);
                *(u32x4*)(Km + row * 1536 + u.pn * 192 + c0) = pack8(acc[ai][0][m][0], acc[ai][0][m][1]);
                *(u32x4*)(Vm + row * 1024 + u.pn * 128 + c0) = pack8(acc[ai][1][m][0], acc[ai][1][m][1]); }
    }
};
template <int MODE> struct EpiGated {
    static constexpr bool PERM = true, AFTER_DRAIN = false;
    __device__ __forceinline__ bool keep(const Unit&) const { return false; }
    bf16_t* O; int ldc;
    __device__ __forceinline__ void operator()(const f32x4 (&acc)[2][2][4][2], const Unit& u, int wr, int wc, int fr, int fq) const {
        const int row0 = u.pm * BM + wr * 64 + fr, col0 = u.pn * HALF + wc * 32 + 8 * fq;
#pragma unroll
        for (int ai = 0; ai < 2; ++ai)
#pragma unroll
            for (int m = 0; m < 4; ++m) { f32x4 o[2];
#pragma unroll
                for (int n = 0; n < 2; ++n)
#pragma unroll
                    for (int j = 0; j < 4; ++j) { const float a = acc[ai][0][m][n][j], b = acc[ai][1][m][n][j]; o[n][j] = MODE == 0 ? a * sigmoid_f(b) : a * sigmoid_f(a) * b; }
                *(u32x4*)(O + (size_t)(row0 + ai * HALF + m * 16) * ldc + col0) = pack8(o[0], o[1]); }
    }
};
struct EpiBranch {
    static constexpr bool PERM = true, AFTER_DRAIN = false;
    const bf16_t* G; int ldg; bf16_t* GS;
    __device__ __forceinline__ bool keep(const Unit& u) const { return (u.pm >> 6) < 3; }
    __device__ __forceinline__ void operator()(f32x4 (&acc)[2][2][4][2], const Unit& u, int wr, int wc, int fr, int fq) const {
        const int br = u.pm >> 6, pm = u.pm & 63, pn = u.pn & 7;
        const int row0 = pm * BM + wr * 64 + fr, col0 = pn * BM + wc * 32 + 8 * fq;
#pragma unroll
        for (int ai = 0; ai < 2; ++ai) {
            u32x4 gc[4][2], gn[4][2];
#pragma unroll
            for (int m = 0; m < 4; ++m)
#pragma unroll
                for (int bj = 0; bj < 2; ++bj) { const bf16_t* gp = G + (size_t)(row0 + ai * HALF + m * 16) * ldg + br * 2048 + col0 + bj * HALF; gc[m][bj] = *(const u32x4*)gp; if (br < 3) gn[m][bj] = *(const u32x4*)(gp + 2048); }
#pragma unroll
            for (int m = 0; m < 4; ++m)
#pragma unroll
                for (int bj = 0; bj < 2; ++bj) { float c[8], n[8]; const u32x4 a = gc[m][bj];
                    c[0] = bf_lo(a.x); c[1] = bf_hi(a.x); c[2] = bf_lo(a.y); c[3] = bf_hi(a.y); c[4] = bf_lo(a.z); c[5] = bf_hi(a.z); c[6] = bf_lo(a.w); c[7] = bf_hi(a.w);
                    if (br < 3) { const u32x4 b = gn[m][bj]; n[0] = bf_lo(b.x); n[1] = bf_hi(b.x); n[2] = bf_lo(b.y); n[3] = bf_hi(b.y); n[4] = bf_lo(b.z); n[5] = bf_hi(b.z); n[6] = bf_lo(b.w); n[7] = bf_hi(b.w); }
#pragma unroll
                    for (int j = 0; j < 8; ++j) { float f = fmaxf(c[j], 1e-6f); if (br < 3) f *= __builtin_amdgcn_rcpf(fmaxf(n[j], 1e-6f)); acc[ai][bj][m][j >> 2][j & 3] *= f; }
                    if (br == 3) *(u32x4*)(GS + (size_t)(row0 + ai * HALF + m * 16) * 2048 + col0 + bj * HALF) = pack8(acc[ai][bj][m][0], acc[ai][bj][m][1]); }
        }
    }
};
struct EpiResid {
    static constexpr bool PERM = false, AFTER_DRAIN = false;
    __device__ __forceinline__ bool keep(const Unit&) const { return false; }
    float* X; const float* mod; int goff; float scale;
    __device__ __forceinline__ void operator()(const f32x4 (&acc)[2][2][4][2], const Unit& u, int wr, int wc, int fr, int fq) const {
        const int row0 = u.pm * BM + wr * 64 + fr, col0 = u.pn * BM + wc * 32 + 4 * fq;
        const int mrow = u.pm < 32 ? 0 : 1 + ((u.pm - 32) >> 3); const float* gp = mod + mrow * 12288 + goff + col0;
        f32x4 gv[2][2];
#pragma unroll
        for (int bj = 0; bj < 2; ++bj)
#pragma unroll
            for (int n = 0; n < 2; ++n) gv[bj][n] = *(const f32x4*)(gp + bj * HALF + n * 16) * scale;
#pragma unroll
        for (int ai = 0; ai < 2; ++ai) { f32x4 xv[4][2][2];
#pragma unroll
            for (int m = 0; m < 4; ++m)
#pragma unroll
                for (int bj = 0; bj < 2; ++bj)
#pragma unroll
                    for (int n = 0; n < 2; ++n) xv[m][bj][n] = *(const f32x4*)(X + (size_t)(row0 + ai * HALF + m * 16) * 2048 + col0 + bj * HALF + n * 16);
#pragma unroll
            for (int m = 0; m < 4; ++m)
#pragma unroll
                for (int bj = 0; bj < 2; ++bj)
#pragma unroll
                    for (int n = 0; n < 2; ++n) *(f32x4*)(X + (size_t)(row0 + ai * HALF + m * 16) * 2048 + col0 + bj * HALF + n * 16) = xv[m][bj][n] + gv[bj][n] * acc[ai][bj][m][n];
            asm volatile("" ::: "memory"); }
    }
};
struct BranchOrder {
    StaticOrder so;
    __device__ bool next(int i, Unit& u) const { Unit t; if (!so.next(i >> 2, t)) return false; const int br = i & 3; u.pm = br * 64 + t.pm; u.pn = br * 8 + t.pn; return true; }
    __device__ __forceinline__ void a_ready(const Unit&) const {}
    __device__ __forceinline__ void done(const Unit&) const {}
};
template <class Epi, class Sched, bool ALIGN_EPI = false, bool SP2 = false>
__device__ __forceinline__ void gemm_phase(PG8_LAS unsigned char* lds, const Gemm g, const Sched& S, const Epi& E) {
    int tid_ = threadIdx.x; asm volatile("" : "+v"(tid_));
    const int tid = tid_, wid = __builtin_amdgcn_readfirstlane(tid >> 6), lane = tid & 63, wr = wid >> 2, wc = wid & 3, fr = lane & 15, fq = lane >> 4;
    const int K = g.K, nt = K / BK;
    unsigned voffA[2], voffB[2];
#pragma unroll
    for (int i = 0; i < 2; ++i) { int R, C; stage_rc(tid * 16 + i * 8192, R, C); const int Rb = Epi::PERM ? ((R & ~31) + perm32(R & 31)) : R;
        voffA[i] = (unsigned)(R * K + C) * 2u; voffB[i] = (unsigned)(Rb * K + C) * 2u; }
    const size_t kstep = (size_t)(BK * 2);
    const size_t hstep = (size_t)HALF * K * 2;
    const size_t tstep = 2 * hstep;
    const unsigned ldsw = (unsigned)wid * 1024u;
    const int aoff = lds_byte(wr * 64 + fr, fq * 8), boff = lds_byte(wc * 32 + fr, fq * 8);
#define PG8_SA(b, h) (((b) * 2 + (h)) * HTB)
#define PG8_SB(b, h) ((4 + (b) * 2 + (h)) * HTB)
#define PG8_STAGE(bufoff, gbase, voff) do { _Pragma("unroll") for (int _i = 0; _i < 2; ++_i) \
        __builtin_amdgcn_global_load_lds((const unsigned*)((const char*)(gbase) + (voff)[_i]), (PG8_LAS unsigned*)(lds + (bufoff) + ldsw + _i * 8192), 16, 0, 0); } while (0)
#define PG8_LDA(dst, b, h) do { _Pragma("unroll") for (int m = 0; m < 4; ++m) _Pragma("unroll") for (int k = 0; k < 2; ++k) dst[m][k] = *(const PG8_LAS bf16x8*)(lds + PG8_SA(b, h) + aoff + m * 2048 + k * 1024); } while (0)
#define PG8_LDB(dst, b, h) do { _Pragma("unroll") for (int n = 0; n < 2; ++n) _Pragma("unroll") for (int k = 0; k < 2; ++k) dst[n][k] = *(const PG8_LAS bf16x8*)(lds + PG8_SB(b, h) + boff + n * 2048 + k * 1024); } while (0)
#define PG8_MMA(ai, bj, At, Bt) do { __builtin_amdgcn_s_setprio(1); _Pragma("unroll") for (int m = 0; m < 4; ++m) _Pragma("unroll") for (int n = 0; n < 2; ++n) _Pragma("unroll") for (int k = 0; k < 2; ++k) \
        acc[ai][bj][m][n] = __builtin_amdgcn_mfma_f32_16x16x32_bf16(Bt[n][k], At[m][k], acc[ai][bj][m][n], 0, 0, 0); __builtin_amdgcn_s_setprio(0); } while (0)
#define PG8_WAIT_V(n) asm volatile("s_waitcnt vmcnt(" #n ")" ::: "memory")
#define PG8_WAIT_L(n) asm volatile("s_waitcnt lgkmcnt(" #n ")" ::: "memory")
#define PG8_BAR __builtin_amdgcn_s_barrier()
#define PG8_SCHED __builtin_amdgcn_sched_barrier(0)
    Unit cur, nxt; int ui = 0;
    if (!S.next(0, cur)) return;
    f32x4 acc[2][2][4][2];
#pragma unroll
    for (int a = 0; a < 2; ++a)
#pragma unroll
        for (int b = 0; b < 2; ++b)
#pragma unroll
            for (int m = 0; m < 4; ++m)
#pragma unroll
                for (int n = 0; n < 2; ++n) acc[a][b][m][n] = (f32x4){0.f, 0.f, 0.f, 0.f};
    bf16x8 At[4][2], B0[2][2], B1[2][2];
    const char* cA = (const char*)g.A + (size_t)cur.pm * tstep; const char* cB = (const char*)g.Bt + (size_t)cur.pn * tstep;
    S.a_ready(cur);
    if constexpr (SP2) {
        PG8_STAGE(PG8_SB(0, 0), cB, voffB); PG8_STAGE(PG8_SB(0, 1), cB + hstep, voffB); PG8_STAGE(PG8_SA(0, 0), cA, voffA); PG8_STAGE(PG8_SA(0, 1), cA + hstep, voffA);
        if (wr == 1) PG8_BAR;
        PG8_WAIT_V(2); PG8_BAR;
        PG8_STAGE(PG8_SB(1, 0), cB + kstep, voffB); PG8_STAGE(PG8_SA(1, 0), cA + kstep, voffA); PG8_STAGE(PG8_SB(1, 1), cB + hstep + kstep, voffB);
        PG8_WAIT_V(6); PG8_BAR;
    } else {
        PG8_STAGE(PG8_SB(0, 0), cB, voffB); PG8_STAGE(PG8_SA(0, 0), cA, voffA); PG8_STAGE(PG8_SB(0, 1), cB + hstep, voffB); PG8_STAGE(PG8_SA(0, 1), cA + hstep, voffA);
        if (wr == 1) PG8_BAR;
        PG8_WAIT_V(4); PG8_BAR;
        PG8_STAGE(PG8_SB(1, 0), cB + kstep, voffB); PG8_STAGE(PG8_SA(1, 0), cA + kstep, voffA); PG8_STAGE(PG8_SB(1, 1), cB + hstep + kstep, voffB);
        PG8_WAIT_V(6); PG8_BAR;
    }
    for (;;) {
        const bool has_next = S.next(ui + 1, nxt);
        const char* nA = has_next ? (const char*)g.A + (size_t)nxt.pm * tstep : cA; const char* nB = has_next ? (const char*)g.Bt + (size_t)nxt.pn * tstep : cB;
#pragma clang loop unroll(disable)
        for (int t = 0; t < nt; t += 2) {
            const bool last = (t == nt - 2);
            const char* a1 = cA + (size_t)(t + 1) * kstep;
            const char* a2 = last ? nA : cA + (size_t)(t + 2) * kstep; const char* b2 = last ? nB : cB + (size_t)(t + 2) * kstep;
            const char* a3 = a2 + kstep; const char* b3 = b2 + kstep;
            if (last && has_next) S.a_ready(nxt);
            if constexpr (SP2) {
            PG8_LDB(B0, 0, 0); PG8_LDB(B1, 0, 1); PG8_SCHED; PG8_LDA(At, 0, 0); PG8_STAGE(PG8_SA(1, 1), a1 + hstep, voffA);
            PG8_WAIT_V(8); PG8_WAIT_L(0); PG8_BAR; PG8_MMA(0, 0, At, B0); PG8_MMA(0, 1, At, B1); PG8_BAR; PG8_SCHED;
            PG8_LDA(At, 0, 1); PG8_STAGE(PG8_SB(0, 0), b2, voffB); PG8_STAGE(PG8_SB(0, 1), b2 + hstep, voffB); PG8_STAGE(PG8_SA(0, 0), a2, voffA);
            PG8_WAIT_V(8); PG8_WAIT_L(0); PG8_BAR; PG8_MMA(1, 0, At, B0); PG8_MMA(1, 1, At, B1); PG8_BAR; PG8_SCHED;
            PG8_LDB(B0, 1, 0); PG8_LDB(B1, 1, 1); PG8_SCHED; PG8_LDA(At, 1, 0); PG8_STAGE(PG8_SA(0, 1), a2 + hstep, voffA);
            PG8_WAIT_V(8); PG8_WAIT_L(0); PG8_BAR; PG8_MMA(0, 0, At, B0); PG8_MMA(0, 1, At, B1); PG8_BAR; PG8_SCHED;
            PG8_LDA(At, 1, 1); PG8_STAGE(PG8_SB(1, 0), b3, voffB); PG8_STAGE(PG8_SB(1, 1), b3 + hstep, voffB); PG8_STAGE(PG8_SA(1, 0), a3, voffA);
            PG8_WAIT_V(8); PG8_WAIT_L(0); PG8_BAR; PG8_MMA(1, 0, At, B0); PG8_MMA(1, 1, At, B1); PG8_BAR; PG8_SCHED;
            } else {
            PG8_LDB(B0, 0, 0); PG8_SCHED; PG8_LDA(At, 0, 0); PG8_STAGE(PG8_SA(1, 1), a1 + hstep, voffA);
            PG8_WAIT_L(8); PG8_BAR; PG8_WAIT_L(0); PG8_MMA(0, 0, At, B0); PG8_BAR; PG8_SCHED;
            PG8_LDB(B1, 0, 1); PG8_STAGE(PG8_SB(0, 0), b2, voffB);
            PG8_BAR; PG8_WAIT_L(0); PG8_MMA(0, 1, At, B1); PG8_BAR;
            PG8_LDA(At, 0, 1); PG8_STAGE(PG8_SA(0, 0), a2, voffA);
            PG8_BAR; PG8_WAIT_L(0); PG8_MMA(1, 0, At, B0); PG8_BAR; PG8_SCHED;
            PG8_STAGE(PG8_SB(0, 1), b2 + hstep, voffB);
            PG8_WAIT_V(6); PG8_BAR; PG8_MMA(1, 1, At, B1); PG8_BAR;
            PG8_LDB(B0, 1, 0); PG8_SCHED; PG8_LDA(At, 1, 0); PG8_STAGE(PG8_SA(0, 1), a2 + hstep, voffA);
            PG8_WAIT_L(8); PG8_BAR; PG8_WAIT_L(0); PG8_MMA(0, 0, At, B0); PG8_BAR; PG8_SCHED;
            PG8_LDB(B1, 1, 1); PG8_STAGE(PG8_SB(1, 0), b3, voffB);
            PG8_BAR; PG8_WAIT_L(0); PG8_MMA(0, 1, At, B1); PG8_BAR;
            PG8_LDA(At, 1, 1); PG8_STAGE(PG8_SA(1, 0), a3, voffA);
            PG8_BAR; PG8_WAIT_L(0); PG8_MMA(1, 0, At, B0); PG8_BAR; PG8_SCHED;
            PG8_STAGE(PG8_SB(1, 1), b3 + hstep, voffB);
            PG8_WAIT_V(6); PG8_BAR; PG8_MMA(1, 1, At, B1); PG8_BAR;
            }
        }
        if constexpr (ALIGN_EPI) { if (wr == 0) PG8_BAR; }
        if constexpr (!Epi::AFTER_DRAIN) { E(acc, cur, wr, wc, fr, fq); S.done(cur); }
        if (!has_next) break;
        if (!E.keep(cur)) {
#pragma unroll
        for (int a = 0; a < 2; ++a)
#pragma unroll
            for (int b = 0; b < 2; ++b)
#pragma unroll
                for (int m = 0; m < 4; ++m)
#pragma unroll
                    for (int n = 0; n < 2; ++n) acc[a][b][m][n] = (f32x4){0.f, 0.f, 0.f, 0.f};
        }
        cur = nxt; cA = nA; cB = nB; ++ui;
        if constexpr (ALIGN_EPI) { if (wr == 1) PG8_BAR; }
    }
    PG8_WAIT_V(0);
    if constexpr (!ALIGN_EPI) { if (wr == 0) PG8_BAR; }
    PG8_BAR;
    if constexpr (Epi::AFTER_DRAIN) { E.fused(acc, cur, wr, wc, fr, fq, lds, wid, lane); S.done(cur); }
#undef PG8_SA
#undef PG8_SB
#undef PG8_STAGE
#undef PG8_LDA
#undef PG8_LDB
#undef PG8_MMA
#undef PG8_WAIT_V
#undef PG8_WAIT_L
#undef PG8_BAR
#undef PG8_SCHED
}
}
namespace att {
using bf16x8 = __attribute__((ext_vector_type(8))) short;
using s16x4  = __attribute__((ext_vector_type(4))) short;
using f32x16 = __attribute__((ext_vector_type(16))) float;
using u32x4  = __attribute__((ext_vector_type(4))) unsigned;
constexpr int NW = 8, QBLK = 32, KVBLK = 64, DV = 128;
constexpr float THR = 8.f;
#ifndef QKT_GRP
#define QKT_GRP 4
#endif
#define ATT_SBAR() __builtin_amdgcn_sched_barrier(0)
template <int DK> struct Cfg {
  static constexpr float SCALE = DK == 128 ? 0.088388347648318440f : 0.072168783648703220f;
  static constexpr int KROW = DK * 2;
  static constexpr int SHM_V = KVBLK * DV * 2, SHM_K = KVBLK * DK * 2;
  static constexpr int SHM = 2 * SHM_V + 2 * SHM_K + NW * 64 * 4;
  static constexpr int NKC = DK / 64;
};
__device__ __forceinline__ int crow(int r, int hi) { return (r & 3) + 8 * (r >> 2) + 4 * hi; }
__device__ __forceinline__ unsigned cvtpk(float lo, float hi) { typedef float f32x2_t_ __attribute__((ext_vector_type(2))); typedef __bf16 bf16x2_t_ __attribute__((ext_vector_type(2))); const f32x2_t_ v_ = {lo, hi}; const bf16x2_t_ b_ = __builtin_convertvector(v_, bf16x2_t_); return __builtin_bit_cast(unsigned, b_); }
template <int DK> __device__ __forceinline__ int kswz(int row, int colB) { return row * (DK * 2) + (colB ^ ((row & 7) << 4)); }

template <int DK> __device__ __forceinline__ void partialSM(f32x16& p0, f32x16& p1, float& m_reg, float& mn, float& alpha) {
  constexpr float SCALE = Cfg<DK>::SCALE; constexpr float C = SCALE * 1.4426950408889634f;
  float pmax = p0[0]; for (int r = 1; r < 16; ++r) pmax = fmaxf(pmax, p0[r]); for (int r = 0; r < 16; ++r) pmax = fmaxf(pmax, p1[r]);
  { auto rr = __builtin_amdgcn_permlane32_swap(__float_as_uint(pmax), __float_as_uint(pmax), false, false);
    pmax = fmaxf(__uint_as_float(rr[0]), __uint_as_float(rr[1])); }
  if (__builtin_expect(__all(pmax - m_reg <= THR / SCALE), 1)) { mn = m_reg; alpha = 1.f; }
  else { mn = fmaxf(m_reg, pmax); alpha = __builtin_amdgcn_exp2f((m_reg - mn) * C); m_reg = mn; }
  float mnC = -mn * C;
  for (int r = 0; r < 16; ++r) p0[r] = fmaf(p0[r], C, mnC); for (int r = 0; r < 16; ++r) p1[r] = fmaf(p1[r], C, mnC);
  for (int r = 0; r < 16; ++r) p0[r] = __builtin_amdgcn_exp2f(p0[r]);
}
__device__ __forceinline__ void finishSM(f32x16& p0, f32x16& p1, float alpha, float& l_reg, bf16x8& pa0, bf16x8& pa1, bf16x8& pa2, bf16x8& pa3) {
  for (int r = 0; r < 16; ++r) p1[r] = __builtin_amdgcn_exp2f(p1[r]);
  float ps = 0; for (int r = 0; r < 16; ++r) ps += p0[r]; for (int r = 0; r < 16; ++r) ps += p1[r];
  { auto rr = __builtin_amdgcn_permlane32_swap(__float_as_uint(ps), __float_as_uint(ps), false, false);
    ps = __uint_as_float(rr[0]) + __uint_as_float(rr[1]); }
  l_reg = l_reg * alpha + ps;
#define ATT_PK4(P, BASE, OUT) do { unsigned a0 = cvtpk(P[BASE + 0], P[BASE + 1]), a1 = cvtpk(P[BASE + 2], P[BASE + 3]);   \
    unsigned b0 = cvtpk(P[BASE + 4], P[BASE + 5]), b1 = cvtpk(P[BASE + 6], P[BASE + 7]);                              \
    auto r0 = __builtin_amdgcn_permlane32_swap(a0, b0, false, false); auto r1 = __builtin_amdgcn_permlane32_swap(a1, b1, false, false); \
    u32x4 w = {r0[0], r1[0], r0[1], r1[1]}; OUT = *reinterpret_cast<bf16x8*>(&w); } while (0)
  ATT_PK4(p0, 0, pa0); ATT_PK4(p0, 8, pa1); ATT_PK4(p1, 0, pa2); ATT_PK4(p1, 8, pa3);
#undef ATT_PK4
}
template <int DK> __device__ __forceinline__ void qkt(f32x16& p0, f32x16& p1, const char* Ks, const bf16x8* qr, int r32, int hi) {
  p0 = f32x16{}; p1 = f32x16{};
#pragma unroll
  for (int d0 = 0; d0 < DK / 16; ++d0) { int cb = (d0 * 16 + hi * 8) * 2;
    bf16x8 b0 = *reinterpret_cast<const bf16x8*>(Ks + kswz<DK>(r32, cb));
    bf16x8 b1 = *reinterpret_cast<const bf16x8*>(Ks + kswz<DK>(32 + r32, cb));
    const bf16x8 q = qr[d0];
    p0 = __builtin_amdgcn_mfma_f32_32x32x16_bf16(b0, q, p0, 0, 0, 0);
    p1 = __builtin_amdgcn_mfma_f32_32x32x16_bf16(b1, q, p1, 0, 0, 0);
  }
}
template <int DK, class HOOK> __device__ __forceinline__ void qkt_hook(f32x16& p0, f32x16& p1, const char* Ks, const bf16x8* qr, int r32, int hi, HOOK&& hook) {
  p0 = f32x16{}; p1 = f32x16{};
#pragma unroll
  for (int d0 = 0; d0 < DK / 16; ++d0) { int cb = (d0 * 16 + hi * 8) * 2;
    bf16x8 b0 = *reinterpret_cast<const bf16x8*>(Ks + kswz<DK>(r32, cb));
    bf16x8 b1 = *reinterpret_cast<const bf16x8*>(Ks + kswz<DK>(32 + r32, cb));
    const bf16x8 q = qr[d0];
    p0 = __builtin_amdgcn_mfma_f32_32x32x16_bf16(b0, q, p0, 0, 0, 0);
    p1 = __builtin_amdgcn_mfma_f32_32x32x16_bf16(b1, q, p1, 0, 0, 0);
    __builtin_amdgcn_sched_barrier(0); hook(d0); __builtin_amdgcn_sched_barrier(0);
  }
}
__device__ __forceinline__ int v_st(int k, int c) { const int kk = (k & ~0xC) | ((k & 4) << 1) | ((k & 8) >> 1); return ((kk >> 3) * 4 + (c >> 5)) * 512 + ((kk & 7) * 32 + (c & 31)) * 2; }
__device__ __forceinline__ int v_rd_base(int lane) { return ((lane & 3) << 3) | (((lane >> 2) & 3) << 6) | (((lane >> 4) & 1) << 5) | (((lane >> 5) & 1) << 8); }
constexpr int v_rd_off(int d0, int ks, int half) { return d0 * 512 + ks * 4096 + half * 2048; }
template <int OFF> __device__ __forceinline__ s16x4 tr_read(int vb) {
  s16x4 r; asm volatile("ds_read_b64_tr_b16 %0, %1 offset:%2" : "=&v"(r) : "v"(vb), "i"(OFF) : "memory"); return r;
}
template <int D0> __device__ __forceinline__ void pv_one(f32x16& od, int vb, bf16x8 pa0, bf16x8 pa1, bf16x8 pa2, bf16x8 pa3) {
  const s16x4 l0 = tr_read<v_rd_off(D0, 0, 0)>(vb), h0 = tr_read<v_rd_off(D0, 0, 1)>(vb), l1 = tr_read<v_rd_off(D0, 1, 0)>(vb), h1 = tr_read<v_rd_off(D0, 1, 1)>(vb);
  const s16x4 l2 = tr_read<v_rd_off(D0, 2, 0)>(vb), h2 = tr_read<v_rd_off(D0, 2, 1)>(vb), l3 = tr_read<v_rd_off(D0, 3, 0)>(vb), h3 = tr_read<v_rd_off(D0, 3, 1)>(vb);
  asm volatile("s_waitcnt lgkmcnt(0)" ::: "memory"); ATT_SBAR();
#define ATT_PK(L, H) (bf16x8){L[0], L[1], L[2], L[3], H[0], H[1], H[2], H[3]}
  od = __builtin_amdgcn_mfma_f32_32x32x16_bf16(pa0, ATT_PK(l0, h0), od, 0, 0, 0);
  od = __builtin_amdgcn_mfma_f32_32x32x16_bf16(pa1, ATT_PK(l1, h1), od, 0, 0, 0);
  od = __builtin_amdgcn_mfma_f32_32x32x16_bf16(pa2, ATT_PK(l2, h2), od, 0, 0, 0);
  od = __builtin_amdgcn_mfma_f32_32x32x16_bf16(pa3, ATT_PK(l3, h3), od, 0, 0, 0);
#undef ATT_PK
}
__device__ __forceinline__ void pv_d0(f32x16* o, int vb, bf16x8 pa0, bf16x8 pa1, bf16x8 pa2, bf16x8 pa3) {
  pv_one<0>(o[0], vb, pa0, pa1, pa2, pa3); pv_one<1>(o[1], vb, pa0, pa1, pa2, pa3); pv_one<2>(o[2], vb, pa0, pa1, pa2, pa3); pv_one<3>(o[3], vb, pa0, pa1, pa2, pa3);
}
template <int DK, int SDEPTH, int ldq, int ldk, int ldv, int ldo>
__device__ __forceinline__ void attn_body(const unsigned short* __restrict__ Qb, const unsigned short* __restrict__ Kh, const unsigned short* __restrict__ Vh,
                                          unsigned short* __restrict__ Ob, int seq, char* lds) {
  using C_ = Cfg<DK>; constexpr int SHM_V = C_::SHM_V, SHM_K = C_::SHM_K, NKC = C_::NKC, CPR = DK / 8;
  int tid_ = threadIdx.x; asm volatile("" : "+v"(tid_));
  const int tid = tid_, wid = tid >> 6, lane = tid & 63, r32 = lane & 31, hi = lane >> 5;
  char* V_lds = lds; char* K_lds = lds + 2 * SHM_V;
  float* ws = (float*)(lds + 2 * SHM_V + 2 * SHM_K) + wid * 64; float* li_l = ws; float* al_l = ws + 32;
  float m_reg = -1e30f, l_reg = 0; f32x16 o[4] = {}; bf16x8 qr[DK / 16];
  const unsigned short* Qw = Qb + (long)(wid * QBLK + r32) * ldq + hi * 8;
#pragma unroll
  for (int d0 = 0; d0 < DK / 16; ++d0) qr[d0] = *reinterpret_cast<const bf16x8*>(Qw + d0 * 16);
  const int sr = tid >> 4, sc = (tid & 15) * 8, vst0 = v_st(sr, sc), vst1 = v_st(32 + sr, sc);
  unsigned kgo[NKC], klo[NKC];
#pragma unroll
  for (int i = 0; i < NKC; ++i) { const int c = tid + 512 * i, kr_ = c / CPR, kc_ = (c % CPR) * 8; kgo[i] = (unsigned)(kr_ * ldk + kc_) * 2u; klo[i] = (unsigned)kswz<DK>(kr_, kc_ * 2); }
  const unsigned vgo0 = (unsigned)(sr * ldv + sc) * 2u, vgo1 = (unsigned)((32 + sr) * ldv + sc) * 2u;
  const int vb0 = (int)(uintptr_t)V_lds + v_rd_base(lane);
  struct { bf16x8 vs0, vs1; bf16x8 ks[NKC]; } sr_[SDEPTH];
#define ATT_SLOAD(i, k0) do { const char* _vt = (const char*)Vh + (size_t)(k0) * (ldv * 2); const char* _kt = (const char*)Kh + (size_t)(k0) * (ldk * 2); \
    sr_[i].vs0 = *reinterpret_cast<const bf16x8*>(_vt + vgo0); sr_[i].vs1 = *reinterpret_cast<const bf16x8*>(_vt + vgo1); \
    _Pragma("unroll") for (int _c = 0; _c < NKC; ++_c) sr_[i].ks[_c] = *reinterpret_cast<const bf16x8*>(_kt + kgo[_c]); } while (0)
#define ATT_SWRITE(b, i) do { *(bf16x8*)(V_lds + (b) * SHM_V + vst0) = sr_[i].vs0; *(bf16x8*)(V_lds + (b) * SHM_V + vst1) = sr_[i].vs1; \
    _Pragma("unroll") for (int _c = 0; _c < NKC; ++_c) *(bf16x8*)(K_lds + (b) * SHM_K + klo[_c]) = sr_[i].ks[_c]; } while (0)
#define ATT_SWAIT() do { if constexpr (SDEPTH == 2) asm volatile("s_waitcnt vmcnt(%0)" :: "n"(2 + NKC) : "memory"); else asm volatile("s_waitcnt vmcnt(0)" ::: "memory"); } while (0)
#define ATT_RESC(a) do { if (__any((a) < 1.f)) { if (hi == 0) al_l[r32] = (a); asm volatile("s_waitcnt lgkmcnt(0)" ::: "memory"); \
    for (int d = 0; d < 4; ++d) for (int r = 0; r < 16; ++r) o[d][r] *= al_l[crow(r, hi)]; } } while (0)
  f32x16 pA0, pA1, pB0, pB1; float mnA, mnB, alA, alB; bf16x8 pa0, pa1, pa2, pa3; const int NT = seq / KVBLK;
  constexpr int SE = 0, SO = SDEPTH - 1;
  ATT_SLOAD(SE, 0); asm volatile("s_waitcnt vmcnt(0)" ::: "memory"); ATT_SWRITE(0, SE); __syncthreads();
  qkt<DK>(pA0, pA1, K_lds, qr, r32, hi); partialSM<DK>(pA0, pA1, m_reg, mnA, alA);
  ATT_SLOAD(SO, KVBLK); if constexpr (SDEPTH == 2) { if (2 < NT) ATT_SLOAD(SE, 2 * KVBLK); }
  ATT_SWAIT(); ATT_SWRITE(1, SO); __syncthreads();
  for (int j = 1; j + 1 < NT; j += 2) {
    ATT_SBAR(); qkt<DK>(pB0, pB1, K_lds + SHM_K, qr, r32, hi);
    finishSM(pA0, pA1, alA, l_reg, pa0, pa1, pa2, pa3); ATT_SBAR();
    ATT_SLOAD(SO, (j + SDEPTH) * KVBLK); ATT_SBAR();
    pv_d0(o, vb0, pa0, pa1, pa2, pa3); partialSM<DK>(pB0, pB1, m_reg, mnB, alB);
    __syncthreads(); ATT_SWAIT(); ATT_SWRITE(0, SE);
    ATT_RESC(alB); __syncthreads();
    ATT_SBAR(); qkt<DK>(pA0, pA1, K_lds, qr, r32, hi);
    finishSM(pB0, pB1, alB, l_reg, pa0, pa1, pa2, pa3); ATT_SBAR();
    if (SDEPTH == 1 || j + 3 < NT) ATT_SLOAD(SE, (j + 1 + SDEPTH) * KVBLK); ATT_SBAR();
    pv_d0(o, vb0 + SHM_V, pa0, pa1, pa2, pa3); partialSM<DK>(pA0, pA1, m_reg, mnA, alA);
    __syncthreads(); if (SDEPTH == 1 || j + 3 < NT) ATT_SWAIT(); else asm volatile("s_waitcnt vmcnt(0)" ::: "memory"); ATT_SWRITE(1, SO);
    ATT_RESC(alA); __syncthreads();
  }
  ATT_SBAR(); qkt<DK>(pB0, pB1, K_lds + SHM_K, qr, r32, hi);
  finishSM(pA0, pA1, alA, l_reg, pa0, pa1, pa2, pa3); ATT_SBAR();
  pv_d0(o, vb0, pa0, pa1, pa2, pa3); partialSM<DK>(pB0, pB1, m_reg, mnB, alB);
  __syncthreads(); ATT_RESC(alB);
  finishSM(pB0, pB1, alB, l_reg, pa0, pa1, pa2, pa3); ATT_SBAR();
  pv_d0(o, vb0 + SHM_V, pa0, pa1, pa2, pa3);
  if (hi == 0) li_l[r32] = l_reg; asm volatile("s_waitcnt lgkmcnt(0)" ::: "memory");
  float rli[16];
#pragma unroll
  for (int r = 0; r < 16; ++r) rli[r] = __builtin_amdgcn_rcpf(li_l[crow(r, hi)]);
  unsigned short* Ow = Ob + (long)(wid * QBLK) * ldo;
#pragma unroll
  for (int r = 0; r < 16; ++r) { int orow = crow(r, hi);
#pragma unroll
    for (int d0 = 0; d0 < 4; ++d0) { const float v = o[d0][r] * rli[r]; unsigned u = __float_as_uint(v); u += 0x7fffu + ((u >> 16) & 1u); Ow[(long)orow * ldo + d0 * 32 + r32] = (unsigned short)(u >> 16); } }
  __syncthreads();
#undef ATT_SLOAD
#undef ATT_SWRITE
#undef ATT_SWAIT
#undef ATT_RESC
}
template <int DK, int ldq, int ldk, int ldv, int ldo, class CV>
__device__ __forceinline__ void attn_body_simple(const unsigned short* __restrict__ Qb, const unsigned short* __restrict__ Kh, const unsigned short* __restrict__ Vh,
                                                 unsigned short* __restrict__ Ob, int seq, char* lds, CV& cv) {
  using C_ = Cfg<DK>; constexpr int SHM_V = C_::SHM_V, SHM_K = C_::SHM_K, NKC = C_::NKC, CPR = DK / 8;
  int tid_ = threadIdx.x; asm volatile("" : "+v"(tid_));
  const int tid = tid_, wid = tid >> 6, lane = tid & 63, r32 = lane & 31, hi = lane >> 5;
  char* V_lds = lds; char* K_lds = lds + 2 * SHM_V;
  float* ws = (float*)(lds + 2 * SHM_V + 2 * SHM_K) + wid * 64; float* li_l = ws; float* al_l = ws + 32;
  float m_reg = -1e30f, l_reg = 0; f32x16 o[4] = {}; bf16x8 qr[DK / 16];
  const unsigned short* Qw = Qb + (long)(wid * QBLK + r32) * ldq + hi * 8;
#pragma unroll
  for (int d0 = 0; d0 < DK / 16; ++d0) qr[d0] = *reinterpret_cast<const bf16x8*>(Qw + d0 * 16);
  const int sr = tid >> 4, sc = (tid & 15) * 8, vst0 = v_st(sr, sc), vst1 = v_st(32 + sr, sc);
  unsigned kgo[NKC], klo[NKC];
#pragma unroll
  for (int i = 0; i < NKC; ++i) { const int c = tid + 512 * i, kr_ = c / CPR, kc_ = (c % CPR) * 8; kgo[i] = (unsigned)(kr_ * ldk + kc_) * 2u; klo[i] = (unsigned)kswz<DK>(kr_, kc_ * 2); }
  const unsigned vgo0 = (unsigned)(sr * ldv + sc) * 2u, vgo1 = (unsigned)((32 + sr) * ldv + sc) * 2u;
  const int vb0 = (int)(uintptr_t)V_lds + v_rd_base(lane);
  bf16x8 vs0, vs1, ks[NKC];
#define ATS_LOAD(k0) do { const char* _vt = (const char*)Vh + (size_t)(k0) * (ldv * 2); const char* _kt = (const char*)Kh + (size_t)(k0) * (ldk * 2); \
    vs0 = *reinterpret_cast<const bf16x8*>(_vt + vgo0); vs1 = *reinterpret_cast<const bf16x8*>(_vt + vgo1); \
    _Pragma("unroll") for (int _c = 0; _c < NKC; ++_c) ks[_c] = *reinterpret_cast<const bf16x8*>(_kt + kgo[_c]); } while (0)
#define ATS_WRITE(b) do { *(bf16x8*)(V_lds + (b) * SHM_V + vst0) = vs0; *(bf16x8*)(V_lds + (b) * SHM_V + vst1) = vs1; \
    _Pragma("unroll") for (int _c = 0; _c < NKC; ++_c) *(bf16x8*)(K_lds + (b) * SHM_K + klo[_c]) = ks[_c]; } while (0)
  const int NT = seq / KVBLK; float cw[32];
  ATS_LOAD(0); __builtin_amdgcn_s_waitcnt(0x0F70)  ; ATS_WRITE(0); __syncthreads();
#define ATT_TILE(J, B) do { const int j = (J); constexpr int b = (B); \
    if (b == 0) { cv.end(cw); cv.decode(); }                       \
    if (j + 1 < NT) ATS_LOAD((j + 1) * KVBLK); \
    ATT_SBAR(); \
    f32x16 p0, p1; float mn, al; bf16x8 pa0, pa1, pa2, pa3; \
    if constexpr (CV::RIDES && DK == 128) qkt_hook<DK>(p0, p1, K_lds + b * SHM_K, qr, r32, hi, [&](int d0) { if ((d0 & 1) == 0) cv.part(cw, b * 4 + (d0 >> 1)); });     \
    else qkt<DK>(p0, p1, K_lds + b * SHM_K, qr, r32, hi); \
    partialSM<DK>(p0, p1, m_reg, mn, al); \
    if (__any(al < 1.f)) { if (hi == 0) al_l[r32] = al; asm volatile("s_waitcnt lgkmcnt(0)" ::: "memory"); \
      for (int d = 0; d < 4; ++d) for (int r = 0; r < 16; ++r) o[d][r] *= al_l[crow(r, hi)]; } \
    finishSM(p0, p1, al, l_reg, pa0, pa1, pa2, pa3); ATT_SBAR(); \
    pv_d0(o, vb0 + b * SHM_V, pa0, pa1, pa2, pa3); \
    if (j + 1 < NT) { if constexpr (CV::RIDES && DK == 128) asm volatile("s_waitcnt vmcnt(4)" ::: "memory"); else asm volatile("s_waitcnt vmcnt(0)" ::: "memory"); ATS_WRITE(b ^ 1); } \
    __syncthreads(); } while (0)
  for (int jj = 0; jj < NT; jj += 2) {
    ATT_TILE(jj, 0);
    if (jj + 1 < NT) ATT_TILE(jj + 1, 1);
  }
#undef ATT_TILE
  if (NT & 1) cv.rest(cw);
  cv.end(cw);
  if (hi == 0) li_l[r32] = l_reg; asm volatile("s_waitcnt lgkmcnt(0)" ::: "memory");
  float rli[16];
#pragma unroll
  for (int r = 0; r < 16; ++r) rli[r] = __builtin_amdgcn_rcpf(li_l[crow(r, hi)]);
  unsigned short* Ow = Ob + (long)(wid * QBLK) * ldo;
#pragma unroll
  for (int r = 0; r < 16; ++r) { int orow = crow(r, hi);
#pragma unroll
    for (int d0 = 0; d0 < 4; ++d0) { const float v = o[d0][r] * rli[r]; unsigned u = __float_as_uint(v); u += 0x7fffu + ((u >> 16) & 1u); Ow[(long)orow * ldo + d0 * 32 + r32] = (unsigned short)(u >> 16); } }
  __syncthreads();
#undef ATS_LOAD
#undef ATS_WRITE
}
}
namespace ssd {
typedef short bf16x8 __attribute__((ext_vector_type(8)));
typedef short v4i16_t __attribute__((ext_vector_type(4)));
typedef float f32x4 __attribute__((ext_vector_type(4)));
typedef unsigned u32x2v __attribute__((ext_vector_type(2)));
typedef unsigned u32x4v __attribute__((ext_vector_type(4)));
#define SSD_LAS __attribute__((address_space(3)))
constexpr int T = 128, LD_B = 136, LD_X = 72, LD_A = 136, LD_S = 136;
constexpr int OFF_B = 0, OFF_X = OFF_B + T * LD_B * 2, OFF_XW = OFF_X + T * LD_X * 2, OFF_A = OFF_XW + T * LD_X * 2, OFF_S = OFF_A + T * LD_A * 2, OFF_E = OFF_S + 64 * LD_S * 2, OFF_W = OFF_E + 512, OFF_DT = OFF_W + 512, OFF_MISC = OFF_DT + 512, LDS_BYTES = OFF_MISC + 64;
static_assert(LDS_BYTES <= 131072, "ssd LDS");
__device__ __forceinline__ unsigned cvt_pk(float lo, float hi) { typedef float f32x2_t_ __attribute__((ext_vector_type(2))); typedef __bf16 bf16x2_t_ __attribute__((ext_vector_type(2))); const f32x2_t_ v_ = {lo, hi}; const bf16x2_t_ b_ = __builtin_convertvector(v_, bf16x2_t_); return __builtin_bit_cast(unsigned, b_); }
__device__ __forceinline__ bf16x8 tr8(const SSD_LAS unsigned char* p, int rowstride_bytes) {
    const v4i16_t a = __builtin_amdgcn_ds_read_tr16_b64_v4i16((SSD_LAS v4i16_t*)p);
    const v4i16_t b = __builtin_amdgcn_ds_read_tr16_b64_v4i16((SSD_LAS v4i16_t*)(p + 4 * rowstride_bytes));
    return (bf16x8){a[0], a[1], a[2], a[3], b[0], b[1], b[2], b[3]};
}
__device__ __forceinline__ void ssd_unit(SSD_LAS unsigned char* lds, const unsigned short* __restrict__ XBC, const float* __restrict__ DT, unsigned short* __restrict__ Y,
                                         int row0, int nc, int h, int dir, float a_h, const float* __restrict__ h0, float* __restrict__ hout) {
    int tid_ = threadIdx.x; asm volatile("" : "+v"(tid_));
    const int tid = tid_, w = tid >> 6, lane = tid & 63, li = lane & 15, g = lane >> 4, grp = h >> 3;
    SSD_LAS float* Es = (SSD_LAS float*)(lds + OFF_E); SSD_LAS float* Ws = (SSD_LAS float*)(lds + OFF_W); SSD_LAS float* Dts = (SSD_LAS float*)(lds + OFF_DT); SSD_LAS float* Misc = (SSD_LAS float*)(lds + OFF_MISC);
    f32x4 st[4];
#pragma unroll
    for (int pt = 0; pt < 4; ++pt) st[pt] = h0 ? *(const f32x4*)(h0 + (size_t)(16 * pt + li) * 128 + 16 * w + 4 * g) : (f32x4){0.f, 0.f, 0.f, 0.f};
#pragma unroll
    for (int pt = 0; pt < 4; ++pt) { u32x2v pk; pk.x = cvt_pk(st[pt][0], st[pt][1]); pk.y = cvt_pk(st[pt][2], st[pt][3]); *(SSD_LAS u32x2v*)(lds + OFF_S + ((16 * pt + li) * LD_S + 16 * w + 4 * g) * 2) = pk; }
    u32x4v bv[4]; u32x4v xv[2]; float dtv = 0.f;
#define SSD_PREFETCH(tq) do { _Pragma("unroll") for (int i = 0; i < 4; ++i) { const int ch = tid + 512 * i, r = ch >> 4, cc = (ch & 15) * 8; bv[i] = *(const u32x4v*)(XBC + (size_t)((tq) + r) * 1536 + 1024 + grp * 128 + cc); } \
        _Pragma("unroll") for (int i = 0; i < 2; ++i) { const int ch = tid + 512 * i, r = ch >> 3, cc = (ch & 7) * 8; xv[i] = *(const u32x4v*)(XBC + (size_t)((tq) + r) * 1536 + h * 64 + cc); } \
        dtv = DT[(size_t)((tq) + (tid & 127)) * 32 + dir * 16 + h]; } while (0)
    SSD_PREFETCH(row0 + (dir ? nc - 1 : 0) * T);
    for (int ci = 0; ci < nc; ++ci) {
        const int c = dir ? nc - 1 - ci : ci; const int t0 = row0 + c * T;
        bf16x8 cf[4];
#pragma unroll
        for (int k = 0; k < 4; ++k) cf[k] = *(const bf16x8*)(XBC + (size_t)(t0 + 16 * w + li) * 1536 + 1280 + grp * 128 + 32 * k + 8 * g);
        if (tid < 128) {
            const float da = dtv * a_h; float p = da;
#pragma unroll
            for (int o = 1; o < 64; o <<= 1) { const float q = __shfl_up(p, o); if (lane >= o) p += q; }
            if (lane == 63) Misc[w] = p;
            Dts[tid] = dtv; Es[tid] = p; Ws[tid] = da;
        }
        __syncthreads();
        if (tid < 128) {
            const float tot0 = Misc[0], tot = tot0 + Misc[1]; float P = Es[tid] + (w == 1 ? tot0 : 0.f); const float da = Ws[tid];
            const float E = dir ? tot - P + da : P;
            Es[tid] = E; Ws[tid] = __expf(tot - E) * Dts[tid];
            if (tid == 0) Misc[2] = tot;
        }
        __syncthreads();
#pragma unroll
        for (int i = 0; i < 4; ++i) { const int ch = tid + 512 * i, r = ch >> 4, cc = (ch & 15) * 8; *(SSD_LAS u32x4v*)(lds + OFF_B + (r * LD_B + cc) * 2) = bv[i]; }
#pragma unroll
        for (int i = 0; i < 2; ++i) { const int ch = tid + 512 * i, r = ch >> 3, cc = (ch & 7) * 8; *(SSD_LAS u32x4v*)(lds + OFF_X + (r * LD_X + cc) * 2) = xv[i];
            const float ws = Ws[r]; u32x4v o; const unsigned* xi = (const unsigned*)&xv[i]; unsigned* oo = (unsigned*)&o;
#pragma unroll
            for (int q = 0; q < 4; ++q) oo[q] = cvt_pk(__uint_as_float(xi[q] << 16) * ws, __uint_as_float(xi[q] & 0xffff0000u) * ws);
            *(SSD_LAS u32x4v*)(lds + OFF_XW + (r * LD_X + cc) * 2) = o; }
        if (ci + 1 < nc) SSD_PREFETCH(row0 + (dir ? nc - 2 - ci : ci + 1) * T);
        __syncthreads();
#define SSD_SB() __builtin_amdgcn_sched_barrier(0)
        const int l = 16 * w + li; const float El = Es[l];
#pragma unroll
        for (int sp = 0; sp < 8; sp += 2) {
            bf16x8 a[2][4]; float es[2][4], ds[2][4];
#pragma unroll
            for (int t = 0; t < 2; ++t) {
#pragma unroll
                for (int k = 0; k < 4; ++k) a[t][k] = *(const SSD_LAS bf16x8*)(lds + OFF_B + ((16 * (sp + t) + li) * LD_B + 32 * k + 8 * g) * 2);
                const f32x4 e4 = *(const SSD_LAS f32x4*)(Es + 16 * (sp + t) + 4 * g), d4 = *(const SSD_LAS f32x4*)(Dts + 16 * (sp + t) + 4 * g);
#pragma unroll
                for (int j = 0; j < 4; ++j) { es[t][j] = e4[j]; ds[t][j] = d4[j]; } }
            SSD_SB();
            f32x4 acc[2] = {{0.f, 0.f, 0.f, 0.f}, {0.f, 0.f, 0.f, 0.f}};
#pragma unroll
            for (int k = 0; k < 4; ++k)
#pragma unroll
                for (int t = 0; t < 2; ++t) acc[t] = __builtin_amdgcn_mfma_f32_16x16x32_bf16(a[t][k], cf[k], acc[t], 0, 0, 0);
#pragma unroll
            for (int t = 0; t < 2; ++t) { float v[4];
#pragma unroll
                for (int j = 0; j < 4; ++j) { const int s_ = 16 * (sp + t) + 4 * g + j; const bool ok = dir ? (s_ >= l) : (s_ <= l); const float e = __expf(El - es[t][j]) * ds[t][j]; v[j] = ok ? acc[t][j] * e : 0.f; }
                u32x2v pk; pk.x = cvt_pk(v[0], v[1]); pk.y = cvt_pk(v[2], v[3]);
                *(SSD_LAS u32x2v*)(lds + OFF_A + (l * LD_A + 16 * (sp + t) + 4 * g) * 2) = pk; }
            SSD_SB();
        }
        asm volatile("s_waitcnt lgkmcnt(0)" ::: "memory");
        float el4[4];
        { const f32x4 e4 = *(const SSD_LAS f32x4*)(Es + 16 * w + 4 * g);
#pragma unroll
          for (int j = 0; j < 4; ++j) el4[j] = __expf(e4[j]); }
        unsigned short* yrow = Y + (size_t)(t0 + 16 * w + 4 * g) * 1024 + h * 64 + li;
        bf16x8 af[4];
#pragma unroll
        for (int k = 0; k < 4; ++k) af[k] = *(const SSD_LAS bf16x8*)(lds + OFF_A + (l * LD_A + 32 * k + 8 * g) * 2);
#pragma unroll
        for (int pt = 0; pt < 4; ++pt) {
            bf16x8 xb[4], sb[4];
#pragma unroll
            for (int k = 0; k < 4; ++k) { xb[k] = tr8(lds + OFF_X + ((32 * k + 8 * g + (li >> 2)) * LD_X + 16 * pt + 4 * (li & 3)) * 2, LD_X * 2);
                sb[k] = *(const SSD_LAS bf16x8*)(lds + OFF_S + ((16 * pt + li) * LD_S + 32 * k + 8 * g) * 2); }
            SSD_SB();
            f32x4 ya = {0.f, 0.f, 0.f, 0.f}, yb = {0.f, 0.f, 0.f, 0.f};
#pragma unroll
            for (int k = 0; k < 4; ++k) { ya = __builtin_amdgcn_mfma_f32_16x16x32_bf16(af[k], xb[k], ya, 0, 0, 0); yb = __builtin_amdgcn_mfma_f32_16x16x32_bf16(cf[k], sb[k], yb, 0, 0, 0); }
#pragma unroll
            for (int j = 0; j < 4; ++j) { const float yv = ya[j] + el4[j] * yb[j]; unsigned u = __float_as_uint(yv); u += 0x7fffu + ((u >> 16) & 1u); yrow[(size_t)j * 1024 + 16 * pt] = (unsigned short)(u >> 16); }
            SSD_SB();
        }
        __syncthreads();
        const float etot = __expf(Misc[2]);
        bf16x8 ba[4];
#pragma unroll
        for (int k = 0; k < 4; ++k) ba[k] = tr8(lds + OFF_B + ((32 * k + 8 * g + (li >> 2)) * LD_B + 16 * w + 4 * (li & 3)) * 2, LD_B * 2);
#pragma unroll
        for (int pt = 0; pt < 4; ++pt) { bf16x8 xw[4];
#pragma unroll
            for (int k = 0; k < 4; ++k) xw[k] = tr8(lds + OFF_XW + ((32 * k + 8 * g + (li >> 2)) * LD_X + 16 * pt + 4 * (li & 3)) * 2, LD_X * 2);
            SSD_SB();
            st[pt] *= etot;
#pragma unroll
            for (int k = 0; k < 4; ++k) st[pt] = __builtin_amdgcn_mfma_f32_16x16x32_bf16(ba[k], xw[k], st[pt], 0, 0, 0);
            u32x2v pk; pk.x = cvt_pk(st[pt][0], st[pt][1]); pk.y = cvt_pk(st[pt][2], st[pt][3]); *(SSD_LAS u32x2v*)(lds + OFF_S + ((16 * pt + li) * LD_S + 16 * w + 4 * g) * 2) = pk;
            SSD_SB(); }
        __syncthreads();
    }
#undef SSD_SB
#undef SSD_PREFETCH
    if (hout) {
#pragma unroll
        for (int pt = 0; pt < 4; ++pt) *(f32x4*)(hout + (size_t)(16 * pt + li) * 128 + 16 * w + 4 * g) = st[pt];
    }
}
}
namespace s5 {
typedef short bf16x8 __attribute__((ext_vector_type(8)));
typedef short bf16x4 __attribute__((ext_vector_type(4)));
typedef float f32x4 __attribute__((ext_vector_type(4)));
typedef float f32x2 __attribute__((ext_vector_type(2)));
typedef unsigned u32x2 __attribute__((ext_vector_type(2)));
typedef unsigned u32x4 __attribute__((ext_vector_type(4)));
#define S5_LAS __attribute__((address_space(3)))
constexpr int LD_BU = 136, LD_HS = 136;
constexpr int OFF_HS = 16 * LD_BU * 2, OFF_YL = OFF_HS + 16 * LD_HS * 2;
constexpr int WAVE_LDS = OFF_YL + 16 * 16 * 16 * 2;
constexpr int CD_BYTES = 1024 + 4096, CG_BYTES = 4096;
__device__ __forceinline__ unsigned short f2bf(float f) { unsigned u = __float_as_uint(f); u += 0x7fffu + ((u >> 16) & 1u); return (unsigned short)(u >> 16); }
__device__ __forceinline__ unsigned pk(float lo, float hi) { typedef float f2_ __attribute__((ext_vector_type(2))); typedef __bf16 b2_ __attribute__((ext_vector_type(2))); const f2_ v = {lo, hi}; const b2_ b = __builtin_convertvector(v, b2_); return __builtin_bit_cast(unsigned, b); }

__device__ __forceinline__ void make_consts(unsigned char* cd, unsigned char* cg  , const float* lam_re, const float* lam_im, float stepsz, const float* b_re, const float* b_im, const float* c_re, const float* c_im, int lane) {
    const int li = lane & 15, g = lane >> 4;
    float ar, ai, kr, ki;
    { const float lr = lam_re[lane], lm = lam_im[lane]; const float mag = expf(lr * stepsz); float sn, cs; sincosf(lm * stepsz, &sn, &cs); ar = mag * cs; ai = mag * sn;
      const float den = lr * lr + lm * lm; kr = ((ar - 1.0f) * lr + ai * lm) / den; ki = (ai * lr - (ar - 1.0f) * lm) / den; }
    float zr = ar, zi = ai;
#pragma unroll
    for (int i = 0; i < 8; ++i) { const float nr = zr * zr - zi * zi, ni = 2.0f * zr * zi; zr = nr; zi = ni; }
    float* cf = (float*)cd; cf[lane] = ar; cf[64 + lane] = ai; cf[128 + lane] = zr; cf[192 + lane] = zi;
#pragma unroll
    for (int ct = 0; ct < 8; ++ct) { const int k = 16 * ct + li, p = k >> 1; const bool im = k & 1; const float kkr = __shfl(kr, p), kki = __shfl(ki, p);
        const f32x4 br = *(const f32x4*)(b_re + p * 16 + 4 * g), bi = *(const f32x4*)(b_im + p * 16 + 4 * g); float v[4];
#pragma unroll
        for (int j = 0; j < 4; ++j) v[j] = im ? kkr * bi[j] + kki * br[j] : kkr * br[j] - kki * bi[j];
        u32x2 w; w.x = pk(v[0], v[1]); w.y = pk(v[2], v[3]); *(u32x2*)(cd + 1024 + (ct * 64 + lane) * 8) = w; }
    if (cg) {
#pragma unroll
        for (int kk = 0; kk < 4; ++kk) { const f32x4 vr = *(const f32x4*)(c_re + li * 64 + 16 * kk + 4 * g), vi = *(const f32x4*)(c_im + li * 64 + 16 * kk + 4 * g);
            u32x4 w; w.x = pk(vr[0], -vi[0]); w.y = pk(vr[1], -vi[1]); w.z = pk(vr[2], -vi[2]); w.w = pk(vr[3], -vi[3]); *(u32x4*)(cg + (kk * 64 + lane) * 16) = w; } }
}
struct Ctx {
    float ar, ai;
    bf16x4 bfr[8];
    bf16x8 cfr[4];
};
__device__ __forceinline__ void load_ctx(Ctx& c, const unsigned char* cd, const unsigned char* cg, int lane, bool with_c) {
    const float* cf = (const float*)cd; c.ar = cf[lane]; c.ai = cf[64 + lane];
#pragma unroll
    for (int ct = 0; ct < 8; ++ct) c.bfr[ct] = __builtin_bit_cast(bf16x4, *(const u32x2*)(cd + 1024 + (ct * 64 + lane) * 8));
    if (with_c) {
#pragma unroll
        for (int kk = 0; kk < 4; ++kk) c.cfr[kk] = __builtin_bit_cast(bf16x8, *(const u32x4*)(cg + (kk * 64 + lane) * 16)); }
}
template <bool NEWT, bool CURT, bool HSW, bool OLDT, bool POST>
__device__ __forceinline__ void step(const Ctx& c, S5_LAS unsigned char* BU, S5_LAS unsigned char* HS, S5_LAS unsigned char* YL  , int lane, int li, int g, int dir, const u32x2 unew, float& hr, float& hi,
                                     const unsigned short* __restrict__ uold, int ldu, unsigned short* __restrict__ outp, float dch) {
    unsigned bu[16]; bf16x8 hf[4]; f32x4 acc[8]; unsigned hs[16]; unsigned short yprev[4]; unsigned short uo[4];
    if (CURT) {
#pragma unroll
        for (int i = 0; i < 16; ++i) { const int t = dir ? 15 - i : i; bu[i] = *(const S5_LAS unsigned*)(BU + t * (LD_BU * 2) + lane * 4); } }
    if (OLDT) {
#pragma unroll
        for (int kk = 0; kk < 4; ++kk) hf[kk] = *(const S5_LAS bf16x8*)(HS + li * (LD_HS * 2) + (32 * kk + 8 * g) * 2);
        if (POST) {
#pragma unroll
            for (int j = 0; j < 4; ++j) { yprev[j] = *(const S5_LAS unsigned short*)(YL + ((4 * g + j) * 16 + li) * 2); uo[j] = uold[(size_t)(4 * g + j) * ldu + li]; } } }
    if (NEWT) { const bf16x4 uf = __builtin_bit_cast(bf16x4, unew);
#pragma unroll
        for (int ct = 0; ct < 8; ++ct) { acc[ct] = (f32x4){0.f, 0.f, 0.f, 0.f}; acc[ct] = __builtin_amdgcn_mfma_f32_16x16x16bf16_1k(c.bfr[ct], uf, acc[ct], 0, 0, 0); } }
    if (CURT) {
#pragma unroll
        for (int i = 0; i < 16; ++i) { const float br = __uint_as_float(bu[i] << 16), bi = __uint_as_float(bu[i] & 0xffff0000u);
            const float nr = c.ar * hr - c.ai * hi + br, ni = c.ar * hi + c.ai * hr + bi; hr = nr; hi = ni; if (HSW) hs[i] = pk(hr, hi); } }
    if (OLDT) { f32x4 y = {0.f, 0.f, 0.f, 0.f};
#pragma unroll
        for (int kk = 0; kk < 4; ++kk) y = __builtin_amdgcn_mfma_f32_16x16x32_bf16(hf[kk], c.cfr[kk], y, 0, 0, 0);
        if (!POST) {
#pragma unroll
            for (int j = 0; j < 4; ++j) *(S5_LAS unsigned short*)(YL + ((4 * g + j) * 16 + li) * 2) = f2bf(y[j]); }
        else {
#pragma unroll
            for (int j = 0; j < 4; ++j) { const float v = y[j] + __uint_as_float((unsigned)yprev[j] << 16) + dch * __uint_as_float((unsigned)uo[j] << 16); const float tt = 0.7978845608028654f * (v + 0.044715f * v * v * v);
                outp[(size_t)(4 * g + j) * 1024 + li] = f2bf(v * (1.0f - 1.0f / (1.0f + __expf(2.0f * tt)))); } } }
    if (NEWT) {
#pragma unroll
        for (int ct = 0; ct < 8; ++ct) { u32x2 w; w.x = pk(acc[ct][0], acc[ct][1]); w.y = pk(acc[ct][2], acc[ct][3]); *(S5_LAS u32x2*)(BU + (li * LD_BU + 16 * ct + 4 * g) * 2) = w; } }
    if (CURT && HSW) {
#pragma unroll
        for (int i = 0; i < 16; ++i) { const int t = dir ? 15 - i : i; *(S5_LAS unsigned*)(HS + t * (LD_HS * 2) + lane * 4) = hs[i]; } }
}
template <bool POST>
__device__ __forceinline__ void s5_pass(const Ctx& c, S5_LAS unsigned char* wl, int lane, int dir, const unsigned short* __restrict__ U, int ldu, unsigned short* __restrict__ OUT, float dch, float& hr, float& hi) {
    const int li = lane & 15, g = lane >> 4; constexpr int L = 256, ntile = 16;
    S5_LAS unsigned char* BU = wl; S5_LAS unsigned char* HS = wl + OFF_HS; S5_LAS unsigned char* YL = wl + OFF_YL;
#define S5_TB(ti) (dir ? L - 16 * ((ti) + 1) : 16 * (ti))
#define S5_ULOAD(ti) (*(const u32x2*)(U + (size_t)(S5_TB(ti) + li) * ldu + 4 * g))
#define S5_ARGS(ti) YL + S5_TB(ti) * 32, lane, li, g, dir
#define S5_ARGS2(ti) U + (size_t)S5_TB(ti) * ldu, ldu, OUT + (size_t)S5_TB(ti) * 1024, dch
    u32x2 u0 = S5_ULOAD(0), u1 = S5_ULOAD(1), u2 = S5_ULOAD(2);
    step<true, false, true, false, POST>(c, BU, HS, S5_ARGS(0), u0, hr, hi, S5_ARGS2(0));
    step<true, true, true, false, POST>(c, BU, HS, S5_ARGS(0), u1, hr, hi, S5_ARGS2(0));
    u0 = u2; u1 = S5_ULOAD(3); u2 = S5_ULOAD(4);
#pragma clang loop unroll(disable)
    for (int ti = 2; ti < ntile; ++ti) {
        const u32x2 uc = u0; u0 = u1; u1 = u2; if (ti + 3 < ntile) u2 = S5_ULOAD(ti + 3);
        step<true, true, true, true, POST>(c, BU, HS, S5_ARGS(ti - 2), uc, hr, hi, S5_ARGS2(ti - 2));
    }
    step<false, true, true, true, POST>(c, BU, HS, S5_ARGS(ntile - 2), u0, hr, hi, S5_ARGS2(ntile - 2));
    step<false, false, true, true, POST>(c, BU, HS, S5_ARGS(ntile - 1), u0, hr, hi, S5_ARGS2(ntile - 1));
#undef S5_ARGS
#undef S5_ARGS2
}
__device__ __forceinline__ void s5_epass(const Ctx& c, S5_LAS unsigned char* wl, int lane, int dir, const unsigned short* __restrict__ U, int ldu, float& hr, float& hi) {
    const int li = lane & 15, g = lane >> 4; constexpr int L = 256, ntile = 16;
    S5_LAS unsigned char* BU = wl; S5_LAS unsigned char* HS = wl + OFF_HS;
    u32x2 uu[16];
#pragma unroll
    for (int ti = 0; ti < 16; ++ti) uu[ti] = S5_ULOAD(ti);
    step<true, false, false, false, false>(c, BU, HS, HS, lane, li, g, dir, uu[0], hr, hi, nullptr, 0, nullptr, 0.f);
#pragma unroll
    for (int ti = 1; ti < ntile; ++ti) step<true, true, false, false, false>(c, BU, HS, HS, lane, li, g, dir, uu[ti], hr, hi, nullptr, 0, nullptr, 0.f);
    step<false, true, false, false, false>(c, BU, HS, HS, lane, li, g, dir, uu[0], hr, hi, nullptr, 0, nullptr, 0.f);
#undef S5_ULOAD
#undef S5_TB
}
}
typedef unsigned short bf16;
typedef float f32x4 __attribute__((ext_vector_type(4)));
typedef unsigned u32x4 __attribute__((ext_vector_type(4)));
typedef unsigned u32x2 __attribute__((ext_vector_type(2)));
#define LAS __attribute__((address_space(3)))
constexpr int NWAVES = 8, NTHREADS = 512;
constexpr int DM = 2048, MROWS = 16384, MCTX = 8192, KROWS = 18432, NLAYER = 4;
constexpr int NIN = 14336;
constexpr int C_GATE = 0, C_GQ = 8192, C_GK = 9216, C_GV = 9472, C_SZ = 9728, C_XBC = 10752, C_S5U = 12288, C_MQD = 13312, C_CKV = 13824, C_KPE = 14080, C_SDT = 14144, C_END = 14176;
constexpr int FFN = 5632;
constexpr float EPS = 1e-6f;
constexpr size_t MiB = 1u << 20;
constexpr size_t WS_CTL = 0, CTL_ZERO_BYTES = 1 * MiB;
constexpr size_t WS_MOD = 1 * MiB;
constexpr size_t WS_TAB = 2 * MiB;
constexpr size_t WS_X = 4 * MiB;
constexpr size_t WS_H = 132 * MiB;
constexpr size_t WS_PROJ = 196 * MiB;
constexpr size_t WS_W = 644 * MiB;
constexpr size_t W_IN = 0, W_UQ = W_IN + (size_t)NIN * 2048 * 2, W_UKV = W_UQ + (size_t)1536 * 512 * 2, W_GLU = W_UKV + (size_t)2048 * 256 * 2, W_BR = W_GLU + (size_t)2048 * 1024 * 2,
                 W_OUT = W_BR + (size_t)4 * 2048 * 1024 * 2, W_FI = W_OUT + (size_t)2048 * 2048 * 2, W_FO = W_FI + (size_t)11264 * 2048 * 2, W_END = W_FO + (size_t)2048 * 5632 * 2;
static_assert(W_END <= 154 * MiB, "weights region");
constexpr size_t WS_Q = 798 * MiB, WS_KG = 830 * MiB, WS_VG = 839 * MiB, WS_AQ = 848 * MiB, WS_ACKV = 864 * MiB, WS_QM = 873 * MiB, WS_KM = 921 * MiB, WS_VM = 975 * MiB,
                 WS_XBC = 1011 * MiB, WS_DT = 1059 * MiB, WS_YF = 1061 * MiB, WS_YB = 1125 * MiB, WS_SF = 1189 * MiB, WS_SB = 1253 * MiB, WS_S5PRE = 1317 * MiB,
                 WS_O = 1349 * MiB, WS_GSF = 1477 * MiB, WS_GS = 1605 * MiB, WS_END = 1669 * MiB;
constexpr size_t WS_S5C = WS_GSF, WS_S5G = WS_GSF + 4 * MiB, WS_S5E = WS_GSF + 8 * MiB;
constexpr int CW_BAR = 4096;
constexpr size_t O_YP = 0, O_YS = 16777216, O_GK = 33554432, O_GV = 41943040, O_CKV = 50331648, O_KPE = 58720256, O_SSD = 60817408, O_S5 = 94371840, O_TOTAL = 96468992;
constexpr int RING_BYTES = 131072, LDSCTL_OFF = 135168  , MISC_OFF = LDSCTL_OFF + 320, LDS_BYTES = 147456;

#define VM_WAIT() asm volatile("s_waitcnt vmcnt(0)" ::: "memory")
__device__ __forceinline__ unsigned f2bf(float f) { unsigned u = __float_as_uint(f); return (u + 0x7fffu + ((u >> 16) & 1u)) >> 16; }
__device__ __forceinline__ unsigned pk2(float lo, float hi) { typedef float f32x2_t_ __attribute__((ext_vector_type(2))); typedef __bf16 bf16x2_t_ __attribute__((ext_vector_type(2))); const f32x2_t_ v_ = {lo, hi}; const bf16x2_t_ b_ = __builtin_convertvector(v_, bf16x2_t_); return __builtin_bit_cast(unsigned, b_); }
__device__ __forceinline__ float bflo(unsigned w) { return __uint_as_float(w << 16); }
__device__ __forceinline__ float bfhi(unsigned w) { return __uint_as_float(w & 0xffff0000u); }
__device__ __forceinline__ void unpack8(const u32x4 w, float* f) { f[0] = bflo(w.x); f[1] = bfhi(w.x); f[2] = bflo(w.y); f[3] = bfhi(w.y); f[4] = bflo(w.z); f[5] = bfhi(w.z); f[6] = bflo(w.w); f[7] = bfhi(w.w); }
__device__ __forceinline__ u32x4 pack8f(const float* f) { u32x4 w; w.x = pk2(f[0], f[1]); w.y = pk2(f[2], f[3]); w.z = pk2(f[4], f[5]); w.w = pk2(f[6], f[7]); return w; }
__device__ __forceinline__ float wave_sum(float v) {
#pragma unroll
    for (int o = 1; o < 64; o <<= 1) v += __shfl_xor(v, o);
    return v;
}
__device__ __forceinline__ float sigm(float x) { return 1.0f / (1.0f + __expf(-x)); }

struct Args { const float* in[41]; float* out; unsigned char* ws; int ph_lo, ph_hi, li, pad; };
struct Frame {
    LAS unsigned char* lds; int tid, lane, wave, G, bid, gw, NGW;
    const float* const* in; float* out; unsigned char* ws;
    const float* const* in0; float* out0; unsigned char* ws0;
};
enum { I_XP = 0, I_XS, I_CGK, I_CGV, I_CCKV, I_CKPE, I_SSSD, I_SS5, I_C, I_CCTX, I_N1G, I_N2G, I_WMOD, I_BMOD, I_WIN, I_QNG, I_KNG, I_CONVW, I_CONVB, I_ALOG, I_DTB, I_SSDD, I_SSDNG,
       I_MQNG, I_WUQ, I_MKVNG, I_WUKV, I_LRE, I_LIM, I_LSTEP, I_BRE, I_BIM, I_CRE, I_CIM, I_S5D, I_WGLU, I_WBR, I_WOUT, I_WFI, I_WFO, I_FING };

__device__ __forceinline__ void transpose_item(const float* W, int K, int N, bf16* WT, int dst_row0, int k0, int n0, LAS float* scr, int lane) {
#pragma unroll 8
    for (int i = 0; i < 32; ++i) { const int kk = 2 * i + (lane >> 5); scr[kk * 33 + (lane & 31)] = W[(size_t)(k0 + kk) * N + n0 + (lane & 31)]; }
    asm volatile("s_waitcnt lgkmcnt(0)" ::: "memory");
    const int c = lane & 7;
#pragma unroll
    for (int j = 0; j < 4; ++j) { const int n = (lane >> 3) + 8 * j; const LAS float* s = scr + (8 * c) * 33 + n;
        u32x4 o; o.x = pk2(s[0 * 33], s[1 * 33]); o.y = pk2(s[2 * 33], s[3 * 33]); o.z = pk2(s[4 * 33], s[5 * 33]); o.w = pk2(s[6 * 33], s[7 * 33]);
        *(u32x4*)(WT + (size_t)(dst_row0 + n) * K + k0 + 8 * c) = o; }
    asm volatile("s_waitcnt lgkmcnt(0)" ::: "memory");
}
__device__ __forceinline__ int map_in(int c) {
    if (c < 12288) return c; if (c < 12320) return C_SDT + (c - 12288); if (c < 12832) return C_MQD + (c - 12320); if (c < 13152) return C_CKV + (c - 12832); return C_S5U + (c - 13152);
}
__device__ __forceinline__ int map_pair(int c, int half) {
    return c < half ? 256 * (c >> 7) + (c & 127) : 256 * ((c - half) >> 7) + 128 + ((c - half) & 127);
}
__device__ __forceinline__ void phase_zero_pad(Frame& F) {
    bf16* Wi = (bf16*)((char*)(F.ws + WS_W) + W_IN); const u32x4 z = {0u, 0u, 0u, 0u};
    for (int r = F.gw; r < NIN - C_END; r += F.NGW) { u32x4* p = (u32x4*)(Wi + (size_t)(C_END + r) * 2048);
#pragma unroll
        for (int j = 0; j < 4; ++j) p[F.lane + 64 * j] = z; }
}
__device__ __forceinline__ void phase_prologue(Frame& F) {
    LAS float* sc = (LAS float*)F.lds;
    LAS float* part = (LAS float*)(F.lds + 40960);
    float* MOD = (float*)(F.ws + WS_MOD);
    for (int i = F.tid; i < 5 * 2048; i += NTHREADS) { const int v = i >> 11, k = i & 2047; const float x = v == 0 ? F.in[I_CCTX][k] : F.in[I_C][(v - 1) * 2048 + k]; sc[i] = x * sigm(x); }
    __syncthreads();
    for (int it = F.bid; it < 192; it += F.G) {
        const int l = it / 48, cg = it % 48; const float* W = F.in[I_WMOD] + (size_t)l * 2048 * 12288 + 256 * cg + 4 * F.lane;
        f32x4 acc[5];
#pragma unroll
        for (int v = 0; v < 5; ++v) acc[v] = (f32x4){0.f, 0.f, 0.f, 0.f};
        const int k0 = 256 * F.wave;
#pragma unroll 16
        for (int k = 0; k < 256; ++k) { const f32x4 w = *(const f32x4*)(W + (size_t)(k0 + k) * 12288);
#pragma unroll
            for (int v = 0; v < 5; ++v) acc[v] += sc[v * 2048 + k0 + k] * w; }
#pragma unroll
        for (int v = 0; v < 5; ++v) *(LAS f32x4*)(part + (F.wave * 5 + v) * 256 + 4 * F.lane) = acc[v];
        __syncthreads();
        for (int o = F.tid; o < 1280; o += NTHREADS) { const int v = o >> 8, col = o & 255; float s = F.in[I_BMOD][l * 12288 + 256 * cg + col];
#pragma unroll
            for (int w = 0; w < 8; ++w) s += part[(w * 5 + v) * 256 + col];
            MOD[((size_t)l * 5 + v) * 12288 + 256 * cg + col] = s; }
        __syncthreads();
    }
    for (int i = F.gw; i < NLAYER * 2 * 64; i += F.NGW) { const int layer = i >> 7, dir = (i >> 6) & 1, g = i & 63; const size_t pg = (size_t)(layer * 2 + dir) * 64 + g;
        s5::make_consts(F.ws + WS_S5C + (size_t)i * s5::CD_BYTES, dir == 0 ? F.ws + WS_S5G + ((size_t)layer * 64 + g) * s5::CG_BYTES : nullptr, F.in[I_LRE] + pg * 64, F.in[I_LIM] + pg * 64, expf(F.in[I_LSTEP][pg]),
                        F.in[I_BRE] + ((size_t)layer * 64 + g) * 1024, F.in[I_BIM] + ((size_t)layer * 64 + g) * 1024, F.in[I_CRE] + ((size_t)layer * 64 + g) * 1024, F.in[I_CIM] + ((size_t)layer * 64 + g) * 1024, F.lane); }
    if (F.bid == F.G - 1) {
        float2* tA = (float2*)(F.ws + WS_TAB); float2* tC = tA + 64 * 32;
        for (int i = F.tid; i < 64 * 32; i += NTHREADS) { const int pos = i >> 5, f = i & 31; const float a = (float)pos * expf(-(float)f * (9.210340371976184f / 32.0f)); float sn, cs; sincosf(a, &sn, &cs); tA[i] = make_float2(cs, sn); }
        for (int i = F.tid; i < 64 * 16; i += NTHREADS) { const int pos = i >> 4, f = i & 15; const float a = (float)pos * expf(-(float)f * (9.210340371976184f / 16.0f)); float sn, cs; sincosf(a, &sn, &cs); tC[i] = make_float2(cs, sn); }
    }
}
__device__ __forceinline__ void phase_norm(Frame& F, int layer, int which  , bool from_input) {
    float* X = (float*)(F.ws + WS_X); bf16* H = (bf16*)(F.ws + WS_H); const float* MOD = (const float*)(F.ws + WS_MOD) + (size_t)layer * 5 * 12288;
    const float* gw = F.in[which ? I_N2G : I_N1G] + layer * 2048;
    for (int m = F.gw; m < MROWS; m += F.NGW) {
        const float* src = from_input ? (m < MCTX ? F.in[I_XP] + (size_t)m * DM : F.in[I_XS] + (size_t)(m - MCTX) * DM) : X + (size_t)m * DM;
        const int mrow = m < MCTX ? 0 : 1 + ((m - MCTX) >> 11); const float* sh = MOD + mrow * 12288 + (which ? 3 : 0) * 2048; const float* scl = sh + 2048;
        f32x4 v[8]; float ss = 0.f;
#pragma unroll
        for (int j = 0; j < 8; ++j) { v[j] = *(const f32x4*)(src + 4 * F.lane + 256 * j); ss += v[j][0] * v[j][0] + v[j][1] * v[j][1] + v[j][2] * v[j][2] + v[j][3] * v[j][3]; }
        if (from_input) {
#pragma unroll
            for (int j = 0; j < 8; ++j) *(f32x4*)(X + (size_t)m * DM + 4 * F.lane + 256 * j) = v[j]; }
        const float rstd = rsqrtf(wave_sum(ss) * (1.0f / DM) + EPS);
#pragma unroll
        for (int j = 0; j < 8; ++j) { const int c = 4 * F.lane + 256 * j; const f32x4 g = *(const f32x4*)(gw + c), s1 = *(const f32x4*)(scl + c), s0 = *(const f32x4*)(sh + c);
            const f32x4 o = v[j] * rstd * g * (1.0f + s1) + s0; u32x2 w; w.x = pk2(o[0], o[1]); w.y = pk2(o[2], o[3]); *(u32x2*)(H + (size_t)m * DM + c) = w; }
    }
}
__device__ __forceinline__ void phase_final_norm(Frame& F) {
    const float* X = (const float*)(F.ws + WS_X); const float* gw = F.in[I_FING];
    for (int m = F.gw; m < MROWS; m += F.NGW) {
        f32x4 v[8]; float ss = 0.f;
#pragma unroll
        for (int j = 0; j < 8; ++j) { v[j] = *(const f32x4*)(X + (size_t)m * DM + 4 * F.lane + 256 * j); ss += v[j][0] * v[j][0] + v[j][1] * v[j][1] + v[j][2] * v[j][2] + v[j][3] * v[j][3]; }
        const float rstd = rsqrtf(wave_sum(ss) * (1.0f / DM) + EPS);
#pragma unroll
        for (int j = 0; j < 8; ++j) { const int c = 4 * F.lane + 256 * j; *(f32x4*)(F.out + O_YP + (size_t)m * DM + c) = v[j] * rstd * *(const f32x4*)(gw + c); }
    }
}
__device__ __forceinline__ void phase_prep(Frame& F, int layer) {
    const bf16* PROJ = (const bf16*)(F.ws + WS_PROJ);
    bf16* Q = (bf16*)(F.ws + WS_Q); bf16* KG = (bf16*)(F.ws + WS_KG); bf16* VG = (bf16*)(F.ws + WS_VG); bf16* AQ = (bf16*)(F.ws + WS_AQ); bf16* ACKV = (bf16*)(F.ws + WS_ACKV);
    bf16* KM = (bf16*)(F.ws + WS_KM); bf16* XBC = (bf16*)(F.ws + WS_XBC); float* DT = (float*)(F.ws + WS_DT);
    const float2* tA = (const float2*)(F.ws + WS_TAB); const float2* tC = tA + 64 * 32;
    const int lane = F.lane;
    for (int vr = F.gw; vr < KROWS; vr += F.NGW) {
        if (vr >= MROWS) {
            const int c = vr - MROWS, b = c >> 9, j = c & 511; const size_t kr = MCTX + (size_t)b * 2560 + 2048 + j; const size_t ci = ((size_t)b * 4 + layer) * 512 + j;
            { const f32x4 a = *(const f32x4*)(F.in[I_CGK] + ci * 256 + 4 * lane); u32x2 w; w.x = pk2(a[0], a[1]); w.y = pk2(a[2], a[3]); *(u32x2*)(KG + kr * 256 + 4 * lane) = w; }
            { const f32x4 a = *(const f32x4*)(F.in[I_CGV] + ci * 256 + 4 * lane); u32x2 w; w.x = pk2(a[0], a[1]); w.y = pk2(a[2], a[3]); *(u32x2*)(VG + kr * 256 + 4 * lane) = w; }
            { const f32x4 a = *(const f32x4*)(F.in[I_CCKV] + ci * 256 + 4 * lane); u32x2 w; w.x = pk2(a[0], a[1]); w.y = pk2(a[2], a[3]); *(u32x2*)(ACKV + kr * 256 + 4 * lane) = w; }
            { const bf16 kp = (bf16)f2bf(F.in[I_CKPE][ci * 64 + lane]);
#pragma unroll
              for (int hh = 0; hh < 8; ++hh) KM[kr * 1536 + hh * 192 + 128 + lane] = kp; }
            continue;
        }
        const int m = vr; const bool lat = m >= MCTX; const int bb = lat ? (m - MCTX) >> 11 : m >> 8; const int t = lat ? (m - MCTX) & 2047 : m & 255; const int L = lat ? 2048 : 256;
        const size_t kr = lat ? MCTX + (size_t)bb * 2560 + t : (size_t)m; const int rowpos = t >> 6, colpos = t & 63;
        const bf16* pr = PROJ + (size_t)m * NIN; const size_t orow = ((size_t)bb * 4 + layer) * 256 + t;
        const int j8 = lane & 7, ax = j8 >> 2, fo = (j8 & 3) * 8;
        const u32x4 ldq0 = *(const u32x4*)(pr + C_GQ + (lane >> 3) * 128 + ax * 64 + fo), ldq1 = *(const u32x4*)(pr + C_GQ + (lane >> 3) * 128 + ax * 64 + fo + 32);
        const u32x4 ldk0 = *(const u32x4*)(pr + C_GK + ((lane >> 3) & 1) * 128 + ax * 64 + fo), ldk1 = *(const u32x4*)(pr + C_GK + ((lane >> 3) & 1) * 128 + ax * 64 + fo + 32);
        const u32x4 ldv = *(const u32x4*)(pr + C_GV + 8 * (lane & 31));
        const u32x4 ldqd = *(const u32x4*)(pr + C_MQD + 8 * lane);
        const u32x4 ldck = *(const u32x4*)(pr + C_CKV + 8 * (lane & 31));
        const int axp = (lane >> 1) & 1, fop = (lane & 1) * 8;
        const u32x4 ldp0 = *(const u32x4*)(pr + C_KPE + axp * 32 + fop), ldp1 = *(const u32x4*)(pr + C_KPE + axp * 32 + fop + 16);
        u32x4 ldc[3][5];
#pragma unroll
        for (int i = 0; i < 3; ++i)
#pragma unroll
            for (int k = 0; k < 5; ++k) { const int tt = t + k - 2; const bool ok = tt >= 0 && tt < L; ldc[i][k] = *(const u32x4*)(pr + (ok ? (ptrdiff_t)(k - 2) * NIN : 0) + C_XBC + 8 * lane + 512 * i); if (!ok) ldc[i][k] = (u32x4){0u, 0u, 0u, 0u}; }
        const unsigned short lddt = pr[C_SDT + (lane & 31)];
        { const float2* tp = tA + (ax ? colpos : rowpos) * 32 + fo;
          { const int hq = lane >> 3; float x0[8], x1[8]; unpack8(ldq0, x0); unpack8(ldq1, x1);
            float ss = 0.f;
#pragma unroll
            for (int e = 0; e < 8; ++e) ss += x0[e] * x0[e] + x1[e] * x1[e];
            ss += __shfl_xor(ss, 1); ss += __shfl_xor(ss, 2); ss += __shfl_xor(ss, 4);
            const float rstd = rsqrtf(ss * (1.0f / 128.0f) + EPS); const float* gq = F.in[I_QNG] + layer * 128 + ax * 64 + fo;
#pragma unroll
            for (int e = 0; e < 8; ++e) { float a = x0[e] * rstd * gq[e], b = x1[e] * rstd * gq[32 + e]; if (lat) { const float2 cs = tp[e]; const float a2 = a * cs.x - b * cs.y; b = a * cs.y + b * cs.x; a = a2; } x0[e] = a; x1[e] = b; }
            bf16* q = Q + (size_t)m * 1024 + hq * 128 + ax * 64 + fo; *(u32x4*)q = pack8f(x0); *(u32x4*)(q + 32) = pack8f(x1); }
          { const int kh = (lane >> 3) & 1; float x0[8], x1[8]; unpack8(ldk0, x0); unpack8(ldk1, x1);
            float ss = 0.f;
#pragma unroll
            for (int e = 0; e < 8; ++e) ss += x0[e] * x0[e] + x1[e] * x1[e];
            ss += __shfl_xor(ss, 1); ss += __shfl_xor(ss, 2); ss += __shfl_xor(ss, 4);
            const float rstd = rsqrtf(ss * (1.0f / 128.0f) + EPS); const float* gk = F.in[I_KNG] + layer * 128 + ax * 64 + fo;
#pragma unroll
            for (int e = 0; e < 8; ++e) { x0[e] *= rstd * gk[e]; x1[e] *= rstd * gk[32 + e]; }
            if (lane < 16) {
            if (!lat) { float* o = F.out + O_GK + orow * 256 + kh * 128 + ax * 64 + fo; *(f32x4*)o = (f32x4){x0[0], x0[1], x0[2], x0[3]}; *(f32x4*)(o + 4) = (f32x4){x0[4], x0[5], x0[6], x0[7]};
                        *(f32x4*)(o + 32) = (f32x4){x1[0], x1[1], x1[2], x1[3]}; *(f32x4*)(o + 36) = (f32x4){x1[4], x1[5], x1[6], x1[7]}; }
            else {
#pragma unroll
                for (int e = 0; e < 8; ++e) { const float2 cs = tp[e]; const float a = x0[e], b = x1[e]; x0[e] = a * cs.x - b * cs.y; x1[e] = a * cs.y + b * cs.x; } }
            bf16* k = KG + kr * 256 + kh * 128 + ax * 64 + fo; *(u32x4*)k = pack8f(x0); *(u32x4*)(k + 32) = pack8f(x1); } }
          if (lane < 32) { *(u32x4*)(VG + kr * 256 + 8 * lane) = ldv;
            if (!lat) { float x[8]; unpack8(ldv, x); float* o = F.out + O_GV + orow * 256 + 8 * lane; *(f32x4*)o = (f32x4){x[0], x[1], x[2], x[3]}; *(f32x4*)(o + 4) = (f32x4){x[4], x[5], x[6], x[7]}; } }
        }
        { float x[8]; unpack8(ldqd, x); float ss = 0.f;
#pragma unroll
          for (int e = 0; e < 8; ++e) ss += x[e] * x[e];
          const float rstd = rsqrtf(wave_sum(ss) * (1.0f / 512.0f) + EPS); const float* g = F.in[I_MQNG] + layer * 512 + 8 * lane;
#pragma unroll
          for (int e = 0; e < 8; ++e) x[e] *= rstd * g[e];
          *(u32x4*)(AQ + (size_t)m * 512 + 8 * lane) = pack8f(x); }
        { float x[8]; float ss = 0.f; unpack8(ldck, x);
          if (lane < 32) {
#pragma unroll
            for (int e = 0; e < 8; ++e) ss += x[e] * x[e]; }
          ss = wave_sum(ss);
          if (lane < 32) { const float rstd = rsqrtf(ss * (1.0f / 256.0f) + EPS); const float* g = F.in[I_MKVNG] + layer * 256 + 8 * lane;
#pragma unroll
            for (int e = 0; e < 8; ++e) x[e] *= rstd * g[e];
            *(u32x4*)(ACKV + kr * 256 + 8 * lane) = pack8f(x);
            if (!lat) { float* o = F.out + O_CKV + orow * 256 + 8 * lane; *(f32x4*)o = (f32x4){x[0], x[1], x[2], x[3]}; *(f32x4*)(o + 4) = (f32x4){x[4], x[5], x[6], x[7]}; } }
          if (lane < 4) { float x0[8], x1[8]; unpack8(ldp0, x0); unpack8(ldp1, x1);
            if (!lat) { float* o = F.out + O_KPE + orow * 64 + axp * 32 + fop; *(f32x4*)o = (f32x4){x0[0], x0[1], x0[2], x0[3]}; *(f32x4*)(o + 4) = (f32x4){x0[4], x0[5], x0[6], x0[7]};
                        *(f32x4*)(o + 16) = (f32x4){x1[0], x1[1], x1[2], x1[3]}; *(f32x4*)(o + 20) = (f32x4){x1[4], x1[5], x1[6], x1[7]}; }
            else { const float2* tp = tC + (axp ? colpos : rowpos) * 16 + fop;
#pragma unroll
                for (int e = 0; e < 8; ++e) { const float2 cs = tp[e]; const float a = x0[e], b = x1[e]; x0[e] = a * cs.x - b * cs.y; x1[e] = a * cs.y + b * cs.x; } }
            const u32x4 w0 = pack8f(x0), w1 = pack8f(x1);
#pragma unroll
            for (int hh = 0; hh < 8; ++hh) { bf16* k = KM + kr * 1536 + hh * 192 + 128 + axp * 32 + fop; *(u32x4*)k = w0; *(u32x4*)(k + 16) = w1; } }
        }
        { const float* cw = F.in[I_CONVW] + (size_t)layer * 5 * 1536; const float* cb = F.in[I_CONVB] + layer * 1536;
#pragma unroll
          for (int i = 0; i < 3; ++i) { const int ch = 8 * lane + 512 * i; float acc[8];
            { const f32x4 b0 = *(const f32x4*)(cb + ch), b1 = *(const f32x4*)(cb + ch + 4); acc[0] = b0[0]; acc[1] = b0[1]; acc[2] = b0[2]; acc[3] = b0[3]; acc[4] = b1[0]; acc[5] = b1[1]; acc[6] = b1[2]; acc[7] = b1[3]; }
#pragma unroll
            for (int k = 0; k < 5; ++k) { float x[8]; unpack8(ldc[i][k], x);
                const f32x4 w0 = *(const f32x4*)(cw + k * 1536 + ch), w1 = *(const f32x4*)(cw + k * 1536 + ch + 4);
                acc[0] += w0[0] * x[0]; acc[1] += w0[1] * x[1]; acc[2] += w0[2] * x[2]; acc[3] += w0[3] * x[3]; acc[4] += w1[0] * x[4]; acc[5] += w1[1] * x[5]; acc[6] += w1[2] * x[6]; acc[7] += w1[3] * x[7]; }
#pragma unroll
            for (int e = 0; e < 8; ++e) acc[e] = acc[e] * sigm(acc[e]);
            *(u32x4*)(XBC + (size_t)m * 1536 + ch) = pack8f(acc); }
          if (lane < 32) { const float raw = __uint_as_float((unsigned)lddt << 16) + F.in[I_DTB][layer * 32 + lane]; const float ey = __expf(raw); DT[(size_t)m * 32 + lane] = raw > 20.f ? raw : (ey < 1e-3f ? ey * (1.0f - 0.5f * ey) : __logf(1.0f + ey)); }
        }
    }
    { LAS unsigned char* wl = F.lds + F.wave * s5::WAVE_LDS; float* S5E = (float*)(F.ws + WS_S5E);
      for (int e = F.gw; e < 4096; e += F.NGW) { const int b = e >> 10, seg = (e >> 7) & 7, g = (e >> 1) & 63, dir = e & 1;
        s5::Ctx c; s5::load_ctx(c, F.ws + WS_S5C + (size_t)((layer * 2 + dir) * 64 + g) * s5::CD_BYTES, nullptr, lane, false);
        float hr = 0.f, hi = 0.f;
        s5::s5_epass(c, wl, lane, dir, PROJ + (size_t)(MCTX + b * 2048 + seg * 256) * NIN + C_S5U + g * 16, NIN, hr, hi);
        float* eo = S5E + ((((size_t)b * 8 + seg) * 64 + g) * 2 + dir) * 128; eo[lane] = hr; eo[64 + lane] = hi; } }
}
__device__ __forceinline__ void phase_ssd_finish(Frame& F, int layer) {
    const bf16* PROJ = (const bf16*)(F.ws + WS_PROJ); const bf16* XBC = (const bf16*)(F.ws + WS_XBC); const bf16* YF = (const bf16*)(F.ws + WS_YF); const bf16* YB = (const bf16*)(F.ws + WS_YB);
    bf16* OB = (bf16*)(F.ws + WS_O) + (size_t)1 * MROWS * 1024; const int lane = F.lane;
    const float dh = F.in[I_SSDD][layer * 16 + (lane >> 2)]; const float* g = F.in[I_SSDNG] + layer * 1024 + 16 * lane;
    for (int m = F.gw; m < MROWS; m += F.NGW) {
        float x[16], z[16], y[16]; unpack8(*(const u32x4*)(XBC + (size_t)m * 1536 + 16 * lane), x); unpack8(*(const u32x4*)(XBC + (size_t)m * 1536 + 16 * lane + 8), x + 8);
        unpack8(*(const u32x4*)(PROJ + (size_t)m * NIN + C_SZ + 16 * lane), z); unpack8(*(const u32x4*)(PROJ + (size_t)m * NIN + C_SZ + 16 * lane + 8), z + 8);
        float ss = 0.f; float yf[16], yb[16];
        unpack8(*(const u32x4*)(YF + (size_t)m * 1024 + 16 * lane), yf); unpack8(*(const u32x4*)(YF + (size_t)m * 1024 + 16 * lane + 8), yf + 8);
        unpack8(*(const u32x4*)(YB + (size_t)m * 1024 + 16 * lane), yb); unpack8(*(const u32x4*)(YB + (size_t)m * 1024 + 16 * lane + 8), yb + 8);
#pragma unroll
        for (int i = 0; i < 16; ++i) { const float v = (yf[i] + yb[i] + dh * x[i]) * (z[i] * sigm(z[i])); y[i] = v; ss += v * v; }
        const float rstd = rsqrtf(wave_sum(ss) * (1.0f / 1024.0f) + EPS);
#pragma unroll
        for (int i = 0; i < 16; ++i) y[i] *= rstd * g[i];
        *(u32x4*)(OB + (size_t)m * 1024 + 16 * lane) = pack8f(y); *(u32x4*)(OB + (size_t)m * 1024 + 16 * lane + 8) = pack8f(y + 8);
    }
}
struct ConvItem { const float* src; bf16* dst; int K, N, mode, half, k0, n0; };
typedef float cvf4 __attribute__((ext_vector_type(4)));
__device__ __forceinline__ const float* conv_ptr(const ConvItem& c, int lane) { const int n4 = c.n0 + 4 * (lane & 15); return c.src + (size_t)(c.k0 + 8 * (lane >> 4)) * c.N + (n4 < c.N ? n4 : c.N - 4); }
__device__ __forceinline__ void conv_load1(const float* p, size_t N, int i, float (&w)[32]) { const cvf4 v = *(const cvf4*)(p + (size_t)i * N); w[4 * i] = v[0]; w[4 * i + 1] = v[1]; w[4 * i + 2] = v[2]; w[4 * i + 3] = v[3]; }
__device__ __forceinline__ void conv_load(const ConvItem& c, int lane, float (&w)[32]) {
    const float* p = conv_ptr(c, lane);
#pragma unroll
    for (int i = 0; i < 8; ++i) conv_load1(p, (size_t)c.N, i, w);
}
__device__ __forceinline__ void conv_store(const ConvItem& c, int lane, const float (&w)[32]) {
    const int n4 = c.n0 + 4 * (lane & 15);
    if (n4 < c.N) {
#pragma unroll
        for (int j = 0; j < 4; ++j) { const int n = n4 + j; const int row = c.mode == 0 ? n : (c.mode == 1 ? map_in(n) : map_pair(n, c.half)); bf16* d = c.dst + (size_t)row * c.K + c.k0 + 8 * (lane >> 4);
            u32x4 o; o.x = pk2(w[j], w[4 + j]); o.y = pk2(w[8 + j], w[12 + j]); o.z = pk2(w[16 + j], w[20 + j]); o.w = pk2(w[24 + j], w[28 + j]); *(u32x4*)d = o; } }
}
constexpr int CV_A0 = 64 * 176, CV_A1 = CV_A0 + 176 * 32, CV_A2 = CV_A1 + 64 * 32, CV_A3 = CV_A2 + 4 * 32 * 32, CV_A4 = CV_A3 + 32 * 32;
constexpr int CV_B0 = 64 * 222, CV_B1 = CV_B0 + 16 * 24, CV_B2 = CV_B1 + 8 * 32;
__device__ __forceinline__ ConvItem conv_decode(int set, int it, int layer, const float* const* in, unsigned char* ws) {
    ConvItem c; char* WB = (char*)(ws + WS_W);
    if (set == 0) {
        if (it < CV_A0) { c.src = in[I_WFI] + (size_t)layer * 2048 * 11264; c.dst = (bf16*)(WB + W_FI); c.K = 2048; c.N = 11264; c.mode = 2; c.half = 5632; c.k0 = 32 * (it / 176); c.n0 = 64 * (it % 176); }
        else if (it < CV_A1) { const int r = it - CV_A0; c.src = in[I_WFO] + (size_t)layer * 5632 * 2048; c.dst = (bf16*)(WB + W_FO); c.K = 5632; c.N = 2048; c.mode = 0; c.half = 0; c.k0 = 32 * (r / 32); c.n0 = 64 * (r % 32); }
        else if (it < CV_A2) { const int r = it - CV_A1; c.src = in[I_WOUT] + (size_t)layer * 2048 * 2048; c.dst = (bf16*)(WB + W_OUT); c.K = 2048; c.N = 2048; c.mode = 0; c.half = 0; c.k0 = 32 * (r / 32); c.n0 = 64 * (r % 32); }
        else if (it < CV_A3) { const int r = it - CV_A2, br = r >> 10, q = r & 1023; c.src = in[I_WBR] + ((size_t)layer * 4 + br) * 1024 * 2048; c.dst = (bf16*)(WB + W_BR) + (size_t)br * 2048 * 1024; c.K = 1024; c.N = 2048; c.mode = 0; c.half = 0; c.k0 = 32 * (q / 32); c.n0 = 64 * (q % 32); }
        else { const int r = it - CV_A3; c.src = in[I_WGLU] + (size_t)layer * 1024 * 2048; c.dst = (bf16*)(WB + W_GLU); c.K = 1024; c.N = 2048; c.mode = 2; c.half = 1024; c.k0 = 32 * (r / 32); c.n0 = 64 * (r % 32); }
    } else {
        if (it < CV_B0) { c.src = in[I_WIN] + (size_t)layer * 2048 * 14176; c.dst = (bf16*)(WB + W_IN); c.K = 2048; c.N = 14176; c.mode = 1; c.half = 0; c.k0 = 32 * (it / 222); c.n0 = 64 * (it % 222); }
        else if (it < CV_B1) { const int r = it - CV_B0; c.src = in[I_WUQ] + (size_t)layer * 512 * 1536; c.dst = (bf16*)(WB + W_UQ); c.K = 512; c.N = 1536; c.mode = 0; c.half = 0; c.k0 = 32 * (r / 24); c.n0 = 64 * (r % 24); }
        else { const int r = it - CV_B1; c.src = in[I_WUKV] + (size_t)layer * 256 * 2048; c.dst = (bf16*)(WB + W_UKV); c.K = 256; c.N = 2048; c.mode = 0; c.half = 0; c.k0 = 32 * (r / 32); c.n0 = 64 * (r % 32); }
    }
    return c;
}
__device__ __forceinline__ void conv_run(int set, int layer, int first, int stride, const float* const* in, unsigned char* ws, int lane) {
    const int total = set == 0 ? CV_A4 : CV_B2;
    for (int it = first; it < total; it += stride) { const ConvItem c = conv_decode(set, it, layer, in, ws); float w[32]; conv_load(c, lane, w); conv_store(c, lane, w); }
}
struct AttnConv {
    const float* const* in; unsigned char* ws; int layer, gw, NGW, total, cnt, lane;
    ConvItem c; bool on;
    __device__ __forceinline__ void begin(float (&w)[32]) {
        const int it = cnt * NGW + gw; on = it < total;
        if (on) { ++cnt; c = it < CV_A4 ? conv_decode(0, it, layer, in, ws) : conv_decode(1, it - CV_A4, layer + 1, in, ws); conv_load(c, lane, w); }
    }
    __device__ __forceinline__ void end(const float (&w)[32]) { if (on) { conv_store(c, lane, w); on = false; } }
    __device__ __forceinline__ bool pending() const { return on; }
    static constexpr bool RIDES = true;
    __device__ __forceinline__ void decode() { const int it = cnt * NGW + gw; on = it < total; const int ic = on ? it : total - 1; cnt += on ? 1 : 0; c = ic < CV_A4 ? conv_decode(0, ic, layer, in, ws) : conv_decode(1, ic - CV_A4, layer + 1, in, ws); }
    __device__ __forceinline__ void part(float (&w)[32], int i) { conv_load1(conv_ptr(c, lane), (size_t)c.N, i, w); }
    __device__ __forceinline__ void rest(float (&w)[32]) { const float* p = conv_ptr(c, lane);
#pragma unroll
        for (int i = 4; i < 8; ++i) conv_load1(p, (size_t)c.N, i, w); }
    __device__ __forceinline__ void finish() { for (int it = cnt * NGW + gw; it < total; it += NGW) { const ConvItem ci = it < CV_A4 ? conv_decode(0, it, layer, in, ws) : conv_decode(1, it - CV_A4, layer + 1, in, ws); float w[32]; conv_load(ci, lane, w); conv_store(ci, lane, w); } }
};
struct NoConv { static constexpr bool RIDES = false; __device__ __forceinline__ void begin(float (&)[32]) {} __device__ __forceinline__ void end(const float (&)[32]) {} __device__ __forceinline__ bool pending() const { return false; }
    __device__ __forceinline__ void decode() {} __device__ __forceinline__ void part(float (&)[32], int) {} __device__ __forceinline__ void rest(float (&)[32]) {} };
template <class Epi> struct EpiConv {
    static constexpr bool PERM = Epi::PERM, AFTER_DRAIN = false;
    Epi e; const float* const* in; unsigned char* ws; int layer, set, gw, NGW, total, first; mutable int cnt;
    __device__ __forceinline__ bool keep(const pg8::Unit& u) const { return e.keep(u); }
    template <class ACC> __device__ __forceinline__ void operator()(ACC& acc, const pg8::Unit& u, int wr, int wc, int fr, int fq) const {
        const int it = first + cnt * NGW + gw; ++cnt; const bool on = it < total; const int lane = threadIdx.x & 63;
        ConvItem c; float w[32];
        if (on) { c = conv_decode(set, it, layer, in, ws); conv_load(c, lane, w); }
        e(acc, u, wr, wc, fr, fq);
        if (on) conv_store(c, lane, w);
    }
};
#define XB_TMO      128
#define XB_XCNT(j)  (256  + 64 * (j))
#define XB_XSUB(j)  (1280 + 64 * (j))
#define XB_XGEN(j)  (2304 + 64 * (j))
#define XB_TOP      3328
#define XB_TOPGEN   3392
#define XCD_BAR_WORDS 3456
#define XB_SPIN_CAP (1u << 18)

__device__ __forceinline__ unsigned xb_ld(unsigned* p)              { return __hip_atomic_load(p, __ATOMIC_RELAXED, __HIP_MEMORY_SCOPE_AGENT); }
__device__ __forceinline__ unsigned xb_add(unsigned* p, unsigned v) { return __hip_atomic_fetch_add(p, v, __ATOMIC_RELAXED, __HIP_MEMORY_SCOPE_AGENT); }
__device__ __forceinline__ unsigned xb_xcc_id() { return (unsigned)__builtin_amdgcn_s_getreg((3 << 11) | 20) & 0xFu; }
#define XB_SPIN(cond, bar) do { unsigned _sp = 0; while (cond) { __builtin_amdgcn_s_sleep(1); \
    if ((++_sp & 255u) == 0u) { if (xb_ld(&(bar)[XB_TMO])) break; if (_sp > XB_SPIN_CAP) { atomicAdd(&(bar)[XB_TMO], 1u); break; } } } } while (0)

struct XcdBarrier {
    unsigned* bar; unsigned x;
    volatile LAS unsigned* st;
};

__device__ __forceinline__ XcdBarrier xcd_barrier_post(unsigned* bar, volatile LAS unsigned* st) {
    XcdBarrier b; b.bar = bar; b.x = xb_xcc_id(); b.st = st;
    if (threadIdx.x == 0) (void)xb_add(&bar[XB_XCNT(b.x)], 1u);
    return b;
}
__device__ __forceinline__ void xcd_barrier_complete(unsigned* bar, unsigned x, unsigned& nloc, unsigned& nx) {
    const unsigned G = gridDim.x * gridDim.y * gridDim.z;
    unsigned sum, cnt, mine, sp = 0u;
    for (;;) {
        sum = 0u; cnt = 0u; mine = 0u;
#pragma unroll
        for (unsigned j = 0; j < 16; ++j) { const unsigned c = xb_ld(&bar[XB_XCNT(j)]); sum += c; cnt += (c > 0u) ? 1u : 0u; mine = (j == x) ? c : mine; }
        if (sum == G) break;
        __builtin_amdgcn_s_sleep(1);
        if ((++sp & 255u) == 0u) { if (xb_ld(&bar[XB_TMO])) break; if (sp > XB_SPIN_CAP) { atomicAdd(&bar[XB_TMO], 1u); break; } }
    }
    nloc = mine > 0u ? mine : 1u; nx = cnt > 0u ? cnt : 1u;
}

__device__ __forceinline__ void xcd_barrier(const XcdBarrier& b) {
    asm volatile("s_waitcnt vmcnt(0)" ::: "memory");
    __syncthreads();
    if (threadIdx.x == 0) {
        unsigned* bar = b.bar;
        __builtin_amdgcn_s_waitcnt(0);
        unsigned nloc = b.st[0], nx = b.st[1];
        if (nloc == 0u) { xcd_barrier_complete(bar, b.x, nloc, nx); b.st[0] = nloc; b.st[1] = nx; }
        const unsigned old = xb_add(&bar[XB_XSUB(b.x)], 1u);
        const unsigned gen = old / nloc;
        if (old + 1u == (gen + 1u) * nloc) {
            __builtin_amdgcn_fence(__ATOMIC_RELEASE, "agent");
            asm volatile("s_waitcnt vmcnt(0)" ::: "memory");
            const unsigned og = xb_add(&bar[XB_TOP], 1u);
            const unsigned tg = og / nx;
            if (og + 1u == (tg + 1u) * nx) xb_add(&bar[XB_TOPGEN], 1u);
            else XB_SPIN(xb_ld(&bar[XB_TOPGEN]) == tg, bar);
            __builtin_amdgcn_fence(__ATOMIC_ACQUIRE, "agent");
            xb_add(&bar[XB_XGEN(b.x)], 1u);
            asm volatile("s_waitcnt vmcnt(0)" ::: "memory");
        } else {
            XB_SPIN(xb_ld(&bar[XB_XGEN(b.x)]) == gen, bar);
            __builtin_amdgcn_fence(__ATOMIC_ACQUIRE, "agent");
            asm volatile("s_waitcnt vmcnt(0)" ::: "memory");
        }
    }
    __syncthreads();
}
#ifndef MLA_SDEPTH
#define MLA_SDEPTH 1
#endif
constexpr int NPHASE = 42;
#ifndef MK_N_LAUNCHES
#define MK_N_LAUNCHES 1
#endif
__device__ __forceinline__ void run_attn_gqa(Frame& F, int layer) {
    AttnConv cv; cv.in = F.in; cv.ws = F.ws; cv.layer = layer; cv.gw = F.gw; cv.NGW = F.NGW; cv.total = CV_A4 + (layer + 1 < NLAYER ? CV_B0 : 0); cv.cnt = 0; cv.lane = F.lane; cv.on = false;
    const bf16* Q = (const bf16*)(F.ws + WS_Q); const bf16* KG = (const bf16*)(F.ws + WS_KG); const bf16* VG = (const bf16*)(F.ws + WS_VG); bf16* OA = (bf16*)(F.ws + WS_O);
    for (int u = F.bid; u < 512; u += F.G) {
        size_t qrow, krow; int hq, seq;
        if (u < 256) { const int b = u >> 6, qb = u & 7; hq = (u >> 3) & 7; qrow = MCTX + (size_t)b * 2048 + qb * 256; krow = MCTX + (size_t)b * 2560; seq = 2560; }
        else { const int v = u - 256, b = v >> 3; hq = v & 7; qrow = (size_t)b * 256; krow = qrow; seq = 256; }
        att::attn_body_simple<128, 1024, 256, 256, 1024>(Q + qrow * 1024 + hq * 128, KG + krow * 256 + (hq >> 2) * 128, VG + krow * 256 + (hq >> 2) * 128, OA + qrow * 1024 + hq * 128, seq, (char*)F.lds, cv);
    }
    cv.finish();
}
__device__ __forceinline__ void run_attn_mla(Frame& F) {
    const bf16* QM = (const bf16*)(F.ws + WS_QM); const bf16* KM = (const bf16*)(F.ws + WS_KM); const bf16* VM = (const bf16*)(F.ws + WS_VM); bf16* OC = (bf16*)(F.ws + WS_O) + (size_t)2 * MROWS * 1024;
    for (int u = F.bid; u < 512; u += F.G) {
        size_t qrow, krow; int hq, seq;
        if (u < 256) { const int b = u >> 6, qb = u & 7; hq = (u >> 3) & 7; qrow = MCTX + (size_t)b * 2048 + qb * 256; krow = MCTX + (size_t)b * 2560; seq = 2560; }
        else { const int v = u - 256, b = v >> 3; hq = v & 7; qrow = (size_t)b * 256; krow = qrow; seq = 256; }
        NoConv nc; att::attn_body_simple<192, 1536, 1536, 1024, 1024>(QM + qrow * 1536 + hq * 192, KM + krow * 1536 + hq * 192, VM + krow * 1024 + hq * 128, OC + qrow * 1024 + hq * 128, seq, (char*)F.lds, nc);
    }
}
__device__ __forceinline__ void run_ssd(Frame& F, int layer) {
    const bf16* XBC = (const bf16*)(F.ws + WS_XBC); const float* DT = (const float*)(F.ws + WS_DT); bf16* YF = (bf16*)(F.ws + WS_YF); bf16* YB = (bf16*)(F.ws + WS_YB);
    for (int u = F.bid; u < 128; u += F.G) { const int b = u >> 5, h = (u >> 1) & 15, dir = u & 1;
        const float a_h = -expf(F.in[I_ALOG][(layer * 2 + dir) * 16 + h]);
        ssd::ssd_unit(F.lds, XBC, DT, dir ? YB : YF, MCTX + b * 2048, 16, h, dir, a_h, F.in[I_SSSD] + ((((size_t)b * 4 + layer) * 2 + dir) * 16 + h) * 8192, nullptr); }
    const int c0 = F.G > 128 ? F.bid - 128 : F.bid, cs = F.G > 128 ? F.G - 128 : F.G;
    if (c0 >= 0) for (int v = c0; v < 1024; v += cs) { const int b = v >> 5, h = (v >> 1) & 15, dir = v & 1;
        const float a_h = -expf(F.in[I_ALOG][(layer * 2 + dir) * 16 + h]);
        ssd::ssd_unit(F.lds, XBC, DT, dir ? YB : YF, b * 256, 2, h, dir, a_h, nullptr, F.out + O_SSD + ((((size_t)b * 4 + layer) * 2 + dir) * 16 + h) * 8192); }
}
__device__ __forceinline__ void s5_entry_state(Frame& F, const unsigned char* cd, const float* S5E, int b, int seg, int g, int layer, int dir, int lane, float& hr, float& hi) {
    const float* h0 = F.in[I_SS5] + ((((size_t)b * 4 + layer) * 2 + dir) * 2) * 4096 + g * 64; hr = h0[lane]; hi = h0[4096 + lane];
    const float zr = ((const float*)cd)[128 + lane], zi = ((const float*)cd)[192 + lane];
    const int n = dir ? 7 - seg : seg;
    float er[7], ei[7];
#pragma unroll
    for (int q = 0; q < 7; ++q) { const int qq = q < n ? q : 0; const int sp = dir ? 7 - qq : qq; const float* e = S5E + ((((size_t)b * 8 + sp) * 64 + g) * 2 + dir) * 128; er[q] = e[lane]; ei[q] = e[64 + lane]; }
#pragma unroll
    for (int q = 0; q < 7; ++q) { const float nr = zr * hr - zi * hi + er[q], ni = zr * hi + zi * hr + ei[q]; if (q < n) { hr = nr; hi = ni; } }
}
__device__ __forceinline__ void run_s5(Frame& F, int layer) {
    const bf16* PROJ = (const bf16*)(F.ws + WS_PROJ); bf16* S5PRE = (bf16*)(F.ws + WS_S5PRE); const float* S5E = (const float*)(F.ws + WS_S5E);
    LAS unsigned char* wl = F.lds + F.wave * s5::WAVE_LDS;
    for (int u = F.gw; u < 4096; u += F.NGW) {
        int lane_ = F.lane; asm volatile("" : "+v"(lane_)); const int lane = lane_;
        const int s = u >> 6, g = u & 63; const bool lat = s >= 32; const int b = lat ? (s - 32) >> 3 : s, seg = lat ? (s - 32) & 7 : 0;
        const size_t row0 = lat ? MCTX + (size_t)b * 2048 + seg * 256 : (size_t)b * 256;
        const unsigned char* cd0 = F.ws + WS_S5C + (size_t)((layer * 2 + 0) * 64 + g) * s5::CD_BYTES; const unsigned char* cd1 = cd0 + 64 * s5::CD_BYTES; const unsigned char* cg = F.ws + WS_S5G + ((size_t)layer * 64 + g) * s5::CG_BYTES;
        const bf16* U = PROJ + row0 * NIN + C_S5U + g * 16; bf16* outp = S5PRE + row0 * 1024 + g * 16;
        const float dch = F.in[I_S5D][layer * 1024 + g * 16 + (lane & 15)];
        s5::Ctx c;
        float hfr = 0.f, hfi = 0.f, hbr = 0.f, hbi = 0.f;
        if (lat) { s5_entry_state(F, cd0, S5E, b, seg, g, layer, 0, lane, hfr, hfi); s5_entry_state(F, cd1, S5E, b, seg, g, layer, 1, lane, hbr, hbi); }
        { s5::load_ctx(c, cd0, cg, lane, true);
          s5::s5_pass<false>(c, wl, lane, 0, U, NIN, outp, dch, hfr, hfi);
          if (!lat) { float* ho = F.out + O_S5 + ((((size_t)b * 4 + layer) * 2 + 0) * 2) * 4096 + g * 64; ho[lane] = hfr; ho[4096 + lane] = hfi; } }
        { s5::load_ctx(c, cd1, cg, lane, false);
          s5::s5_pass<true>(c, wl, lane, 1, U, NIN, outp, dch, hbr, hbi);
          if (!lat) { float* ho = F.out + O_S5 + ((((size_t)b * 4 + layer) * 2 + 1) * 2) * 4096 + g * 64; ho[lane] = hbr; ho[4096 + lane] = hbi; } }
    }
}
__device__ __forceinline__ bool launder(Frame& F) {
    asm volatile("" : "+v"(F.tid), "+v"(F.lane)); return true; }
__global__ void __launch_bounds__(NTHREADS, 2) skel_fwd(Args args) {
    extern __shared__ __attribute__((aligned(16))) unsigned char lds_raw[];
    Frame F;
    F.lds = (LAS unsigned char*)lds_raw;
    F.tid = threadIdx.x; F.lane = F.tid & 63; F.wave = __builtin_amdgcn_readfirstlane(F.tid >> 6);
    F.G = gridDim.x; F.bid = blockIdx.x; F.gw = F.bid * NWAVES + F.wave; F.NGW = F.G * NWAVES;
    F.in0 = args.in; F.out0 = args.out; F.ws0 = args.ws; F.in = F.in0; F.out = F.out0; F.ws = F.ws0;
    for (int u = F.tid; u < (LDS_BYTES - LDSCTL_OFF) / 4; u += NTHREADS) ((LAS unsigned*)(F.lds + LDSCTL_OFF))[u] = 0u;
    __syncthreads();
    const int lo = args.ph_lo, hi = args.ph_hi;
    unsigned* barw = (unsigned*)(F.ws + WS_CTL) + CW_BAR + args.li * XCD_BAR_WORDS;
    XcdBarrier bar; bar.bar = barw; bar.x = 0; bar.st = nullptr;
    if (hi - lo > 1) bar = xcd_barrier_post(barw, (volatile LAS unsigned*)(F.lds + MISC_OFF) + 8);
#ifndef SUB_MASK
#define SUB_MASK 0xffu
#endif
#define SUBON(b) (((SUB_MASK) >> (b)) & 1u)
#ifndef REP_MASK
#define REP_MASK 0u
#endif
#define REP(b) for (int rep_ = 0; rep_ < 1 + (int)(((REP_MASK) >> (b)) & 1u); ++rep_)
#ifndef PH_MASK
#define PH_MASK 0xffffffffu
#endif
#define IN(k) (lo <= (k) && (k) < hi)
#define INJ(j) ((((PH_MASK) >> (j)) & 1u) && IN(pb + (j)) && launder(F))
#define SEAM(k) do { if (IN(k) && IN((k) + 1)) xcd_barrier(bar); } while (0)
    bf16* WB = (bf16*)(F.ws + WS_W);
    bf16* const Win = (bf16*)((char*)WB + W_IN); bf16* const Wuq = (bf16*)((char*)WB + W_UQ); bf16* const Wukv = (bf16*)((char*)WB + W_UKV); bf16* const Wglu = (bf16*)((char*)WB + W_GLU);
    bf16* const Wbr = (bf16*)((char*)WB + W_BR); bf16* const Wout = (bf16*)((char*)WB + W_OUT); bf16* const Wfi = (bf16*)((char*)WB + W_FI); bf16* const Wfo = (bf16*)((char*)WB + W_FO);
    bf16* const H = (bf16*)(F.ws + WS_H); bf16* const PROJ = (bf16*)(F.ws + WS_PROJ); float* const X = (float*)(F.ws + WS_X);

    if (((PH_MASK >> 11) & 1u) && IN(0)) { phase_prologue(F); conv_run(1, 0, F.gw, F.NGW, F.in, F.ws, F.lane); phase_zero_pad(F); } SEAM(0);
    for (int layer = 0; layer < NLAYER; ++layer) {
        const int pb = 1 + 10 * layer; const float* MODL = (const float*)(F.ws + WS_MOD) + (size_t)layer * 5 * 12288;
        if (INJ(0)) { REP(9) phase_norm(F, layer, 0, layer == 0); } SEAM(pb + 0);
        if (INJ(1)) { pg8::Gemm g{H, Win, MROWS, NIN, 2048}; pg8::StaticOrder S; S.init(MROWS, NIN, F.G, F.bid);
            pg8::EpiInProj E{PROJ, NIN, 32};
            pg8::gemm_phase<pg8::EpiInProj, pg8::StaticOrder, true, true>(F.lds, g, S, E); } SEAM(pb + 1);
        if (INJ(2)) { REP(10) phase_prep(F, layer); } SEAM(pb + 2);
        if (INJ(3)) {
            if (SUBON(0)) { pg8::Gemm g{(bf16*)(F.ws + WS_AQ), Wuq, MROWS, 1536, 512}; pg8::StaticOrder S; S.init(MROWS, 1536, F.G, F.bid); pg8::EpiMlaQ E{(bf16*)(F.ws + WS_QM), (const float2*)(F.ws + WS_TAB) + 64 * 32};
              REP(15) pg8::gemm_phase<pg8::EpiMlaQ, pg8::StaticOrder, true, true>(F.lds, g, S, E); }
            if (SUBON(1)) { pg8::Gemm g{(bf16*)(F.ws + WS_ACKV), Wukv, KROWS, 2048, 256}; pg8::StaticOrder S; S.init(KROWS, 2048, F.G, (F.bid + (F.G >> 2)) % F.G  ); pg8::EpiMlaKV E{(bf16*)(F.ws + WS_KM), (bf16*)(F.ws + WS_VM)};
              REP(15) pg8::gemm_phase<pg8::EpiMlaKV, pg8::StaticOrder, true, true>(F.lds, g, S, E); }
            if (SUBON(2)) run_attn_gqa(F, layer);
            if (SUBON(3)) REP(3) run_ssd(F, layer);
            if (SUBON(4)) REP(4) run_s5(F, layer);
        } SEAM(pb + 3);
        if (INJ(4)) { if (SUBON(5)) REP(5) run_attn_mla(F); if (SUBON(6)) REP(6) phase_ssd_finish(F, layer);
            { pg8::Gemm g{(bf16*)(F.ws + WS_S5PRE), Wglu, MROWS, 2048, 1024}; pg8::StaticOrder S; S.init(MROWS, 2048, F.G, F.bid); pg8::EpiGated<0> E{(bf16*)(F.ws + WS_O) + (size_t)3 * MROWS * 1024, 1024};
              REP(15) pg8::gemm_phase<pg8::EpiGated<0>, pg8::StaticOrder, true, true>(F.lds, g, S, E); } } SEAM(pb + 4);
        if (INJ(5)) { pg8::Gemm g{(bf16*)(F.ws + WS_O), Wbr, 4 * MROWS, 4 * 2048, 1024}; pg8::BranchOrder S; S.so.init(MROWS, 2048, F.G, F.bid); pg8::EpiBranch E{PROJ, NIN, (bf16*)(F.ws + WS_GS)};
            REP(13) pg8::gemm_phase<pg8::EpiBranch, pg8::BranchOrder, true, true>(F.lds, g, S, E); } SEAM(pb + 5);
        if (INJ(6)) { pg8::Gemm g{(bf16*)(F.ws + WS_GS), Wout, MROWS, 2048, 2048}; pg8::StaticOrder S; S.init(MROWS, 2048, F.G, F.bid); pg8::EpiResid E{X, MODL, 4096, 1.0f};
            if ((REP_MASK >> 14) & 1u) { pg8::EpiResid E0{X, MODL, 4096, 0.0f}; pg8::gemm_phase<pg8::EpiResid, pg8::StaticOrder, true, true>(F.lds, g, S, E0); }
            pg8::gemm_phase<pg8::EpiResid, pg8::StaticOrder, true, true>(F.lds, g, S, E); } SEAM(pb + 6);
        if (INJ(7)) { REP(9) phase_norm(F, layer, 1, false); } SEAM(pb + 7);
        if (INJ(8)) { pg8::Gemm g{H, Wfi, MROWS, 11264, 2048}; pg8::StaticOrder S; S.init(MROWS, 11264, F.G, F.bid);
            EpiConv<pg8::EpiGated<1>> E{pg8::EpiGated<1>{PROJ  , FFN}, F.in, F.ws, layer + 1, 1, F.gw, F.NGW, layer + 1 < NLAYER ? CV_B2 : 0, CV_B0, 0};
            pg8::gemm_phase<EpiConv<pg8::EpiGated<1>>, pg8::StaticOrder, true, true>(F.lds, g, S, E);
            if (layer + 1 < NLAYER) conv_run(1, layer + 1, CV_B0 + E.cnt * F.NGW + F.gw, F.NGW, F.in, F.ws, F.lane); } SEAM(pb + 8);
        if (INJ(9)) { pg8::Gemm g{PROJ, Wfo, MROWS, 2048, FFN}; pg8::StaticOrder S; S.init(MROWS, 2048, F.G, F.bid); pg8::EpiResid E{X, MODL, 10240, 1.0f};
            if ((REP_MASK >> 14) & 1u) { pg8::EpiResid E0{X, MODL, 10240, 0.0f}; pg8::gemm_phase<pg8::EpiResid, pg8::StaticOrder, true, true>(F.lds, g, S, E0); }
            pg8::gemm_phase<pg8::EpiResid, pg8::StaticOrder, true, true>(F.lds, g, S, E); } SEAM(pb + 9);
    }
    if (((PH_MASK >> 12) & 1u) && IN(41)) phase_final_norm(F);
#undef IN
#undef INJ
#undef SEAM
}

extern "C" void kernel_launch(void* const* d_in, const int* in_sizes, int n_in, void* d_out, int out_size, void* d_ws, size_t ws_size, hipStream_t stream) {
    static int grid = 0;
    if (grid == 0) {
        if (n_in != 41 || out_size != (int)O_TOTAL || ws_size < WS_END) { fprintf(stderr, "kernel_launch: expected 41 inputs, %zu outputs, >= %zu bytes of workspace; got n_in %d out %d ws %zu\n", (size_t)O_TOTAL, (size_t)WS_END, n_in, out_size, ws_size); grid = -1; return; }
        int dev = 0, cus = 0, per_cu = 0;
        if (hipGetDevice(&dev) != hipSuccess || hipDeviceGetAttribute(&cus, hipDeviceAttributeMultiprocessorCount, dev) != hipSuccess) { grid = -1; return; }
        if (hipFuncSetAttribute((const void*)skel_fwd, hipFuncAttributeMaxDynamicSharedMemorySize, LDS_BYTES) != hipSuccess) { fprintf(stderr, "kernel_launch: hipFuncSetAttribute failed\n"); grid = -1; return; }
        if (hipOccupancyMaxActiveBlocksPerMultiprocessor(&per_cu, (const void*)skel_fwd, NTHREADS, LDS_BYTES) != hipSuccess || per_cu < 1) fprintf(stderr, "kernel_launch: occupancy query reports %d\n", per_cu);
        (void)hipGetLastError();
        grid = cus;
    }
    if (grid < 0) return;
    if (hipMemsetAsync((char*)d_ws + WS_CTL, 0, CTL_ZERO_BYTES, stream) != hipSuccess) return;
    Args a{};
    for (int i = 0; i < 41; ++i) a.in[i] = (const float*)d_in[i];
    a.out = (float*)d_out; a.ws = (unsigned char*)d_ws;
    constexpr int NL = MK_N_LAUNCHES;
    for (int li = 0; li < NL; ++li) {
        a.li = li; a.ph_lo = (int)((long)NPHASE * li / NL); a.ph_hi = (int)((long)NPHASE * (li + 1) / NL);
        hipLaunchKernelGGL(skel_fwd, dim3(grid), dim3(NTHREADS), LDS_BYTES, stream, a);
        const hipError_t le = hipPeekAtLastError();
        if (le != hipSuccess) { fprintf(stderr, "kernel_launch: launch %d failed: %s\n", li, hipGetErrorName(le)); break; }
    }
}
```

```cpp
#include <hip/hip_runtime.h>
#include <cstdio>
#include <cstdint>
#include <cmath>
#define MK_N_LAUNCHES 1
#define REP_MASK 0u
namespace pg8 {
#define PG8_LAS __attribute__((address_space(3)))
typedef unsigned short bf16_t;
typedef short bf16x8 __attribute__((ext_vector_type(8)));
typedef float f32x4 __attribute__((ext_vector_type(4)));
typedef unsigned u32x4 __attribute__((ext_vector_type(4)));
constexpr int BM = 256, BK = 64, HALF = 128, HTB = HALF * BK * 2  , STAGE_BYTES = 8 * HTB, NXCD = 8, WGM = 8;

__host__ __device__ __forceinline__ int lds_byte(int r, int c) { const int st = (r >> 4) * 2 + (c >> 5), rr = r & 15, cc = c & 31, ob = rr * 64 + cc * 2; return st * 1024 + (ob ^ (((ob >> 9) & 1) << 5)); }
__host__ __device__ __forceinline__ void stage_rc(int b, int& R, int& C) { const int st = b / 1024, sb = b % 1024, swz = sb ^ (((sb >> 9) & 1) << 5); R = (st >> 1) * 16 + swz / 64; C = (st & 1) * 32 + (swz % 64) / 2; }
__host__ __device__ __forceinline__ int perm32(int rho) { const int n = rho >> 4, i = rho & 15; return 8 * (i >> 2) + 4 * n + (i & 3); }

struct Unit { int pm, pn; };
struct Gemm { const bf16_t* A; const bf16_t* Bt; int M, N, K; };

struct StaticOrder {
    int nM, nN, nwg, G, c;
    __host__ __device__ void init(int M, int N, int G_, int c_) { nM = M / BM; nN = N / BM; nwg = nM * nN; G = G_; c = c_; }
    __host__ __device__ bool next(int i, Unit& u) const {
        const long L = (long)i * G + c; if (L >= nwg) return false;
        int wgid = (int)L; { const int q = nwg / NXCD, r = nwg % NXCD, xcd = wgid % NXCD, off = wgid / NXCD; wgid = (xcd < r ? xcd * (q + 1) : r * (q + 1) + (xcd - r) * q) + off; }
        const int nig = WGM * nN, gid = wgid / nig, fm = gid * WGM, gsz = (nM - fm) < WGM ? (nM - fm) : WGM;
        u.pm = fm + ((wgid % nig) % gsz); u.pn = (wgid % nig) / gsz; return true;
    }
    __device__ __forceinline__ void a_ready(const Unit&) const {}
    __device__ __forceinline__ void done(const Unit&) const {}
};
__device__ __forceinline__ unsigned cvt_pk_bf16(float lo, float hi) { typedef float f32x2_t_ __attribute__((ext_vector_type(2))); typedef __bf16 bf16x2_t_ __attribute__((ext_vector_type(2))); const f32x2_t_ v_ = {lo, hi}; const bf16x2_t_ b_ = __builtin_convertvector(v_, bf16x2_t_); return __builtin_bit_cast(unsigned, b_); }
__device__ __forceinline__ float bf_lo(unsigned w) { return __uint_as_float(w << 16); }
__device__ __forceinline__ float bf_hi(unsigned w) { return __uint_as_float(w & 0xffff0000u); }
__device__ __forceinline__ float sigmoid_f(float x) { return __builtin_amdgcn_rcpf(1.0f + __expf(-x)); }
__device__ __forceinline__ u32x4 pack8(const f32x4 a, const f32x4 b) { u32x4 w; w.x = cvt_pk_bf16(a[0], a[1]); w.y = cvt_pk_bf16(a[2], a[3]); w.z = cvt_pk_bf16(b[0], b[1]); w.w = cvt_pk_bf16(b[2], b[3]); return w; }

struct EpiInProj {
    static constexpr bool PERM = true, AFTER_DRAIN = false;
    __device__ __forceinline__ bool keep(const Unit&) const { return false; }
    bf16_t* O; int ldc; int nsig;
    __device__ __forceinline__ void operator()(const f32x4 (&acc)[2][2][4][2], const Unit& u, int wr, int wc, int fr, int fq) const {
        const int row0 = u.pm * BM + wr * 64 + fr, col0 = u.pn * BM + wc * 32 + 8 * fq; const bool sg = u.pn < nsig;
#pragma unroll
        for (int ai = 0; ai < 2; ++ai)
#pragma unroll
            for (int m = 0; m < 4; ++m) { bf16_t* rowp = O + (size_t)(row0 + ai * HALF + m * 16) * ldc + col0;
#pragma unroll
                for (int bj = 0; bj < 2; ++bj) { f32x4 v0 = acc[ai][bj][m][0], v1 = acc[ai][bj][m][1];
                    if (sg) {
#pragma unroll
                        for (int j = 0; j < 4; ++j) { v0[j] = sigmoid_f(v0[j]); v1[j] = sigmoid_f(v1[j]); } }
                    *(u32x4*)(rowp + bj * HALF) = pack8(v0, v1); } }
    }
};
struct EpiMlaQ {
    static constexpr bool PERM = false, AFTER_DRAIN = false;
    __device__ __forceinline__ bool keep(const Unit&) const { return false; }
    bf16_t* O; const float2* tab;
    __device__ __forceinline__ void operator()(const f32x4 (&acc)[2][2][4][2], const Unit& u, int wr, int wc, int fr, int fq) const {
        const int row0 = u.pm * BM + wr * 64 + fr; const bool lat = u.pm >= 32;
#pragma unroll
        for (int bj = 0; bj < 2; ++bj) {
            const int cg = u.pn * BM + bj * HALF + wc * 32;
            const int w = cg % 192; const bool rp = lat && (w >= 128); const int axis = (w - 128) >> 5;
#pragma unroll
            for (int ai = 0; ai < 2; ++ai)
#pragma unroll
                for (int m = 0; m < 4; ++m) { const int row = row0 + ai * HALF + m * 16; f32x4 x0 = acc[ai][bj][m][0], x1 = acc[ai][bj][m][1];
                    if (rp) { const int t = (row - 8192) & 2047; const int pos = axis ? (t & 63) : (t >> 6); const float2* tp = tab + pos * 16 + 4 * fq;
#pragma unroll
                        for (int j = 0; j < 4; ++j) { const float2 cs = tp[j]; const float a = x0[j], b = x1[j]; x0[j] = a * cs.x - b * cs.y; x1[j] = a * cs.y + b * cs.x; } }
                    bf16_t* p = O + (size_t)row * 1536 + cg + 4 * fq;
                    uint2 w0; w0.x = cvt_pk_bf16(x0[0], x0[1]); w0.y = cvt_pk_bf16(x0[2], x0[3]); uint2 w1; w1.x = cvt_pk_bf16(x1[0], x1[1]); w1.y = cvt_pk_bf16(x1[2], x1[3]);
                    *(uint2*)p = w0; *(uint2*)(p + 16) = w1; } }
    }
};
struct EpiMlaKV {
    static constexpr bool PERM = true, AFTER_DRAIN = false;
    __device__ __forceinline__ bool keep(const Unit&) const { return false; }
    bf16_t* Km; bf16_t* Vm;
    __device__ __forceinline__ void operator()(const f32x4 (&acc)[2][2][4][2], const Unit& u, int wr, int wc, int fr, int fq) const {
        const int row0 = u.pm * BM + wr * 64 + fr, c0 = wc * 32 + 8 * fq;
#pragma unroll
        for (int ai = 0; ai < 2; ++ai)
#pragma unroll
            for (int m = 0; m < 4; ++m) { const size_t row = (size_t)(row0 + ai * HALF + m * 16);
                *(u32x4*)(Km + row * 1536 + u.pn * 192 + c0) = pack8(acc[ai][0][m][0], acc[ai][0][m][1]);
                *(u32x4*)(Vm + row * 1024 + u.pn * 128 + c0) = pack8(acc[ai][1][m][0], acc[ai][1][m][1]); }
    }
};
template <int MODE> struct EpiGated {
    static constexpr bool PERM = true, AFTER_DRAIN = false;
    __device__ __forceinline__ bool keep(const Unit&) const { return false; }
    bf16_t* O; int ldc;
    __device__ __forceinline__ void operator()(const f32x4 (&acc)[2][2][4][2], const Unit& u, int wr, int wc, int fr, int fq) const {
        const int row0 = u.pm * BM + wr * 64 + fr, col0 = u.pn * HALF + wc * 32 + 8 * fq;
#pragma unroll
        for (int ai = 0; ai < 2; ++ai)
#pragma unroll
            for (int m = 0; m < 4; ++m) { f32x4 o[2];
#pragma unroll
                for (int n = 0; n < 2; ++n)
#pragma unroll
                    for (int j = 0; j < 4; ++j) { const float a = acc[ai][0][m][n][j], b = acc[ai][1][m][n][j]; o[n][j] = MODE == 0 ? a * sigmoid_f(b) : a * sigmoid_f(a) * b; }
                *(u32x4*)(O + (size_t)(row0 + ai * HALF + m * 16) * ldc + col0) = pack8(o[0], o[1]); }
    }
};
struct EpiBranch {
    static constexpr bool PERM = true, AFTER_DRAIN = false;
    const bf16_t* G; int ldg; bf16_t* GS;
    __device__ __forceinline__ bool keep(const Unit& u) const { return (u.pm >> 6) < 3; }
    __device__ __forceinline__ void operator()(f32x4 (&acc)[2][2][4][2], const Unit& u, int wr, int wc, int fr, int fq) const {
        const int br = u.pm >> 6, pm = u.pm & 63, pn = u.pn & 7;
        const int row0 = pm * BM + wr * 64 + fr, col0 = pn * BM + wc * 32 + 8 * fq;
#pragma unroll
        for (int ai = 0; ai < 2; ++ai) {
            u32x4 gc[4][2], gn[4][2];
#pragma unroll
            for (int m = 0; m < 4; ++m)
#pragma unroll
                for (int bj = 0; bj < 2; ++bj) { const bf16_t* gp = G + (size_t)(row0 + ai * HALF + m * 16) * ldg + br * 2048 + col0 + bj * HALF; gc[m][bj] = *(const u32x4*)gp; if (br < 3) gn[m][bj] = *(const u32x4*)(gp + 2048); }
#pragma unroll
            for (int m = 0; m < 4; ++m)
#pragma unroll
                for (int bj = 0; bj < 2; ++bj) { float c[8], n[8]; const u32x4 a = gc[m][bj];
                    c[0] = bf_lo(a.x); c[1] = bf_hi(a.x); c[2] = bf_lo(a.y); c[3] = bf_hi(a.y); c[4] = bf_lo(a.z); c[5] = bf_hi(a.z); c[6] = bf_lo(a.w); c[7] = bf_hi(a.w);
                    if (br < 3) { const u32x4 b = gn[m][bj]; n[0] = bf_lo(b.x); n[1] = bf_hi(b.x); n[2] = bf_lo(b.y); n[3] = bf_hi(b.y); n[4] = bf_lo(b.z); n[5] = bf_hi(b.z); n[6] = bf_lo(b.w); n[7] = bf_hi(b.w); }
#pragma unroll
                    for (int j = 0; j < 8; ++j) { float f = fmaxf(c[j], 1e-6f); if (br < 3) f *= __builtin_amdgcn_rcpf(fmaxf(n[j], 1e-6f)); acc[ai][bj][m][j >> 2][j & 3] *= f; }
                    if (br == 3) *(u32x4*)(GS + (size_t)(row0 + ai * HALF + m * 16) * 2048 + col0 + bj * HALF) = pack8(acc[ai][bj][m][0], acc[ai][bj][m][1]); }
        }
    }
};
struct EpiResid {
    static constexpr bool PERM = false, AFTER_DRAIN = false;
    __device__ __forceinline__ bool keep(const Unit&) const { return false; }
    float* X; const float* mod; int goff; float scale;
    __device__ __forceinline__ void operator()(const f32x4 (&acc)[2][2][4][2], const Unit& u, int wr, int wc, int fr, int fq) const {
        const int row0 = u.pm * BM + wr * 64 + fr, col0 = u.pn * BM + wc * 32 + 4 * fq;
        const int mrow = u.pm < 32 ? 0 : 1 + ((u.pm - 32) >> 3); const float* gp = mod + mrow * 12288 + goff + col0;
        f32x4 gv[2][2];
#pragma unroll
        for (int bj = 0; bj < 2; ++bj)
#pragma unroll
            for (int n = 0; n < 2; ++n) gv[bj][n] = *(const f32x4*)(gp + bj * HALF + n * 16) * scale;
#pragma unroll
        for (int ai = 0; ai < 2; ++ai) { f32x4 xv[4][2][2];
#pragma unroll
            for (int m = 0; m < 4; ++m)
#pragma unroll
                for (int bj = 0; bj < 2; ++bj)
#pragma unroll
                    for (int n = 0; n < 2; ++n) xv[m][bj][n] = *(const f32x4*)(X + (size_t)(row0 + ai * HALF + m * 16) * 2048 + col0 + bj * HALF + n * 16);
#pragma unroll
            for (int m = 0; m < 4; ++m)
#pragma unroll
                for (int bj = 0; bj < 2; ++bj)
#pragma unroll
                    for (int n = 0; n < 2; ++n) *(f32x4*)(X + (size_t)(row0 + ai * HALF + m * 16) * 2048 + col0 + bj * HALF + n * 16) = xv[m][bj][n] + gv[bj][n] * acc[ai][bj][m][n];
            asm volatile("" ::: "memory"); }
    }
};
struct BranchOrder {
    StaticOrder so;
    __device__ bool next(int i, Unit& u) const { Unit t; if (!so.next(i >> 2, t)) return false; const int br = i & 3; u.pm = br * 64 + t.pm; u.pn = br * 8 + t.pn; return true; }
    __device__ __forceinline__ void a_ready(const Unit&) const {}
    __device__ __forceinline__ void done(const Unit&) const {}
};
template <class Epi, class Sched, bool ALIGN_EPI = false, bool SP2 = false>
__device__ __forceinline__ void gemm_phase(PG8_LAS unsigned char* lds, const Gemm g, const Sched& S, const Epi& E) {
    int tid_ = threadIdx.x; asm volatile("" : "+v"(tid_));
    const int tid = tid_, wid = __builtin_amdgcn_readfirstlane(tid >> 6), lane = tid & 63, wr = wid >> 2, wc = wid & 3, fr = lane & 15, fq = lane >> 4;
    const int K = g.K, nt = K / BK;
    unsigned voffA[2], voffB[2];
#pragma unroll
    for (int i = 0; i < 2; ++i) { int R, C; stage_rc(tid * 16 + i * 8192, R, C); const int Rb = Epi::PERM ? ((R & ~31) + perm32(R & 31)) : R;
        voffA[i] = (unsigned)(R * K + C) * 2u; voffB[i] = (unsigned)(Rb * K + C) * 2u; }
    const size_t kstep = (size_t)(BK * 2);
    const size_t hstep = (size_t)HALF * K * 2;
    const size_t tstep = 2 * hstep;
    const unsigned ldsw = (unsigned)wid * 1024u;
    const int aoff = lds_byte(wr * 64 + fr, fq * 8), boff = lds_byte(wc * 32 + fr, fq * 8);
#define PG8_SA(b, h) (((b) * 2 + (h)) * HTB)
#define PG8_SB(b, h) ((4 + (b) * 2 + (h)) * HTB)
#define PG8_STAGE(bufoff, gbase, voff) do { _Pragma("unroll") for (int _i = 0; _i < 2; ++_i) \
        __builtin_amdgcn_global_load_lds((const unsigned*)((const char*)(gbase) + (voff)[_i]), (PG8_LAS unsigned*)(lds + (bufoff) + ldsw + _i * 8192), 16, 0, 0); } while (0)
#define PG8_LDA(dst, b, h) do { _Pragma("unroll") for (int m = 0; m < 4; ++m) _Pragma("unroll") for (int k = 0; k < 2; ++k) dst[m][k] = *(const PG8_LAS bf16x8*)(lds + PG8_SA(b, h) + aoff + m * 2048 + k * 1024); } while (0)
#define PG8_LDB(dst, b, h) do { _Pragma("unroll") for (int n = 0; n < 2; ++n) _Pragma("unroll") for (int k = 0; k < 2; ++k) dst[n][k] = *(const PG8_LAS bf16x8*)(lds + PG8_SB(b, h) + boff + n * 2048 + k * 1024); } while (0)
#define PG8_MMA(ai, bj, At, Bt) do { __builtin_amdgcn_s_setprio(1); _Pragma("unroll") for (int m = 0; m < 4; ++m) _Pragma("unroll") for (int n = 0; n < 2; ++n) _Pragma("unroll") for (int k = 0; k < 2; ++k) \
        acc[ai][bj][m][n] = __builtin_amdgcn_mfma_f32_16x16x32_bf16(Bt[n][k], At[m][k], acc[ai][bj][m][n], 0, 0, 0); __builtin_amdgcn_s_setprio(0); } while (0)
#define PG8_WAIT_V(n) asm volatile("s_waitcnt vmcnt(" #n ")" ::: "memory")
#define PG8_WAIT_L(n) asm volatile("s_waitcnt lgkmcnt(" #n ")" ::: "memory")
#define PG8_BAR __builtin_amdgcn_s_barrier()
#define PG8_SCHED __builtin_amdgcn_sched_barrier(0)
    Unit cur, nxt; int ui = 0;
    if (!S.next(0, cur)) return;
    f32x4 acc[2][2][4][2];
#pragma unroll
    for (int a = 0; a < 2; ++a)
#pragma unroll
        for (int b = 0; b < 2; ++b)
#pragma unroll
            for (int m = 0; m < 4; ++m)
#pragma unroll
                for (int n = 0; n < 2; ++n) acc[a][b][m][n] = (f32x4){0.f, 0.f, 0.f, 0.f};
    bf16x8 At[4][2], B0[2][2], B1[2][2];
    const char* cA = (const char*)g.A + (size_t)cur.pm * tstep; const char* cB = (const char*)g.Bt + (size_t)cur.pn * tstep;
    S.a_ready(cur);
    if constexpr (SP2) {
        PG8_STAGE(PG8_SB(0, 0), cB, voffB); PG8_STAGE(PG8_SB(0, 1), cB + hstep, voffB); PG8_STAGE(PG8_SA(0, 0), cA, voffA); PG8_STAGE(PG8_SA(0, 1), cA + hstep, voffA);
        if (wr == 1) PG8_BAR;
        PG8_WAIT_V(2); PG8_BAR;
        PG8_STAGE(PG8_SB(1, 0), cB + kstep, voffB); PG8_STAGE(PG8_SA(1, 0), cA + kstep, voffA); PG8_STAGE(PG8_SB(1, 1), cB + hstep + kstep, voffB);
        PG8_WAIT_V(6); PG8_BAR;
    } else {
        PG8_STAGE(PG8_SB(0, 0), cB, voffB); PG8_STAGE(PG8_SA(0, 0), cA, voffA); PG8_STAGE(PG8_SB(0, 1), cB + hstep, voffB); PG8_STAGE(PG8_SA(0, 1), cA + hstep, voffA);
        if (wr == 1) PG8_BAR;
        PG8_WAIT_V(4); PG8_BAR;
        PG8_STAGE(PG8_SB(1, 0), cB + kstep, voffB); PG8_STAGE(PG8_SA(1, 0), cA + kstep, voffA); PG8_STAGE(PG8_SB(1, 1), cB + hstep + kstep, voffB);
        PG8_WAIT_V(6); PG8_BAR;
    }
    for (;;) {
        const bool has_next = S.next(ui + 1, nxt);
        const char* nA = has_next ? (const char*)g.A + (size_t)nxt.pm * tstep : cA; const char* nB = has_next ? (const char*)g.Bt + (size_t)nxt.pn * tstep : cB;
#pragma clang loop unroll(disable)
        for (int t = 0; t < nt; t += 2) {
            const bool last = (t == nt - 2);
            const char* a1 = cA + (size_t)(t + 1) * kstep;
            const char* a2 = last ? nA : cA + (size_t)(t + 2) * kstep; const char* b2 = last ? nB : cB + (size_t)(t + 2) * kstep;
            const char* a3 = a2 + kstep; const char* b3 = b2 + kstep;
            if (last && has_next) S.a_ready(nxt);
            if constexpr (SP2) {
            PG8_LDB(B0, 0, 0); PG8_LDB(B1, 0, 1); PG8_SCHED; PG8_LDA(At, 0, 0); PG8_STAGE(PG8_SA(1, 1), a1 + hstep, voffA);
            PG8_WAIT_V(8); PG8_WAIT_L(0); PG8_BAR; PG8_MMA(0, 0, At, B0); PG8_MMA(0, 1, At, B1); PG8_BAR; PG8_SCHED;
            PG8_LDA(At, 0, 1); PG8_STAGE(PG8_SB(0, 0), b2, voffB); PG8_STAGE(PG8_SB(0, 1), b2 + hstep, voffB); PG8_STAGE(PG8_SA(0, 0), a2, voffA);
            PG8_WAIT_V(8); PG8_WAIT_L(0); PG8_BAR; PG8_MMA(1, 0, At, B0); PG8_MMA(1, 1, At, B1); PG8_BAR; PG8_SCHED;
            PG8_LDB(B0, 1, 0); PG8_LDB(B1, 1, 1); PG8_SCHED; PG8_LDA(At, 1, 0); PG8_STAGE(PG8_SA(0, 1), a2 + hstep, voffA);
            PG8_WAIT_V(8); PG8_WAIT_L(0); PG8_BAR; PG8_MMA(0, 0, At, B0); PG8_MMA(0, 1, At, B1); PG8_BAR; PG8_SCHED;
            PG8_LDA(At, 1, 1); PG8_STAGE(PG8_SB(1, 0), b3, voffB); PG8_STAGE(PG8_SB(1, 1), b3 + hstep, voffB); PG8_STAGE(PG8_SA(1, 0), a3, voffA);
            PG8_WAIT_V(8); PG8_WAIT_L(0); PG8_BAR; PG8_MMA(1, 0, At, B0); PG8_MMA(1, 1, At, B1); PG8_BAR; PG8_SCHED;
            } else {
            PG8_LDB(B0, 0, 0); PG8_SCHED; PG8_LDA(At, 0, 0); PG8_STAGE(PG8_SA(1, 1), a1 + hstep, voffA);
            PG8_WAIT_L(8); PG8_BAR; PG8_WAIT_L(0); PG8_MMA(0, 0, At, B0); PG8_BAR; PG8_SCHED;
            PG8_LDB(B1, 0, 1); PG8_STAGE(PG8_SB(0, 0), b2, voffB);
            PG8_BAR; PG8_WAIT_L(0); PG8_MMA(0, 1, At, B1); PG8_BAR;
            PG8_LDA(At, 0, 1); PG8_STAGE(PG8_SA(0, 0), a2, voffA);
            PG8_BAR; PG8_WAIT_L(0); PG8_MMA(1, 0, At, B0); PG8_BAR; PG8_SCHED;
            PG8_STAGE(PG8_SB(0, 1), b2 + hstep, voffB);
            PG8_WAIT_V(6); PG8_BAR; PG8_MMA(1, 1, At, B1); PG8_BAR;
            PG8_LDB(B0, 1, 0); PG8_SCHED; PG8_LDA(At, 1, 0); PG8_STAGE(PG8_SA(0, 1), a2 + hstep, voffA);
            PG8_WAIT_L(8); PG8_BAR; PG8_WAIT_L(0); PG8_MMA(0, 0, At, B0); PG8_BAR; PG8_SCHED;
            PG8_LDB(B1, 1, 1); PG8_STAGE(PG8_SB(1, 0), b3, voffB);
            PG8_BAR; PG8_WAIT_L(0); PG8_MMA(0, 1, At, B1); PG8_BAR;
            PG8_LDA(At, 1, 1); PG8_STAGE(PG8_SA(1, 0), a3, voffA);
            PG8_BAR; PG8_WAIT_L(0); PG8_MMA(1, 0, At, B0); PG8_BAR; PG8_SCHED;
            PG8_STAGE(PG8_SB(1, 1), b3 + hstep, voffB);
            PG8_WAIT_V(6); PG8_BAR; PG8_MMA(1, 1, At, B1); PG8_BAR;
            }
        }
        if constexpr (ALIGN_EPI) { if (wr == 0) PG8_BAR; }
        if constexpr (!Epi::AFTER_DRAIN) { E(acc, cur, wr, wc, fr, fq); S.done(cur); }
        if (!has_next) break;
        if (!E.keep(cur)) {
#pragma unroll
        for (int a = 0; a < 2; ++a)
#pragma unroll
            for (int b = 0; b < 2; ++b)
#pragma unroll
                for (int m = 0; m < 4; ++m)
#pragma unroll
                    for (int n = 0; n < 2; ++n) acc[a][b][m][n] = (f32x4){0.f, 0.f, 0.f, 0.f};
        }
        cur = nxt; cA = nA; cB = nB; ++ui;
        if constexpr (ALIGN_EPI) { if (wr == 1) PG8_BAR; }
    }
    PG8_WAIT_V(0);
    if constexpr (!ALIGN_EPI) { if (wr == 0) PG8_BAR; }
    PG8_BAR;
    if constexpr (Epi::AFTER_DRAIN) { E.fused(acc, cur, wr, wc, fr, fq, lds, wid, lane); S.done(cur); }
#undef PG8_SA
#undef PG8_SB
#undef PG8_STAGE
#undef PG8_LDA
#undef PG8_LDB
#undef PG8_MMA
#undef PG8_WAIT_V
#undef PG8_WAIT_L
#undef PG8_BAR
#undef PG8_SCHED
}
}
namespace att {
using bf16x8 = __attribute__((ext_vector_type(8))) short;
using s16x4  = __attribute__((ext_vector_type(4))) short;
using f32x16 = __attribute__((ext_vector_type(16))) float;
using u32x4  = __attribute__((ext_vector_type(4))) unsigned;
constexpr int NW = 8, QBLK = 32, KVBLK = 64, DV = 128;
constexpr float THR = 8.f;
#ifndef QKT_GRP
#define QKT_GRP 4
#endif
#define ATT_SBAR() __builtin_amdgcn_sched_barrier(0)
template <int DK> struct Cfg {
  static constexpr float SCALE = DK == 128 ? 0.088388347648318440f : 0.072168783648703220f;
  static constexpr int KROW = DK * 2;
  static constexpr int SHM_V = KVBLK * DV * 2, SHM_K = KVBLK * DK * 2;
  static constexpr int SHM = 2 * SHM_V + 2 * SHM_K + NW * 64 * 4;
  static constexpr int NKC = DK / 64;
};
__device__ __forceinline__ int crow(int r, int hi) { return (r & 3) + 8 * (r >> 2) + 4 * hi; }
__device__ __forceinline__ unsigned cvtpk(float lo, float hi) { typedef float f32x2_t_ __attribute__((ext_vector_type(2))); typedef __bf16 bf16x2_t_ __attribute__((ext_vector_type(2))); const f32x2_t_ v_ = {lo, hi}; const bf16x2_t_ b_ = __builtin_convertvector(v_, bf16x2_t_); return __builtin_bit_cast(unsigned, b_); }
template <int DK> __device__ __forceinline__ int kswz(int row, int colB) { return row * (DK * 2) + (colB ^ ((row & 7) << 4)); }

template <int DK> __device__ __forceinline__ void partialSM(f32x16& p0, f32x16& p1, float& m_reg, float& mn, float& alpha) {
  constexpr float SCALE = Cfg<DK>::SCALE; constexpr float C = SCALE * 1.4426950408889634f;
  float pmax = p0[0]; for (int r = 1; r < 16; ++r) pmax = fmaxf(pmax, p0[r]); for (int r = 0; r < 16; ++r) pmax = fmaxf(pmax, p1[r]);
  { auto rr = __builtin_amdgcn_permlane32_swap(__float_as_uint(pmax), __float_as_uint(pmax), false, false);
    pmax = fmaxf(__uint_as_float(rr[0]), __uint_as_float(rr[1])); }
  if (__builtin_expect(__all(pmax - m_reg <= THR / SCALE), 1)) { mn = m_reg; alpha = 1.f; }
  else { mn = fmaxf(m_reg, pmax); alpha = __builtin_amdgcn_exp2f((m_reg - mn) * C); m_reg = mn; }
  float mnC = -mn * C;
  for (int r = 0; r < 16; ++r) p0[r] = fmaf(p0[r], C, mnC); for (int r = 0; r < 16; ++r) p1[r] = fmaf(p1[r], C, mnC);
  for (int r = 0; r < 16; ++r) p0[r] = __builtin_amdgcn_exp2f(p0[r]);
}
__device__ __forceinline__ void finishSM(f32x16& p0, f32x16& p1, float alpha, float& l_reg, bf16x8& pa0, bf16x8& pa1, bf16x8& pa2, bf16x8& pa3) {
  for (int r = 0; r < 16; ++r) p1[r] = __builtin_amdgcn_exp2f(p1[r]);
  float ps = 0; for (int r = 0; r < 16; ++r) ps += p0[r]; for (int r = 0; r < 16; ++r) ps += p1[r];
  { auto rr = __builtin_amdgcn_permlane32_swap(__float_as_uint(ps), __float_as_uint(ps), false, false);
    ps = __uint_as_float(rr[0]) + __uint_as_float(rr[1]); }
  l_reg = l_reg * alpha + ps;
#define ATT_PK4(P, BASE, OUT) do { unsigned a0 = cvtpk(P[BASE + 0], P[BASE + 1]), a1 = cvtpk(P[BASE + 2], P[BASE + 3]);   \
    unsigned b0 = cvtpk(P[BASE + 4], P[BASE + 5]), b1 = cvtpk(P[BASE + 6], P[BASE + 7]);                              \
    auto r0 = __builtin_amdgcn_permlane32_swap(a0, b0, false, false); auto r1 = __builtin_amdgcn_permlane32_swap(a1, b1, false, false); \
    u32x4 w = {r0[0], r1[0], r0[1], r1[1]}; OUT = *reinterpret_cast<bf16x8*>(&w); } while (0)
  ATT_PK4(p0, 0, pa0); ATT_PK4(p0, 8, pa1); ATT_PK4(p1, 0, pa2); ATT_PK4(p1, 8, pa3);
#undef ATT_PK4
}
template <int DK> __device__ __forceinline__ void qkt(f32x16& p0, f32x16& p1, const char* Ks, const bf16x8* qr, int r32, int hi) {
  p0 = f32x16{}; p1 = f32x16{};
#pragma unroll
  for (int d0 = 0; d0 < DK / 16; ++d0) { int cb = (d0 * 16 + hi * 8) * 2;
    bf16x8 b0 = *reinterpret_cast<const bf16x8*>(Ks + kswz<DK>(r32, cb));
    bf16x8 b1 = *reinterpret_cast<const bf16x8*>(Ks + kswz<DK>(32 + r32, cb));
    const bf16x8 q = qr[d0];
    p0 = __builtin_amdgcn_mfma_f32_32x32x16_bf16(b0, q, p0, 0, 0, 0);
    p1 = __builtin_amdgcn_mfma_f32_32x32x16_bf16(b1, q, p1, 0, 0, 0);
  }
}
template <int DK, class HOOK> __device__ __forceinline__ void qkt_hook(f32x16& p0, f32x16& p1, const char* Ks, const bf16x8* qr, int r32, int hi, HOOK&& hook) {
  p0 = f32x16{}; p1 = f32x16{};
#pragma unroll
  for (int d0 = 0; d0 < DK / 16; ++d0) { int cb = (d0 * 16 + hi * 8) * 2;
    bf16x8 b0 = *reinterpret_cast<const bf16x8*>(Ks + kswz<DK>(r32, cb));
    bf16x8 b1 = *reinterpret_cast<const bf16x8*>(Ks + kswz<DK>(32 + r32, cb));
    const bf16x8 q = qr[d0];
    p0 = __builtin_amdgcn_mfma_f32_32x32x16_bf16(b0, q, p0, 0, 0, 0);
    p1 = __builtin_amdgcn_mfma_f32_32x32x16_bf16(b1, q, p1, 0, 0, 0);
    __builtin_amdgcn_sched_barrier(0); hook(d0); __builtin_amdgcn_sched_barrier(0);
  }
}
__device__ __forceinline__ int v_st(int k, int c) { const int kk = (k & ~0xC) | ((k & 4) << 1) | ((k & 8) >> 1); return ((kk >> 3) * 4 + (c >> 5)) * 512 + ((kk & 7) * 32 + (c & 31)) * 2; }
__device__ __forceinline__ int v_rd_base(int lane) { return ((lane & 3) << 3) | (((lane >> 2) & 3) << 6) | (((lane >> 4) & 1) << 5) | (((lane >> 5) & 1) << 8); }
constexpr int v_rd_off(int d0, int ks, int half) { return d0 * 512 + ks * 4096 + half * 2048; }
template <int OFF> __device__ __forceinline__ s16x4 tr_read(int vb) {
  s16x4 r; asm volatile("ds_read_b64_tr_b16 %0, %1 offset:%2" : "=&v"(r) : "v"(vb), "i"(OFF) : "memory"); return r;
}
template <int D0> __device__ __forceinline__ void pv_one(f32x16& od, int vb, bf16x8 pa0, bf16x8 pa1, bf16x8 pa2, bf16x8 pa3) {
  const s16x4 l0 = tr_read<v_rd_off(D0, 0, 0)>(vb), h0 = tr_read<v_rd_off(D0, 0, 1)>(vb), l1 = tr_read<v_rd_off(D0, 1, 0)>(vb), h1 = tr_read<v_rd_off(D0, 1, 1)>(vb);
  const s16x4 l2 = tr_read<v_rd_off(D0, 2, 0)>(vb), h2 = tr_read<v_rd_off(D0, 2, 1)>(vb), l3 = tr_read<v_rd_off(D0, 3, 0)>(vb), h3 = tr_read<v_rd_off(D0, 3, 1)>(vb);
  asm volatile("s_waitcnt lgkmcnt(0)" ::: "memory"); ATT_SBAR();
#define ATT_PK(L, H) (bf16x8){L[0], L[1], L[2], L[3], H[0], H[1], H[2], H[3]}
  od = __builtin_amdgcn_mfma_f32_32x32x16_bf16(pa0, ATT_PK(l0, h0), od, 0, 0, 0);
  od = __builtin_amdgcn_mfma_f32_32x32x16_bf16(pa1, ATT_PK(l1, h1), od, 0, 0, 0);
  od = __builtin_amdgcn_mfma_f32_32x32x16_bf16(pa2, ATT_PK(l2, h2), od, 0, 0, 0);
  od = __builtin_amdgcn_mfma_f32_32x32x16_bf16(pa3, ATT_PK(l3, h3), od, 0, 0, 0);
#undef ATT_PK
}
__device__ __forceinline__ void pv_d0(f32x16* o, int vb, bf16x8 pa0, bf16x8 pa1, bf16x8 pa2, bf16x8 pa3) {
  pv_one<0>(o[0], vb, pa0, pa1, pa2, pa3); pv_one<1>(o[1], vb, pa0, pa1, pa2, pa3); pv_one<2>(o[2], vb, pa0, pa1, pa2, pa3); pv_one<3>(o[3], vb, pa0, pa1, pa2, pa3);
}
template <int DK, int SDEPTH, int ldq, int ldk, int ldv, int ldo>
__device__ __forceinline__ void attn_body(const unsigned short* __restrict__ Qb, const unsigned short* __restrict__ Kh, const unsigned short* __restrict__ Vh,
                                          unsigned short* __restrict__ Ob, int seq, char* lds) {
  using C_ = Cfg<DK>; constexpr int SHM_V = C_::SHM_V, SHM_K = C_::SHM_K, NKC = C_::NKC, CPR = DK / 8;
  int tid_ = threadIdx.x; asm volatile("" : "+v"(tid_));
  const int tid = tid_, wid = tid >> 6, lane = tid & 63, r32 = lane & 31, hi = lane >> 5;
  char* V_lds = lds; char* K_lds = lds + 2 * SHM_V;
  float* ws = (float*)(lds + 2 * SHM_V + 2 * SHM_K) + wid * 64; float* li_l = ws; float* al_l = ws + 32;
  float m_reg = -1e30f, l_reg = 0; f32x16 o[4] = {}; bf16x8 qr[DK / 16];
  const unsigned short* Qw = Qb + (long)(wid * QBLK + r32) * ldq + hi * 8;
#pragma unroll
  for (int d0 = 0; d0 < DK / 16; ++d0) qr[d0] = *reinterpret_cast<const bf16x8*>(Qw + d0 * 16);
  const int sr = tid >> 4, sc = (tid & 15) * 8, vst0 = v_st(sr, sc), vst1 = v_st(32 + sr, sc);
  unsigned kgo[NKC], klo[NKC];
#pragma unroll
  for (int i = 0; i < NKC; ++i) { const int c = tid + 512 * i, kr_ = c / CPR, kc_ = (c % CPR) * 8; kgo[i] = (unsigned)(kr_ * ldk + kc_) * 2u; klo[i] = (unsigned)kswz<DK>(kr_, kc_ * 2); }
  const unsigned vgo0 = (unsigned)(sr * ldv + sc) * 2u, vgo1 = (unsigned)((32 + sr) * ldv + sc) * 2u;
  const int vb0 = (int)(uintptr_t)V_lds + v_rd_base(lane);
  struct { bf16x8 vs0, vs1; bf16x8 ks[NKC]; } sr_[SDEPTH];
#define ATT_SLOAD(i, k0) do { const char* _vt = (const char*)Vh + (size_t)(k0) * (ldv * 2); const char* _kt = (const char*)Kh + (size_t)(k0) * (ldk * 2); \
    sr_[i].vs0 = *reinterpret_cast<const bf16x8*>(_vt + vgo0); sr_[i].vs1 = *reinterpret_cast<const bf16x8*>(_vt + vgo1); \
    _Pragma("unroll") for (int _c = 0; _c < NKC; ++_c) sr_[i].ks[_c] = *reinterpret_cast<const bf16x8*>(_kt + kgo[_c]); } while (0)
#define ATT_SWRITE(b, i) do { *(bf16x8*)(V_lds + (b) * SHM_V + vst0) = sr_[i].vs0; *(bf16x8*)(V_lds + (b) * SHM_V + vst1) = sr_[i].vs1; \
    _Pragma("unroll") for (int _c = 0; _c < NKC; ++_c) *(bf16x8*)(K_lds + (b) * SHM_K + klo[_c]) = sr_[i].ks[_c]; } while (0)
#define ATT_SWAIT() do { if constexpr (SDEPTH == 2) asm volatile("s_waitcnt vmcnt(%0)" :: "n"(2 + NKC) : "memory"); else asm volatile("s_waitcnt vmcnt(0)" ::: "memory"); } while (0)
#define ATT_RESC(a) do { if (__any((a) < 1.f)) { if (hi == 0) al_l[r32] = (a); asm volatile("s_waitcnt lgkmcnt(0)" ::: "memory"); \
    for (int d = 0; d < 4; ++d) for (int r = 0; r < 16; ++r) o[d][r] *= al_l[crow(r, hi)]; } } while (0)
  f32x16 pA0, pA1, pB0, pB1; float mnA, mnB, alA, alB; bf16x8 pa0, pa1, pa2, pa3; const int NT = seq / KVBLK;
  constexpr int SE = 0, SO = SDEPTH - 1;
  ATT_SLOAD(SE, 0); asm volatile("s_waitcnt vmcnt(0)" ::: "memory"); ATT_SWRITE(0, SE); __syncthreads();
  qkt<DK>(pA0, pA1, K_lds, qr, r32, hi); partialSM<DK>(pA0, pA1, m_reg, mnA, alA);
  ATT_SLOAD(SO, KVBLK); if constexpr (SDEPTH == 2) { if (2 < NT) ATT_SLOAD(SE, 2 * KVBLK); }
  ATT_SWAIT(); ATT_SWRITE(1, SO); __syncthreads();
  for (int j = 1; j + 1 < NT; j += 2) {
    ATT_SBAR(); qkt<DK>(pB0, pB1, K_lds + SHM_K, qr, r32, hi);
    finishSM(pA0, pA1, alA, l_reg, pa0, pa1, pa2, pa3); ATT_SBAR();
    ATT_SLOAD(SO, (j + SDEPTH) * KVBLK); ATT_SBAR();
    pv_d0(o, vb0, pa0, pa1, pa2, pa3); partialSM<DK>(pB0, pB1, m_reg, mnB, alB);
    __syncthreads(); ATT_SWAIT(); ATT_SWRITE(0, SE);
    ATT_RESC(alB); __syncthreads();
    ATT_SBAR(); qkt<DK>(pA0, pA1, K_lds, qr, r32, hi);
    finishSM(pB0, pB1, alB, l_reg, pa0, pa1, pa2, pa3); ATT_SBAR();
    if (SDEPTH == 1 || j + 3 < NT) ATT_SLOAD(SE, (j + 1 + SDEPTH) * KVBLK); ATT_SBAR();
    pv_d0(o, vb0 + SHM_V, pa0, pa1, pa2, pa3); partialSM<DK>(pA0, pA1, m_reg, mnA, alA);
    __syncthreads(); if (SDEPTH == 1 || j + 3 < NT) ATT_SWAIT(); else asm volatile("s_waitcnt vmcnt(0)" ::: "memory"); ATT_SWRITE(1, SO);
    ATT_RESC(alA); __syncthreads();
  }
  ATT_SBAR(); qkt<DK>(pB0, pB1, K_lds + SHM_K, qr, r32, hi);
  finishSM(pA0, pA1, alA, l_reg, pa0, pa1, pa2, pa3); ATT_SBAR();
  pv_d0(o, vb0, pa0, pa1, pa2, pa3); partialSM<DK>(pB0, pB1, m_reg, mnB, alB);
  __syncthreads(); ATT_RESC(alB);
  finishSM(pB0, pB1, alB, l_reg, pa0, pa1, pa2, pa3); ATT_SBAR();
  pv_d0(o, vb0 + SHM_V, pa0, pa1, pa2, pa3);
  if (hi == 0) li_l[r32] = l_reg; asm volatile("s_waitcnt lgkmcnt(0)" ::: "memory");
  float rli[16];
#pragma unroll
  for (int r = 0; r < 16; ++r) rli[r] = __builtin_amdgcn_rcpf(li_l[crow(r, hi)]);
  unsigned short* Ow = Ob + (long)(wid * QBLK) * ldo;
#pragma unroll
  for (int r = 0; r < 16; ++r) { int orow = crow(r, hi);
#pragma unroll
    for (int d0 = 0; d0 < 4; ++d0) { const float v = o[d0][r] * rli[r]; unsigned u = __float_as_uint(v); u += 0x7fffu + ((u >> 16) & 1u); Ow[(long)orow * ldo + d0 * 32 + r32] = (unsigned short)(u >> 16); } }
  __syncthreads();
#undef ATT_SLOAD
#undef ATT_SWRITE
#undef ATT_SWAIT
#undef ATT_RESC
}
template <int DK, int ldq, int ldk, int ldv, int ldo, class CV>
__device__ __forceinline__ void attn_body_simple(const unsigned short* __restrict__ Qb, const unsigned short* __restrict__ Kh, const unsigned short* __restrict__ Vh,
                                                 unsigned short* __restrict__ Ob, int seq, char* lds, CV& cv) {
  using C_ = Cfg<DK>; constexpr int SHM_V = C_::SHM_V, SHM_K = C_::SHM_K, NKC = C_::NKC, CPR = DK / 8;
  int tid_ = threadIdx.x; asm volatile("" : "+v"(tid_));
  const int tid = tid_, wid = tid >> 6, lane = tid & 63, r32 = lane & 31, hi = lane >> 5;
  char* V_lds = lds; char* K_lds = lds + 2 * SHM_V;
  float* ws = (float*)(lds + 2 * SHM_V + 2 * SHM_K) + wid * 64; float* li_l = ws; float* al_l = ws + 32;
  float m_reg = -1e30f, l_reg = 0; f32x16 o[4] = {}; bf16x8 qr[DK / 16];
  const unsigned short* Qw = Qb + (long)(wid * QBLK + r32) * ldq + hi * 8;
#pragma unroll
  for (int d0 = 0; d0 < DK / 16; ++d0) qr[d0] = *reinterpret_cast<const bf16x8*>(Qw + d0 * 16);
  const int sr = tid >> 4, sc = (tid & 15) * 8, vst0 = v_st(sr, sc), vst1 = v_st(32 + sr, sc);
  unsigned kgo[NKC], klo[NKC];
#pragma unroll
  for (int i = 0; i < NKC; ++i) { const int c = tid + 512 * i, kr_ = c / CPR, kc_ = (c % CPR) * 8; kgo[i] = (unsigned)(kr_ * ldk + kc_) * 2u; klo[i] = (unsigned)kswz<DK>(kr_, kc_ * 2); }
  const unsigned vgo0 = (unsigned)(sr * ldv + sc) * 2u, vgo1 = (unsigned)((32 + sr) * ldv + sc) * 2u;
  const int vb0 = (int)(uintptr_t)V_lds + v_rd_base(lane);
  bf16x8 vs0, vs1, ks[NKC];
#define ATS_LOAD(k0) do { const char* _vt = (const char*)Vh + (size_t)(k0) * (ldv * 2); const char* _kt = (const char*)Kh + (size_t)(k0) * (ldk * 2); \
    vs0 = *reinterpret_cast<const bf16x8*>(_vt + vgo0); vs1 = *reinterpret_cast<const bf16x8*>(_vt + vgo1); \
    _Pragma("unroll") for (int _c = 0; _c < NKC; ++_c) ks[_c] = *reinterpret_cast<const bf16x8*>(_kt + kgo[_c]); } while (0)
#define ATS_WRITE(b) do { *(bf16x8*)(V_lds + (b) * SHM_V + vst0) = vs0; *(bf16x8*)(V_lds + (b) * SHM_V + vst1) = vs1; \
    _Pragma("unroll") for (int _c = 0; _c < NKC; ++_c) *(bf16x8*)(K_lds + (b) * SHM_K + klo[_c]) = ks[_c]; } while (0)
  const int NT = seq / KVBLK; float cw[32];
  ATS_LOAD(0); __builtin_amdgcn_s_waitcnt(0x0F70)  ; ATS_WRITE(0); __syncthreads();
#define ATT_TILE(J, B) do { const int j = (J); constexpr int b = (B); \
    if (b == 0) { cv.end(cw); cv.decode(); }                       \
    if (j + 1 < NT) ATS_LOAD((j + 1) * KVBLK); \
    ATT_SBAR(); \
    f32x16 p0, p1; float mn, al; bf16x8 pa0, pa1, pa2, pa3; \
    if constexpr (CV::RIDES && DK == 128) qkt_hook<DK>(p0, p1, K_lds + b * SHM_K, qr, r32, hi, [&](int d0) { if ((d0 & 1) == 0) cv.part(cw, b * 4 + (d0 >> 1)); });     \
    else qkt<DK>(p0, p1, K_lds + b * SHM_K, qr, r32, hi); \
    partialSM<DK>(p0, p1, m_reg, mn, al); \
    if (__any(al < 1.f)) { if (hi == 0) al_l[r32] = al; asm volatile("s_waitcnt lgkmcnt(0)" ::: "memory"); \
      for (int d = 0; d < 4; ++d) for (int r = 0; r < 16; ++r) o[d][r] *= al_l[crow(r, hi)]; } \
    finishSM(p0, p1, al, l_reg, pa0, pa1, pa2, pa3); ATT_SBAR(); \
    pv_d0(o, vb0 + b * SHM_V, pa0, pa1, pa2, pa3); \
    if (j + 1 < NT) { if constexpr (CV::RIDES && DK == 128) asm volatile("s_waitcnt vmcnt(4)" ::: "memory"); else asm volatile("s_waitcnt vmcnt(0)" ::: "memory"); ATS_WRITE(b ^ 1); } \
    __syncthreads(); } while (0)
  for (int jj = 0; jj < NT; jj += 2) {
    ATT_TILE(jj, 0);
    if (jj + 1 < NT) ATT_TILE(jj + 1, 1);
  }
#undef ATT_TILE
  if (NT & 1) cv.rest(cw);
  cv.end(cw);
  if (hi == 0) li_l[r32] = l_reg; asm volatile("s_waitcnt lgkmcnt(0)" ::: "memory");
  float rli[16];
#pragma unroll
  for (int r = 0; r < 16; ++r) rli[r] = __builtin_amdgcn_rcpf(li_l[crow(r, hi)]);
  unsigned short* Ow = Ob + (long)(wid * QBLK) * ldo;
#pragma unroll
  for (int r = 0; r < 16; ++r) { int orow = crow(r, hi);
#pragma unroll
    for (int d0 = 0; d0 < 4; ++d0) { const float v = o[d0][r] * rli[r]; unsigned u = __float_as_uint(v); u += 0x7fffu + ((u >> 16) & 1u); Ow[(long)orow * ldo + d0 * 32 + r32] = (unsigned short)(u >> 16); } }
  __syncthreads();
#undef ATS_LOAD
#undef ATS_WRITE
}
}
namespace ssd {
typedef short bf16x8 __attribute__((ext_vector_type(8)));
typedef short v4i16_t __attribute__((ext_vector_type(4)));
typedef float f32x4 __attribute__((ext_vector_type(4)));
typedef unsigned u32x2v __attribute__((ext_vector_type(2)));
typedef unsigned u32x4v __attribute__((ext_vector_type(4)));
#define SSD_LAS __attribute__((address_space(3)))
constexpr int T = 128, LD_B = 136, LD_X = 72, LD_A = 136, LD_S = 136;
constexpr int OFF_B = 0, OFF_X = OFF_B + T * LD_B * 2, OFF_XW = OFF_X + T * LD_X * 2, OFF_A = OFF_XW + T * LD_X * 2, OFF_S = OFF_A + T * LD_A * 2, OFF_E = OFF_S + 64 * LD_S * 2, OFF_W = OFF_E + 512, OFF_DT = OFF_W + 512, OFF_MISC = OFF_DT + 512, LDS_BYTES = OFF_MISC + 64;
static_assert(LDS_BYTES <= 131072, "ssd LDS");
__device__ __forceinline__ unsigned cvt_pk(float lo, float hi) { typedef float f32x2_t_ __attribute__((ext_vector_type(2))); typedef __bf16 bf16x2_t_ __attribute__((ext_vector_type(2))); const f32x2_t_ v_ = {lo, hi}; const bf16x2_t_ b_ = __builtin_convertvector(v_, bf16x2_t_); return __builtin_bit_cast(unsigned, b_); }
__device__ __forceinline__ bf16x8 tr8(const SSD_LAS unsigned char* p, int rowstride_bytes) {
    const v4i16_t a = __builtin_amdgcn_ds_read_tr16_b64_v4i16((SSD_LAS v4i16_t*)p);
    const v4i16_t b = __builtin_amdgcn_ds_read_tr16_b64_v4i16((SSD_LAS v4i16_t*)(p + 4 * rowstride_bytes));
    return (bf16x8){a[0], a[1], a[2], a[3], b[0], b[1], b[2], b[3]};
}
__device__ __forceinline__ void ssd_unit(SSD_LAS unsigned char* lds, const unsigned short* __restrict__ XBC, const float* __restrict__ DT, unsigned short* __restrict__ Y,
                                         int row0, int nc, int h, int dir, float a_h, const float* __restrict__ h0, float* __restrict__ hout) {
    int tid_ = threadIdx.x; asm volatile("" : "+v"(tid_));
    const int tid = tid_, w = tid >> 6, lane = tid & 63, li = lane & 15, g = lane >> 4, grp = h >> 3;
    SSD_LAS float* Es = (SSD_LAS float*)(lds + OFF_E); SSD_LAS float* Ws = (SSD_LAS float*)(lds + OFF_W); SSD_LAS float* Dts = (SSD_LAS float*)(lds + OFF_DT); SSD_LAS float* Misc = (SSD_LAS float*)(lds + OFF_MISC);
    f32x4 st[4];
#pragma unroll
    for (int pt = 0; pt < 4; ++pt) st[pt] = h0 ? *(const f32x4*)(h0 + (size_t)(16 * pt + li) * 128 + 16 * w + 4 * g) : (f32x4){0.f, 0.f, 0.f, 0.f};
#pragma unroll
    for (int pt = 0; pt < 4; ++pt) { u32x2v pk; pk.x = cvt_pk(st[pt][0], st[pt][1]); pk.y = cvt_pk(st[pt][2], st[pt][3]); *(SSD_LAS u32x2v*)(lds + OFF_S + ((16 * pt + li) * LD_S + 16 * w + 4 * g) * 2) = pk; }
    u32x4v bv[4]; u32x4v xv[2]; float dtv = 0.f;
#define SSD_PREFETCH(tq) do { _Pragma("unroll") for (int i = 0; i < 4; ++i) { const int ch = tid + 512 * i, r = ch >> 4, cc = (ch & 15) * 8; bv[i] = *(const u32x4v*)(XBC + (size_t)((tq) + r) * 1536 + 1024 + grp * 128 + cc); } \
        _Pragma("unroll") for (int i = 0; i < 2; ++i) { const int ch = tid + 512 * i, r = ch >> 3, cc = (ch & 7) * 8; xv[i] = *(const u32x4v*)(XBC + (size_t)((tq) + r) * 1536 + h * 64 + cc); } \
        dtv = DT[(size_t)((tq) + (tid & 127)) * 32 + dir * 16 + h]; } while (0)
    SSD_PREFETCH(row0 + (dir ? nc - 1 : 0) * T);
    for (int ci = 0; ci < nc; ++ci) {
        const int c = dir ? nc - 1 - ci : ci; const int t0 = row0 + c * T;
        bf16x8 cf[4];
#pragma unroll
        for (int k = 0; k < 4; ++k) cf[k] = *(const bf16x8*)(XBC + (size_t)(t0 + 16 * w + li) * 1536 + 1280 + grp * 128 + 32 * k + 8 * g);
        __builtin_amdgcn_sched_barrier(0);
        if (tid < 128) {
            const float da = dtv * a_h; float p = da;
#pragma unroll
            for (int o = 1; o < 64; o <<= 1) { const float q = __shfl_up(p, o); if (lane >= o) p += q; }
            if (lane == 63) Misc[w] = p;
            Dts[tid] = dtv; Es[tid] = p; Ws[tid] = da;
        }
        __syncthreads();
        if (tid < 128) {
            const float tot0 = Misc[0], tot = tot0 + Misc[1]; float P = Es[tid] + (w == 1 ? tot0 : 0.f); const float da = Ws[tid];
            const float E = dir ? tot - P + da : P;
            Es[tid] = E; Ws[tid] = __expf(tot - E) * Dts[tid];
            if (tid == 0) Misc[2] = tot;
        }
        __syncthreads();
#pragma unroll
        for (int i = 0; i < 4; ++i) { const int ch = tid + 512 * i, r = ch >> 4, cc = (ch & 15) * 8; *(SSD_LAS u32x4v*)(lds + OFF_B + (r * LD_B + cc) * 2) = bv[i]; }
#pragma unroll
        for (int i = 0; i < 2; ++i) { const int ch = tid + 512 * i, r = ch >> 3, cc = (ch & 7) * 8; *(SSD_LAS u32x4v*)(lds + OFF_X + (r * LD_X + cc) * 2) = xv[i];
            const float ws = Ws[r]; u32x4v o; const unsigned* xi = (const unsigned*)&xv[i]; unsigned* oo = (unsigned*)&o;
#pragma unroll
            for (int q = 0; q < 4; ++q) oo[q] = cvt_pk(__uint_as_float(xi[q] << 16) * ws, __uint_as_float(xi[q] & 0xffff0000u) * ws);
            *(SSD_LAS u32x4v*)(lds + OFF_XW + (r * LD_X + cc) * 2) = o; }
        SSD_PREFETCH(row0 + (ci + 1 < nc ? (dir ? nc - 2 - ci : ci + 1) : c) * T);
        __syncthreads();
#define SSD_SB() __builtin_amdgcn_sched_barrier(0)
        const int l = 16 * w + li; const float El = Es[l];
#pragma unroll
        for (int sp = 0; sp < 8; sp += 2) {
            bf16x8 a[2][4]; float es[2][4], ds[2][4];
#pragma unroll
            for (int t = 0; t < 2; ++t) {
#pragma unroll
                for (int k = 0; k < 4; ++k) a[t][k] = *(const SSD_LAS bf16x8*)(lds + OFF_B + ((16 * (sp + t) + li) * LD_B + 32 * k + 8 * g) * 2);
                const f32x4 e4 = *(const SSD_LAS f32x4*)(Es + 16 * (sp + t) + 4 * g), d4 = *(const SSD_LAS f32x4*)(Dts + 16 * (sp + t) + 4 * g);
#pragma unroll
                for (int j = 0; j < 4; ++j) { es[t][j] = e4[j]; ds[t][j] = d4[j]; } }
            SSD_SB();
            f32x4 acc[2] = {{0.f, 0.f, 0.f, 0.f}, {0.f, 0.f, 0.f, 0.f}};
#pragma unroll
            for (int k = 0; k < 4; ++k)
#pragma unroll
                for (int t = 0; t < 2; ++t) acc[t] = __builtin_amdgcn_mfma_f32_16x16x32_bf16(a[t][k], cf[k], acc[t], 0, 0, 0);
#pragma unroll
            for (int t = 0; t < 2; ++t) { float v[4];
#pragma unroll
                for (int j = 0; j < 4; ++j) { const int s_ = 16 * (sp + t) + 4 * g + j; const bool ok = dir ? (s_ >= l) : (s_ <= l); const float e = __expf(El - es[t][j]) * ds[t][j]; v[j] = ok ? acc[t][j] * e : 0.f; }
                u32x2v pk; pk.x = cvt_pk(v[0], v[1]); pk.y = cvt_pk(v[2], v[3]);
                *(SSD_LAS u32x2v*)(lds + OFF_A + (l * LD_A + 16 * (sp + t) + 4 * g) * 2) = pk; }
            SSD_SB();
        }
        asm volatile("s_waitcnt lgkmcnt(0)" ::: "memory");
        float el4[4];
        { const f32x4 e4 = *(const SSD_LAS f32x4*)(Es + 16 * w + 4 * g);
#pragma unroll
          for (int j = 0; j < 4; ++j) el4[j] = __expf(e4[j]); }
        unsigned short* yrow = Y + (size_t)(t0 + 16 * w + 4 * g) * 1024 + h * 64 + li;
        bf16x8 af[4];
#pragma unroll
        for (int k = 0; k < 4; ++k) af[k] = *(const SSD_LAS bf16x8*)(lds + OFF_A + (l * LD_A + 32 * k + 8 * g) * 2);
#pragma unroll
        for (int pt = 0; pt < 4; ++pt) {
            bf16x8 xb[4], sb[4];
#pragma unroll
            for (int k = 0; k < 4; ++k) { xb[k] = tr8(lds + OFF_X + ((32 * k + 8 * g + (li >> 2)) * LD_X + 16 * pt + 4 * (li & 3)) * 2, LD_X * 2);
                sb[k] = *(const SSD_LAS bf16x8*)(lds + OFF_S + ((16 * pt + li) * LD_S + 32 * k + 8 * g) * 2); }
            SSD_SB();
            f32x4 ya = {0.f, 0.f, 0.f, 0.f}, yb = {0.f, 0.f, 0.f, 0.f};
#pragma unroll
            for (int k = 0; k < 4; ++k) { ya = __builtin_amdgcn_mfma_f32_16x16x32_bf16(af[k], xb[k], ya, 0, 0, 0); yb = __builtin_amdgcn_mfma_f32_16x16x32_bf16(cf[k], sb[k], yb, 0, 0, 0); }
#pragma unroll
            for (int j = 0; j < 4; ++j) { const float yv = ya[j] + el4[j] * yb[j]; unsigned u = __float_as_uint(yv); u += 0x7fffu + ((u >> 16) & 1u); yrow[(size_t)j * 1024 + 16 * pt] = (unsigned short)(u >> 16); }
            SSD_SB();
        }
        __syncthreads();
        const float etot = __expf(Misc[2]);
        bf16x8 ba[4];
#pragma unroll
        for (int k = 0; k < 4; ++k) ba[k] = tr8(lds + OFF_B + ((32 * k + 8 * g + (li >> 2)) * LD_B + 16 * w + 4 * (li & 3)) * 2, LD_B * 2);
#pragma unroll
        for (int pt = 0; pt < 4; ++pt) { bf16x8 xw[4];
#pragma unroll
            for (int k = 0; k < 4; ++k) xw[k] = tr8(lds + OFF_XW + ((32 * k + 8 * g + (li >> 2)) * LD_X + 16 * pt + 4 * (li & 3)) * 2, LD_X * 2);
            SSD_SB();
            st[pt] *= etot;
#pragma unroll
            for (int k = 0; k < 4; ++k) st[pt] = __builtin_amdgcn_mfma_f32_16x16x32_bf16(ba[k], xw[k], st[pt], 0, 0, 0);
            u32x2v pk; pk.x = cvt_pk(st[pt][0], st[pt][1]); pk.y = cvt_pk(st[pt][2], st[pt][3]); *(SSD_LAS u32x2v*)(lds + OFF_S + ((16 * pt + li) * LD_S + 16 * w + 4 * g) * 2) = pk;
            SSD_SB(); }
        __syncthreads();
    }
#undef SSD_SB
#undef SSD_PREFETCH
    if (hout) {
#pragma unroll
        for (int pt = 0; pt < 4; ++pt) *(f32x4*)(hout + (size_t)(16 * pt + li) * 128 + 16 * w + 4 * g) = st[pt];
    }
}
}
namespace s5 {
typedef short bf16x8 __attribute__((ext_vector_type(8)));
typedef short bf16x4 __attribute__((ext_vector_type(4)));
typedef float f32x4 __attribute__((ext_vector_type(4)));
typedef float f32x2 __attribute__((ext_vector_type(2)));
typedef unsigned u32x2 __attribute__((ext_vector_type(2)));
typedef unsigned u32x4 __attribute__((ext_vector_type(4)));
#define S5_LAS __attribute__((address_space(3)))
constexpr int LD_BU = 136, LD_HS = 136;
constexpr int OFF_HS = 16 * LD_BU * 2, OFF_YL = OFF_HS + 16 * LD_HS * 2;
constexpr int WAVE_LDS = OFF_YL + 16 * 16 * 16 * 2;
constexpr int CD_BYTES = 1024 + 4096, CG_BYTES = 4096;
__device__ __forceinline__ unsigned short f2bf(float f) { unsigned u = __float_as_uint(f); u += 0x7fffu + ((u >> 16) & 1u); return (unsigned short)(u >> 16); }
__device__ __forceinline__ unsigned pk(float lo, float hi) { typedef float f2_ __attribute__((ext_vector_type(2))); typedef __bf16 b2_ __attribute__((ext_vector_type(2))); const f2_ v = {lo, hi}; const b2_ b = __builtin_convertvector(v, b2_); return __builtin_bit_cast(unsigned, b); }

__device__ __forceinline__ void make_consts(unsigned char* cd, unsigned char* cg  , const float* lam_re, const float* lam_im, float stepsz, const float* b_re, const float* b_im, const float* c_re, const float* c_im, int lane) {
    const int li = lane & 15, g = lane >> 4;
    float ar, ai, kr, ki;
    { const float lr = lam_re[lane], lm = lam_im[lane]; const float mag = expf(lr * stepsz); float sn, cs; sincosf(lm * stepsz, &sn, &cs); ar = mag * cs; ai = mag * sn;
      const float den = lr * lr + lm * lm; kr = ((ar - 1.0f) * lr + ai * lm) / den; ki = (ai * lr - (ar - 1.0f) * lm) / den; }
    float zr = ar, zi = ai;
#pragma unroll
    for (int i = 0; i < 8; ++i) { const float nr = zr * zr - zi * zi, ni = 2.0f * zr * zi; zr = nr; zi = ni; }
    float* cf = (float*)cd; cf[lane] = ar; cf[64 + lane] = ai; cf[128 + lane] = zr; cf[192 + lane] = zi;
#pragma unroll
    for (int ct = 0; ct < 8; ++ct) { const int k = 16 * ct + li, p = k >> 1; const bool im = k & 1; const float kkr = __shfl(kr, p), kki = __shfl(ki, p);
        const f32x4 br = *(const f32x4*)(b_re + p * 16 + 4 * g), bi = *(const f32x4*)(b_im + p * 16 + 4 * g); float v[4];
#pragma unroll
        for (int j = 0; j < 4; ++j) v[j] = im ? kkr * bi[j] + kki * br[j] : kkr * br[j] - kki * bi[j];
        u32x2 w; w.x = pk(v[0], v[1]); w.y = pk(v[2], v[3]); *(u32x2*)(cd + 1024 + (ct * 64 + lane) * 8) = w; }
    if (cg) {
#pragma unroll
        for (int kk = 0; kk < 4; ++kk) { const f32x4 vr = *(const f32x4*)(c_re + li * 64 + 16 * kk + 4 * g), vi = *(const f32x4*)(c_im + li * 64 + 16 * kk + 4 * g);
            u32x4 w; w.x = pk(vr[0], -vi[0]); w.y = pk(vr[1], -vi[1]); w.z = pk(vr[2], -vi[2]); w.w = pk(vr[3], -vi[3]); *(u32x4*)(cg + (kk * 64 + lane) * 16) = w; } }
}
struct Ctx {
    float ar, ai;
    bf16x4 bfr[8];
    bf16x8 cfr[4];
};
__device__ __forceinline__ void load_ctx(Ctx& c, const unsigned char* cd, const unsigned char* cg, int lane, bool with_c) {
    const float* cf = (const float*)cd; c.ar = cf[lane]; c.ai = cf[64 + lane];
#pragma unroll
    for (int ct = 0; ct < 8; ++ct) c.bfr[ct] = __builtin_bit_cast(bf16x4, *(const u32x2*)(cd + 1024 + (ct * 64 + lane) * 8));
    if (with_c) {
#pragma unroll
        for (int kk = 0; kk < 4; ++kk) c.cfr[kk] = __builtin_bit_cast(bf16x8, *(const u32x4*)(cg + (kk * 64 + lane) * 16)); }
}
template <bool NEWT, bool CURT, bool HSW, bool OLDT, bool POST>
__device__ __forceinline__ void step(const Ctx& c, S5_LAS unsigned char* BU, S5_LAS unsigned char* HS, S5_LAS unsigned char* YL  , int lane, int li, int g, int dir, const u32x2 unew, float& hr, float& hi,
                                     const unsigned short* __restrict__ uold, int ldu, unsigned short* __restrict__ outp, float dch) {
    unsigned bu[16]; bf16x8 hf[4]; f32x4 acc[8]; unsigned hs[16]; unsigned short yprev[4]; unsigned short uo[4];
    if (CURT) {
#pragma unroll
        for (int i = 0; i < 16; ++i) { const int t = dir ? 15 - i : i; bu[i] = *(const S5_LAS unsigned*)(BU + t * (LD_BU * 2) + lane * 4); } }
    if (OLDT) {
#pragma unroll
        for (int kk = 0; kk < 4; ++kk) hf[kk] = *(const S5_LAS bf16x8*)(HS + li * (LD_HS * 2) + (32 * kk + 8 * g) * 2);
        if (POST) {
#pragma unroll
            for (int j = 0; j < 4; ++j) { yprev[j] = *(const S5_LAS unsigned short*)(YL + ((4 * g + j) * 16 + li) * 2); uo[j] = uold[(size_t)(4 * g + j) * ldu + li]; } } }
    if (NEWT) { const bf16x4 uf = __builtin_bit_cast(bf16x4, unew);
#pragma unroll
        for (int ct = 0; ct < 8; ++ct) { acc[ct] = (f32x4){0.f, 0.f, 0.f, 0.f}; acc[ct] = __builtin_amdgcn_mfma_f32_16x16x16bf16_1k(c.bfr[ct], uf, acc[ct], 0, 0, 0); } }
    if (CURT) {
#pragma unroll
        for (int i = 0; i < 16; ++i) { const float br = __uint_as_float(bu[i] << 16), bi = __uint_as_float(bu[i] & 0xffff0000u);
            const float nr = c.ar * hr - c.ai * hi + br, ni = c.ar * hi + c.ai * hr + bi; hr = nr; hi = ni; if (HSW) hs[i] = pk(hr, hi); } }
    if (OLDT) { f32x4 y = {0.f, 0.f, 0.f, 0.f};
#pragma unroll
        for (int kk = 0; kk < 4; ++kk) y = __builtin_amdgcn_mfma_f32_16x16x32_bf16(hf[kk], c.cfr[kk], y, 0, 0, 0);
        if (!POST) {
#pragma unroll
            for (int j = 0; j < 4; ++j) *(S5_LAS unsigned short*)(YL + ((4 * g + j) * 16 + li) * 2) = f2bf(y[j]); }
        else {
#pragma unroll
            for (int j = 0; j < 4; ++j) { const float v = y[j] + __uint_as_float((unsigned)yprev[j] << 16) + dch * __uint_as_float((unsigned)uo[j] << 16); const float tt = 0.7978845608028654f * (v + 0.044715f * v * v * v);
                outp[(size_t)(4 * g + j) * 1024 + li] = f2bf(v * (1.0f - 1.0f / (1.0f + __expf(2.0f * tt)))); } } }
    if (NEWT) {
#pragma unroll
        for (int ct = 0; ct < 8; ++ct) { u32x2 w; w.x = pk(acc[ct][0], acc[ct][1]); w.y = pk(acc[ct][2], acc[ct][3]); *(S5_LAS u32x2*)(BU + (li * LD_BU + 16 * ct + 4 * g) * 2) = w; } }
    if (CURT && HSW) {
#pragma unroll
        for (int i = 0; i < 16; ++i) { const int t = dir ? 15 - i : i; *(S5_LAS unsigned*)(HS + t * (LD_HS * 2) + lane * 4) = hs[i]; } }
}
template <bool POST>
__device__ __forceinline__ void s5_pass(const Ctx& c, S5_LAS unsigned char* wl, int lane, int dir, const unsigned short* __restrict__ U, int ldu, unsigned short* __restrict__ OUT, float dch, float& hr, float& hi) {
    const int li = lane & 15, g = lane >> 4; constexpr int L = 256, ntile = 16;
    S5_LAS unsigned char* BU = wl; S5_LAS unsigned char* HS = wl + OFF_HS; S5_LAS unsigned char* YL = wl + OFF_YL;
#define S5_TB(ti) (dir ? L - 16 * ((ti) + 1) : 16 * (ti))
#define S5_ULOAD(ti) (*(const u32x2*)(U + (size_t)(S5_TB(ti) + li) * ldu + 4 * g))
#define S5_ARGS(ti) YL + S5_TB(ti) * 32, lane, li, g, dir
#define S5_ARGS2(ti) U + (size_t)S5_TB(ti) * ldu, ldu, OUT + (size_t)S5_TB(ti) * 1024, dch
    u32x2 u0 = S5_ULOAD(0), u1 = S5_ULOAD(1), u2 = S5_ULOAD(2);
    step<true, false, true, false, POST>(c, BU, HS, S5_ARGS(0), u0, hr, hi, S5_ARGS2(0));
    step<true, true, true, false, POST>(c, BU, HS, S5_ARGS(0), u1, hr, hi, S5_ARGS2(0));
    u0 = u2; u1 = S5_ULOAD(3); u2 = S5_ULOAD(4);
#pragma clang loop unroll(disable)
    for (int ti = 2; ti < ntile; ++ti) {
        const u32x2 uc = u0; u0 = u1; u1 = u2; if (ti + 3 < ntile) u2 = S5_ULOAD(ti + 3);
        step<true, true, true, true, POST>(c, BU, HS, S5_ARGS(ti - 2), uc, hr, hi, S5_ARGS2(ti - 2));
    }
    step<false, true, true, true, POST>(c, BU, HS, S5_ARGS(ntile - 2), u0, hr, hi, S5_ARGS2(ntile - 2));
    step<false, false, true, true, POST>(c, BU, HS, S5_ARGS(ntile - 1), u0, hr, hi, S5_ARGS2(ntile - 1));
#undef S5_ARGS
#undef S5_ARGS2
}
__device__ __forceinline__ void s5_epass(const Ctx& c, S5_LAS unsigned char* wl, int lane, int dir, const unsigned short* __restrict__ U, int ldu, float& hr, float& hi) {
    const int li = lane & 15, g = lane >> 4; constexpr int L = 256, ntile = 16;
    S5_LAS unsigned char* BU = wl; S5_LAS unsigned char* HS = wl + OFF_HS;
    u32x2 uu[16];
#pragma unroll
    for (int ti = 0; ti < 16; ++ti) uu[ti] = S5_ULOAD(ti);
    step<true, false, false, false, false>(c, BU, HS, HS, lane, li, g, dir, uu[0], hr, hi, nullptr, 0, nullptr, 0.f);
#pragma unroll
    for (int ti = 1; ti < ntile; ++ti) step<true, true, false, false, false>(c, BU, HS, HS, lane, li, g, dir, uu[ti], hr, hi, nullptr, 0, nullptr, 0.f);
    step<false, true, false, false, false>(c, BU, HS, HS, lane, li, g, dir, uu[0], hr, hi, nullptr, 0, nullptr, 0.f);
#undef S5_ULOAD
#undef S5_TB
}
}
typedef unsigned short bf16;
typedef float f32x4 __attribute__((ext_vector_type(4)));
typedef unsigned u32x4 __attribute__((ext_vector_type(4)));
typedef unsigned u32x2 __attribute__((ext_vector_type(2)));
#define LAS __attribute__((address_space(3)))
constexpr int NWAVES = 8, NTHREADS = 512;
constexpr int DM = 2048, MROWS = 16384, MCTX = 8192, KROWS = 18432, NLAYER = 4;
constexpr int NIN = 14336;
constexpr int C_GATE = 0, C_GQ = 8192, C_GK = 9216, C_GV = 9472, C_SZ = 9728, C_XBC = 10752, C_S5U = 12288, C_MQD = 13312, C_CKV = 13824, C_KPE = 14080, C_SDT = 14144, C_END = 14176;
constexpr int FFN = 5632;
constexpr float EPS = 1e-6f;
constexpr size_t MiB = 1u << 20;
constexpr size_t WS_CTL = 0, CTL_ZERO_BYTES = 1 * MiB;
constexpr size_t WS_MOD = 1 * MiB;
constexpr size_t WS_TAB = 2 * MiB;
constexpr size_t WS_X = 4 * MiB;
constexpr size_t WS_H = 132 * MiB;
constexpr size_t WS_PROJ = 196 * MiB;
constexpr size_t WS_W = 644 * MiB;
constexpr size_t W_IN = 0, W_UQ = W_IN + (size_t)NIN * 2048 * 2, W_UKV = W_UQ + (size_t)1536 * 512 * 2, W_GLU = W_UKV + (size_t)2048 * 256 * 2, W_BR = W_GLU + (size_t)2048 * 1024 * 2,
                 W_OUT = W_BR + (size_t)4 * 2048 * 1024 * 2, W_FI = W_OUT + (size_t)2048 * 2048 * 2, W_FO = W_FI + (size_t)11264 * 2048 * 2, W_END = W_FO + (size_t)2048 * 5632 * 2;
static_assert(W_END <= 154 * MiB, "weights region");
constexpr size_t WS_Q = 798 * MiB, WS_KG = 830 * MiB, WS_VG = 839 * MiB, WS_AQ = 848 * MiB, WS_ACKV = 864 * MiB, WS_QM = 873 * MiB, WS_KM = 921 * MiB, WS_VM = 975 * MiB,
                 WS_XBC = 1011 * MiB, WS_DT = 1059 * MiB, WS_YF = 1061 * MiB, WS_YB = 1125 * MiB, WS_SF = 1189 * MiB, WS_SB = 1253 * MiB, WS_S5PRE = 1317 * MiB,
                 WS_O = 1349 * MiB, WS_GSF = 1477 * MiB, WS_GS = 1605 * MiB, WS_END = 1669 * MiB;
constexpr size_t WS_S5C = WS_GSF, WS_S5G = WS_GSF + 4 * MiB, WS_S5E = WS_GSF + 8 * MiB;
constexpr int CW_BAR = 4096;
constexpr size_t O_YP = 0, O_YS = 16777216, O_GK = 33554432, O_GV = 41943040, O_CKV = 50331648, O_KPE = 58720256, O_SSD = 60817408, O_S5 = 94371840, O_TOTAL = 96468992;
constexpr int RING_BYTES = 131072, LDSCTL_OFF = 135168  , MISC_OFF = LDSCTL_OFF + 320, LDS_BYTES = 147456;

#define VM_WAIT() asm volatile("s_waitcnt vmcnt(0)" ::: "memory")
__device__ __forceinline__ unsigned f2bf(float f) { unsigned u = __float_as_uint(f); return (u + 0x7fffu + ((u >> 16) & 1u)) >> 16; }
__device__ __forceinline__ unsigned pk2(float lo, float hi) { typedef float f32x2_t_ __attribute__((ext_vector_type(2))); typedef __bf16 bf16x2_t_ __attribute__((ext_vector_type(2))); const f32x2_t_ v_ = {lo, hi}; const bf16x2_t_ b_ = __builtin_convertvector(v_, bf16x2_t_); return __builtin_bit_cast(unsigned, b_); }
__device__ __forceinline__ float bflo(unsigned w) { return __uint_as_float(w << 16); }
__device__ __forceinline__ float bfhi(unsigned w) { return __uint_as_float(w & 0xffff0000u); }
__device__ __forceinline__ void unpack8(const u32x4 w, float* f) { f[0] = bflo(w.x); f[1] = bfhi(w.x); f[2] = bflo(w.y); f[3] = bfhi(w.y); f[4] = bflo(w.z); f[5] = bfhi(w.z); f[6] = bflo(w.w); f[7] = bfhi(w.w); }
__device__ __forceinline__ u32x4 pack8f(const float* f) { u32x4 w; w.x = pk2(f[0], f[1]); w.y = pk2(f[2], f[3]); w.z = pk2(f[4], f[5]); w.w = pk2(f[6], f[7]); return w; }
__device__ __forceinline__ float wave_sum(float v) {
#pragma unroll
    for (int o = 1; o < 64; o <<= 1) v += __shfl_xor(v, o);
    return v;
}
__device__ __forceinline__ float sigm(float x) { return 1.0f / (1.0f + __expf(-x)); }

struct Args { const float* in[41]; float* out; unsigned char* ws; int ph_lo, ph_hi, li, pad; };
struct Frame {
    LAS unsigned char* lds; int tid, lane, wave, G, bid, gw, NGW;
    const float* const* in; float* out; unsigned char* ws;
    const float* const* in0; float* out0; unsigned char* ws0;
};
enum { I_XP = 0, I_XS, I_CGK, I_CGV, I_CCKV, I_CKPE, I_SSSD, I_SS5, I_C, I_CCTX, I_N1G, I_N2G, I_WMOD, I_BMOD, I_WIN, I_QNG, I_KNG, I_CONVW, I_CONVB, I_ALOG, I_DTB, I_SSDD, I_SSDNG,
       I_MQNG, I_WUQ, I_MKVNG, I_WUKV, I_LRE, I_LIM, I_LSTEP, I_BRE, I_BIM, I_CRE, I_CIM, I_S5D, I_WGLU, I_WBR, I_WOUT, I_WFI, I_WFO, I_FING };

__device__ __forceinline__ void transpose_item(const float* W, int K, int N, bf16* WT, int dst_row0, int k0, int n0, LAS float* scr, int lane) {
#pragma unroll 8
    for (int i = 0; i < 32; ++i) { const int kk = 2 * i + (lane >> 5); scr[kk * 33 + (lane & 31)] = W[(size_t)(k0 + kk) * N + n0 + (lane & 31)]; }
    asm volatile("s_waitcnt lgkmcnt(0)" ::: "memory");
    const int c = lane & 7;
#pragma unroll
    for (int j = 0; j < 4; ++j) { const int n = (lane >> 3) + 8 * j; const LAS float* s = scr + (8 * c) * 33 + n;
        u32x4 o; o.x = pk2(s[0 * 33], s[1 * 33]); o.y = pk2(s[2 * 33], s[3 * 33]); o.z = pk2(s[4 * 33], s[5 * 33]); o.w = pk2(s[6 * 33], s[7 * 33]);
        *(u32x4*)(WT + (size_t)(dst_row0 + n) * K + k0 + 8 * c) = o; }
    asm volatile("s_waitcnt lgkmcnt(0)" ::: "memory");
}
__device__ __forceinline__ int map_in(int c) {
    if (c < 12288) return c; if (c < 12320) return C_SDT + (c - 12288); if (c < 12832) return C_MQD + (c - 12320); if (c < 13152) return C_CKV + (c - 12832); return C_S5U + (c - 13152);
}
__device__ __forceinline__ int map_pair(int c, int half) {
    return c < half ? 256 * (c >> 7) + (c & 127) : 256 * ((c - half) >> 7) + 128 + ((c - half) & 127);
}
__device__ __forceinline__ void phase_zero_pad(Frame& F) {
    bf16* Wi = (bf16*)((char*)(F.ws + WS_W) + W_IN); const u32x4 z = {0u, 0u, 0u, 0u};
    for (int r = F.gw; r < NIN - C_END; r += F.NGW) { u32x4* p = (u32x4*)(Wi + (size_t)(C_END + r) * 2048);
#pragma unroll
        for (int j = 0; j < 4; ++j) p[F.lane + 64 * j] = z; }
}
__device__ __forceinline__ void phase_prologue(Frame& F) {
    LAS float* sc = (LAS float*)F.lds;
    LAS float* part = (LAS float*)(F.lds + 40960);
    float* MOD = (float*)(F.ws + WS_MOD);
    for (int i = F.tid; i < 5 * 2048; i += NTHREADS) { const int v = i >> 11, k = i & 2047; const float x = v == 0 ? F.in[I_CCTX][k] : F.in[I_C][(v - 1) * 2048 + k]; sc[i] = x * sigm(x); }
    __syncthreads();
    for (int it = F.bid; it < 192; it += F.G) {
        const int l = it / 48, cg = it % 48; const float* W = F.in[I_WMOD] + (size_t)l * 2048 * 12288 + 256 * cg + 4 * F.lane;
        f32x4 acc[5];
#pragma unroll
        for (int v = 0; v < 5; ++v) acc[v] = (f32x4){0.f, 0.f, 0.f, 0.f};
        const int k0 = 256 * F.wave;
#pragma unroll 16
        for (int k = 0; k < 256; ++k) { const f32x4 w = *(const f32x4*)(W + (size_t)(k0 + k) * 12288);
#pragma unroll
            for (int v = 0; v < 5; ++v) acc[v] += sc[v * 2048 + k0 + k] * w; }
#pragma unroll
        for (int v = 0; v < 5; ++v) *(LAS f32x4*)(part + (F.wave * 5 + v) * 256 + 4 * F.lane) = acc[v];
        __syncthreads();
        for (int o = F.tid; o < 1280; o += NTHREADS) { const int v = o >> 8, col = o & 255; float s = F.in[I_BMOD][l * 12288 + 256 * cg + col];
#pragma unroll
            for (int w = 0; w < 8; ++w) s += part[(w * 5 + v) * 256 + col];
            MOD[((size_t)l * 5 + v) * 12288 + 256 * cg + col] = s; }
        __syncthreads();
    }
    for (int i = F.gw; i < NLAYER * 2 * 64; i += F.NGW) { const int layer = i >> 7, dir = (i >> 6) & 1, g = i & 63; const size_t pg = (size_t)(layer * 2 + dir) * 64 + g;
        s5::make_consts(F.ws + WS_S5C + (size_t)i * s5::CD_BYTES, dir == 0 ? F.ws + WS_S5G + ((size_t)layer * 64 + g) * s5::CG_BYTES : nullptr, F.in[I_LRE] + pg * 64, F.in[I_LIM] + pg * 64, expf(F.in[I_LSTEP][pg]),
                        F.in[I_BRE] + ((size_t)layer * 64 + g) * 1024, F.in[I_BIM] + ((size_t)layer * 64 + g) * 1024, F.in[I_CRE] + ((size_t)layer * 64 + g) * 1024, F.in[I_CIM] + ((size_t)layer * 64 + g) * 1024, F.lane); }
    if (F.bid == F.G - 1) {
        float2* tA = (float2*)(F.ws + WS_TAB); float2* tC = tA + 64 * 32;
        for (int i = F.tid; i < 64 * 32; i += NTHREADS) { const int pos = i >> 5, f = i & 31; const float a = (float)pos * expf(-(float)f * (9.210340371976184f / 32.0f)); float sn, cs; sincosf(a, &sn, &cs); tA[i] = make_float2(cs, sn); }
        for (int i = F.tid; i < 64 * 16; i += NTHREADS) { const int pos = i >> 4, f = i & 15; const float a = (float)pos * expf(-(float)f * (9.210340371976184f / 16.0f)); float sn, cs; sincosf(a, &sn, &cs); tC[i] = make_float2(cs, sn); }
    }
}
__device__ __forceinline__ void phase_norm(Frame& F, int layer, int which  , bool from_input) {
    float* X = (float*)(F.ws + WS_X); bf16* H = (bf16*)(F.ws + WS_H); const float* MOD = (const float*)(F.ws + WS_MOD) + (size_t)layer * 5 * 12288;
    const float* gw = F.in[which ? I_N2G : I_N1G] + layer * 2048;
    for (int m = F.gw; m < MROWS; m += F.NGW) {
        const float* src = from_input ? (m < MCTX ? F.in[I_XP] + (size_t)m * DM : F.in[I_XS] + (size_t)(m - MCTX) * DM) : X + (size_t)m * DM;
        const int mrow = m < MCTX ? 0 : 1 + ((m - MCTX) >> 11); const float* sh = MOD + mrow * 12288 + (which ? 3 : 0) * 2048; const float* scl = sh + 2048;
        f32x4 v[8]; float ss = 0.f;
#pragma unroll
        for (int j = 0; j < 8; ++j) { v[j] = *(const f32x4*)(src + 4 * F.lane + 256 * j); ss += v[j][0] * v[j][0] + v[j][1] * v[j][1] + v[j][2] * v[j][2] + v[j][3] * v[j][3]; }
        if (from_input) {
#pragma unroll
            for (int j = 0; j < 8; ++j) *(f32x4*)(X + (size_t)m * DM + 4 * F.lane + 256 * j) = v[j]; }
        const float rstd = rsqrtf(wave_sum(ss) * (1.0f / DM) + EPS);
#pragma unroll
        for (int j = 0; j < 8; ++j) { const int c = 4 * F.lane + 256 * j; const f32x4 g = *(const f32x4*)(gw + c), s1 = *(const f32x4*)(scl + c), s0 = *(const f32x4*)(sh + c);
            const f32x4 o = v[j] * rstd * g * (1.0f + s1) + s0; u32x2 w; w.x = pk2(o[0], o[1]); w.y = pk2(o[2], o[3]); *(u32x2*)(H + (size_t)m * DM + c) = w; }
    }
}
__device__ __forceinline__ void phase_final_norm(Frame& F) {
    const float* X = (const float*)(F.ws + WS_X); const float* gw = F.in[I_FING];
    for (int m = F.gw; m < MROWS; m += F.NGW) {
        f32x4 v[8]; float ss = 0.f;
#pragma unroll
        for (int j = 0; j < 8; ++j) { v[j] = *(const f32x4*)(X + (size_t)m * DM + 4 * F.lane + 256 * j); ss += v[j][0] * v[j][0] + v[j][1] * v[j][1] + v[j][2] * v[j][2] + v[j][3] * v[j][3]; }
        const float rstd = rsqrtf(wave_sum(ss) * (1.0f / DM) + EPS);
#pragma unroll
        for (int j = 0; j < 8; ++j) { const int c = 4 * F.lane + 256 * j; *(f32x4*)(F.out + O_YP + (size_t)m * DM + c) = v[j] * rstd * *(const f32x4*)(gw + c); }
    }
}
__device__ __forceinline__ void phase_prep(Frame& F, int layer) {
    const bf16* PROJ = (const bf16*)(F.ws + WS_PROJ);
    bf16* Q = (bf16*)(F.ws + WS_Q); bf16* KG = (bf16*)(F.ws + WS_KG); bf16* VG = (bf16*)(F.ws + WS_VG); bf16* AQ = (bf16*)(F.ws + WS_AQ); bf16* ACKV = (bf16*)(F.ws + WS_ACKV);
    bf16* KM = (bf16*)(F.ws + WS_KM); bf16* XBC = (bf16*)(F.ws + WS_XBC); float* DT = (float*)(F.ws + WS_DT);
    const float2* tA = (const float2*)(F.ws + WS_TAB); const float2* tC = tA + 64 * 32;
    const int lane = F.lane;
    for (int vr = F.gw; vr < KROWS; vr += F.NGW) {
        if (vr >= MROWS) {
            const int c = vr - MROWS, b = c >> 9, j = c & 511; const size_t kr = MCTX + (size_t)b * 2560 + 2048 + j; const size_t ci = ((size_t)b * 4 + layer) * 512 + j;
            { const f32x4 a = *(const f32x4*)(F.in[I_CGK] + ci * 256 + 4 * lane); u32x2 w; w.x = pk2(a[0], a[1]); w.y = pk2(a[2], a[3]); *(u32x2*)(KG + kr * 256 + 4 * lane) = w; }
            { const f32x4 a = *(const f32x4*)(F.in[I_CGV] + ci * 256 + 4 * lane); u32x2 w; w.x = pk2(a[0], a[1]); w.y = pk2(a[2], a[3]); *(u32x2*)(VG + kr * 256 + 4 * lane) = w; }
            { const f32x4 a = *(const f32x4*)(F.in[I_CCKV] + ci * 256 + 4 * lane); u32x2 w; w.x = pk2(a[0], a[1]); w.y = pk2(a[2], a[3]); *(u32x2*)(ACKV + kr * 256 + 4 * lane) = w; }
            { const bf16 kp = (bf16)f2bf(F.in[I_CKPE][ci * 64 + lane]);
#pragma unroll
              for (int hh = 0; hh < 8; ++hh) KM[kr * 1536 + hh * 192 + 128 + lane] = kp; }
            continue;
        }
        const int m = vr; const bool lat = m >= MCTX; const int bb = lat ? (m - MCTX) >> 11 : m >> 8; const int t = lat ? (m - MCTX) & 2047 : m & 255; const int L = lat ? 2048 : 256;
        const size_t kr = lat ? MCTX + (size_t)bb * 2560 + t : (size_t)m; const int rowpos = t >> 6, colpos = t & 63;
        const bf16* pr = PROJ + (size_t)m * NIN; const size_t orow = ((size_t)bb * 4 + layer) * 256 + t;
        const int j8 = lane & 7, ax = j8 >> 2, fo = (j8 & 3) * 8;
        const u32x4 ldq0 = *(const u32x4*)(pr + C_GQ + (lane >> 3) * 128 + ax * 64 + fo), ldq1 = *(const u32x4*)(pr + C_GQ + (lane >> 3) * 128 + ax * 64 + fo + 32);
        const u32x4 ldk0 = *(const u32x4*)(pr + C_GK + ((lane >> 3) & 1) * 128 + ax * 64 + fo), ldk1 = *(const u32x4*)(pr + C_GK + ((lane >> 3) & 1) * 128 + ax * 64 + fo + 32);
        const u32x4 ldv = *(const u32x4*)(pr + C_GV + 8 * (lane & 31));
        const u32x4 ldqd = *(const u32x4*)(pr + C_MQD + 8 * lane);
        const u32x4 ldck = *(const u32x4*)(pr + C_CKV + 8 * (lane & 31));
        const int axp = (lane >> 1) & 1, fop = (lane & 1) * 8;
        const u32x4 ldp0 = *(const u32x4*)(pr + C_KPE + axp * 32 + fop), ldp1 = *(const u32x4*)(pr + C_KPE + axp * 32 + fop + 16);
        u32x4 ldc[3][5];
#pragma unroll
        for (int i = 0; i < 3; ++i)
#pragma unroll
            for (int k = 0; k < 5; ++k) { const int tt = t + k - 2; const bool ok = tt >= 0 && tt < L; ldc[i][k] = *(const u32x4*)(pr + (ok ? (ptrdiff_t)(k - 2) * NIN : 0) + C_XBC + 8 * lane + 512 * i); if (!ok) ldc[i][k] = (u32x4){0u, 0u, 0u, 0u}; }
        const unsigned short lddt = pr[C_SDT + (lane & 31)];
        { const float2* tp = tA + (ax ? colpos : rowpos) * 32 + fo;
          { const int hq = lane >> 3; float x0[8], x1[8]; unpack8(ldq0, x0); unpack8(ldq1, x1);
            float ss = 0.f;
#pragma unroll
            for (int e = 0; e < 8; ++e) ss += x0[e] * x0[e] + x1[e] * x1[e];
            ss += __shfl_xor(ss, 1); ss += __shfl_xor(ss, 2); ss += __shfl_xor(ss, 4);
            const float rstd = rsqrtf(ss * (1.0f / 128.0f) + EPS); const float* gq = F.in[I_QNG] + layer * 128 + ax * 64 + fo;
#pragma unroll
            for (int e = 0; e < 8; ++e) { float a = x0[e] * rstd * gq[e], b = x1[e] * rstd * gq[32 + e]; if (lat) { const float2 cs = tp[e]; const float a2 = a * cs.x - b * cs.y; b = a * cs.y + b * cs.x; a = a2; } x0[e] = a; x1[e] = b; }
            bf16* q = Q + (size_t)m * 1024 + hq * 128 + ax * 64 + fo; *(u32x4*)q = pack8f(x0); *(u32x4*)(q + 32) = pack8f(x1); }
          { const int kh = (lane >> 3) & 1; float x0[8], x1[8]; unpack8(ldk0, x0); unpack8(ldk1, x1);
            float ss = 0.f;
#pragma unroll
            for (int e = 0; e < 8; ++e) ss += x0[e] * x0[e] + x1[e] * x1[e];
            ss += __shfl_xor(ss, 1); ss += __shfl_xor(ss, 2); ss += __shfl_xor(ss, 4);
            const float rstd = rsqrtf(ss * (1.0f / 128.0f) + EPS); const float* gk = F.in[I_KNG] + layer * 128 + ax * 64 + fo;
#pragma unroll
            for (int e = 0; e < 8; ++e) { x0[e] *= rstd * gk[e]; x1[e] *= rstd * gk[32 + e]; }
            if (lane < 16) {
            if (!lat) { float* o = F.out + O_GK + orow * 256 + kh * 128 + ax * 64 + fo; *(f32x4*)o = (f32x4){x0[0], x0[1], x0[2], x0[3]}; *(f32x4*)(o + 4) = (f32x4){x0[4], x0[5], x0[6], x0[7]};
                        *(f32x4*)(o + 32) = (f32x4){x1[0], x1[1], x1[2], x1[3]}; *(f32x4*)(o + 36) = (f32x4){x1[4], x1[5], x1[6], x1[7]}; }
            else {
#pragma unroll
                for (int e = 0; e < 8; ++e) { const float2 cs = tp[e]; const float a = x0[e], b = x1[e]; x0[e] = a * cs.x - b * cs.y; x1[e] = a * cs.y + b * cs.x; } }
            bf16* k = KG + kr * 256 + kh * 128 + ax * 64 + fo; *(u32x4*)k = pack8f(x0); *(u32x4*)(k + 32) = pack8f(x1); } }
          if (lane < 32) { *(u32x4*)(VG + kr * 256 + 8 * lane) = ldv;
            if (!lat) { float x[8]; unpack8(ldv, x); float* o = F.out + O_GV + orow * 256 + 8 * lane; *(f32x4*)o = (f32x4){x[0], x[1], x[2], x[3]}; *(f32x4*)(o + 4) = (f32x4){x[4], x[5], x[6], x[7]}; } }
        }
        { float x[8]; unpack8(ldqd, x); float ss = 0.f;
#pragma unroll
          for (int e = 0; e < 8; ++e) ss += x[e] * x[e];
          const float rstd = rsqrtf(wave_sum(ss) * (1.0f / 512.0f) + EPS); const float* g = F.in[I_MQNG] + layer * 512 + 8 * lane;
#pragma unroll
          for (int e = 0; e < 8; ++e) x[e] *= rstd * g[e];
          *(u32x4*)(AQ + (size_t)m * 512 + 8 * lane) = pack8f(x); }
        { float x[8]; float ss = 0.f; unpack8(ldck, x);
          if (lane < 32) {
#pragma unroll
            for (int e = 0; e < 8; ++e) ss += x[e] * x[e]; }
          ss = wave_sum(ss);
          if (lane < 32) { const float rstd = rsqrtf(ss * (1.0f / 256.0f) + EPS); const float* g = F.in[I_MKVNG] + layer * 256 + 8 * lane;
#pragma unroll
            for (int e = 0; e < 8; ++e) x[e] *= rstd * g[e];
            *(u32x4*)(ACKV + kr * 256 + 8 * lane) = pack8f(x);
            if (!lat) { float* o = F.out + O_CKV + orow * 256 + 8 * lane; *(f32x4*)o = (f32x4){x[0], x[1], x[2], x[3]}; *(f32x4*)(o + 4) = (f32x4){x[4], x[5], x[6], x[7]}; } }
          if (lane < 4) { float x0[8], x1[8]; unpack8(ldp0, x0); unpack8(ldp1, x1);
            if (!lat) { float* o = F.out + O_KPE + orow * 64 + axp * 32 + fop; *(f32x4*)o = (f32x4){x0[0], x0[1], x0[2], x0[3]}; *(f32x4*)(o + 4) = (f32x4){x0[4], x0[5], x0[6], x0[7]};
                        *(f32x4*)(o + 16) = (f32x4){x1[0], x1[1], x1[2], x1[3]}; *(f32x4*)(o + 20) = (f32x4){x1[4], x1[5], x1[6], x1[7]}; }
            else { const float2* tp = tC + (axp ? colpos : rowpos) * 16 + fop;
#pragma unroll
                for (int e = 0; e < 8; ++e) { const float2 cs = tp[e]; const float a = x0[e], b = x1[e]; x0[e] = a * cs.x - b * cs.y; x1[e] = a * cs.y + b * cs.x; } }
            const u32x4 w0 = pack8f(x0), w1 = pack8f(x1);
#pragma unroll
            for (int hh = 0; hh < 8; ++hh) { bf16* k = KM + kr * 1536 + hh * 192 + 128 + axp * 32 + fop; *(u32x4*)k = w0; *(u32x4*)(k + 16) = w1; } }
        }
        { const float* cw = F.in[I_CONVW] + (size_t)layer * 5 * 1536; const float* cb = F.in[I_CONVB] + layer * 1536;
#pragma unroll
          for (int i = 0; i < 3; ++i) { const int ch = 8 * lane + 512 * i; float acc[8];
            { const f32x4 b0 = *(const f32x4*)(cb + ch), b1 = *(const f32x4*)(cb + ch + 4); acc[0] = b0[0]; acc[1] = b0[1]; acc[2] = b0[2]; acc[3] = b0[3]; acc[4] = b1[0]; acc[5] = b1[1]; acc[6] = b1[2]; acc[7] = b1[3]; }
#pragma unroll
            for (int k = 0; k < 5; ++k) { float x[8]; unpack8(ldc[i][k], x);
                const f32x4 w0 = *(const f32x4*)(cw + k * 1536 + ch), w1 = *(const f32x4*)(cw + k * 1536 + ch + 4);
                acc[0] += w0[0] * x[0]; acc[1] += w0[1] * x[1]; acc[2] += w0[2] * x[2]; acc[3] += w0[3] * x[3]; acc[4] += w1[0] * x[4]; acc[5] += w1[1] * x[5]; acc[6] += w1[2] * x[6]; acc[7] += w1[3] * x[7]; }
#pragma unroll
            for (int e = 0; e < 8; ++e) acc[e] = acc[e] * sigm(acc[e]);
            *(u32x4*)(XBC + (size_t)m * 1536 + ch) = pack8f(acc); }
          if (lane < 32) { const float raw = __uint_as_float((unsigned)lddt << 16) + F.in[I_DTB][layer * 32 + lane]; const float ey = __expf(raw); DT[(size_t)m * 32 + lane] = raw > 20.f ? raw : (ey < 1e-3f ? ey * (1.0f - 0.5f * ey) : __logf(1.0f + ey)); }
        }
    }
    { LAS unsigned char* wl = F.lds + F.wave * s5::WAVE_LDS; float* S5E = (float*)(F.ws + WS_S5E);
      for (int e = F.gw; e < 4096; e += F.NGW) { const int b = e >> 10, seg = (e >> 7) & 7, g = (e >> 1) & 63, dir = e & 1;
        s5::Ctx c; s5::load_ctx(c, F.ws + WS_S5C + (size_t)((layer * 2 + dir) * 64 + g) * s5::CD_BYTES, nullptr, lane, false);
        float hr = 0.f, hi = 0.f;
        s5::s5_epass(c, wl, lane, dir, PROJ + (size_t)(MCTX + b * 2048 + seg * 256) * NIN + C_S5U + g * 16, NIN, hr, hi);
        float* eo = S5E + ((((size_t)b * 8 + seg) * 64 + g) * 2 + dir) * 128; eo[lane] = hr; eo[64 + lane] = hi; } }
}
__device__ __forceinline__ void phase_ssd_finish(Frame& F, int layer) {
    const bf16* PROJ = (const bf16*)(F.ws + WS_PROJ); const bf16* XBC = (const bf16*)(F.ws + WS_XBC); const bf16* YF = (const bf16*)(F.ws + WS_YF); const bf16* YB = (const bf16*)(F.ws + WS_YB);
    bf16* OB = (bf16*)(F.ws + WS_O) + (size_t)1 * MROWS * 1024; const int lane = F.lane;
    const float dh = F.in[I_SSDD][layer * 16 + (lane >> 2)]; const float* g = F.in[I_SSDNG] + layer * 1024 + 16 * lane;
    for (int m = F.gw; m < MROWS; m += F.NGW) {
        float x[16], z[16], y[16]; unpack8(*(const u32x4*)(XBC + (size_t)m * 1536 + 16 * lane), x); unpack8(*(const u32x4*)(XBC + (size_t)m * 1536 + 16 * lane + 8), x + 8);
        unpack8(*(const u32x4*)(PROJ + (size_t)m * NIN + C_SZ + 16 * lane), z); unpack8(*(const u32x4*)(PROJ + (size_t)m * NIN + C_SZ + 16 * lane + 8), z + 8);
        float ss = 0.f; float yf[16], yb[16];
        unpack8(*(const u32x4*)(YF + (size_t)m * 1024 + 16 * lane), yf); unpack8(*(const u32x4*)(YF + (size_t)m * 1024 + 16 * lane + 8), yf + 8);
        unpack8(*(const u32x4*)(YB + (size_t)m * 1024 + 16 * lane), yb); unpack8(*(const u32x4*)(YB + (size_t)m * 1024 + 16 * lane + 8), yb + 8);
#pragma unroll
        for (int i = 0; i < 16; ++i) { const float v = (yf[i] + yb[i] + dh * x[i]) * (z[i] * sigm(z[i])); y[i] = v; ss += v * v; }
        const float rstd = rsqrtf(wave_sum(ss) * (1.0f / 1024.0f) + EPS);
#pragma unroll
        for (int i = 0; i < 16; ++i) y[i] *= rstd * g[i];
        *(u32x4*)(OB + (size_t)m * 1024 + 16 * lane) = pack8f(y); *(u32x4*)(OB + (size_t)m * 1024 + 16 * lane + 8) = pack8f(y + 8);
    }
}
struct ConvItem { const float* src; bf16* dst; int K, N, mode, half, k0, n0; };
typedef float cvf4 __attribute__((ext_vector_type(4)));
__device__ __forceinline__ const float* conv_ptr(const ConvItem& c, int lane) { const int n4 = c.n0 + 4 * (lane & 15); return c.src + (size_t)(c.k0 + 8 * (lane >> 4)) * c.N + (n4 < c.N ? n4 : c.N - 4); }
__device__ __forceinline__ void conv_load1(const float* p, size_t N, int i, float (&w)[32]) { const cvf4 v = *(const cvf4*)(p + (size_t)i * N); w[4 * i] = v[0]; w[4 * i + 1] = v[1]; w[4 * i + 2] = v[2]; w[4 * i + 3] = v[3]; }
__device__ __forceinline__ void conv_load(const ConvItem& c, int lane, float (&w)[32]) {
    const float* p = conv_ptr(c, lane);
#pragma unroll
    for (int i = 0; i < 8; ++i) conv_load1(p, (size_t)c.N, i, w);
}
__device__ __forceinline__ void conv_store(const ConvItem& c, int lane, const float (&w)[32]) {
    const int n4 = c.n0 + 4 * (lane & 15);
    if (n4 < c.N) {
#pragma unroll
        for (int j = 0; j < 4; ++j) { const int n = n4 + j; const int row = c.mode == 0 ? n : (c.mode == 1 ? map_in(n) : map_pair(n, c.half)); bf16* d = c.dst + (size_t)row * c.K + c.k0 + 8 * (lane >> 4);
            u32x4 o; o.x = pk2(w[j], w[4 + j]); o.y = pk2(w[8 + j], w[12 + j]); o.z = pk2(w[16 + j], w[20 + j]); o.w = pk2(w[24 + j], w[28 + j]); *(u32x4*)d = o; } }
}
constexpr int CV_A0 = 64 * 176, CV_A1 = CV_A0 + 176 * 32, CV_A2 = CV_A1 + 64 * 32, CV_A3 = CV_A2 + 4 * 32 * 32, CV_A4 = CV_A3 + 32 * 32;
constexpr int CV_B0 = 64 * 222, CV_B1 = CV_B0 + 16 * 24, CV_B2 = CV_B1 + 8 * 32;
__device__ __forceinline__ ConvItem conv_decode(int set, int it, int layer, const float* const* in, unsigned char* ws) {
    ConvItem c; char* WB = (char*)(ws + WS_W);
    if (set == 0) {
        if (it < CV_A0) { c.src = in[I_WFI] + (size_t)layer * 2048 * 11264; c.dst = (bf16*)(WB + W_FI); c.K = 2048; c.N = 11264; c.mode = 2; c.half = 5632; c.k0 = 32 * (it / 176); c.n0 = 64 * (it % 176); }
        else if (it < CV_A1) { const int r = it - CV_A0; c.src = in[I_WFO] + (size_t)layer * 5632 * 2048; c.dst = (bf16*)(WB + W_FO); c.K = 5632; c.N = 2048; c.mode = 0; c.half = 0; c.k0 = 32 * (r / 32); c.n0 = 64 * (r % 32); }
        else if (it < CV_A2) { const int r = it - CV_A1; c.src = in[I_WOUT] + (size_t)layer * 2048 * 2048; c.dst = (bf16*)(WB + W_OUT); c.K = 2048; c.N = 2048; c.mode = 0; c.half = 0; c.k0 = 32 * (r / 32); c.n0 = 64 * (r % 32); }
        else if (it < CV_A3) { const int r = it - CV_A2, br = r >> 10, q = r & 1023; c.src = in[I_WBR] + ((size_t)layer * 4 + br) * 1024 * 2048; c.dst = (bf16*)(WB + W_BR) + (size_t)br * 2048 * 1024; c.K = 1024; c.N = 2048; c.mode = 0; c.half = 0; c.k0 = 32 * (q / 32); c.n0 = 64 * (q % 32); }
        else { const int r = it - CV_A3; c.src = in[I_WGLU] + (size_t)layer * 1024 * 2048; c.dst = (bf16*)(WB + W_GLU); c.K = 1024; c.N = 2048; c.mode = 2; c.half = 1024; c.k0 = 32 * (r / 32); c.n0 = 64 * (r % 32); }
    } else {
        if (it < CV_B0) { c.src = in[I_WIN] + (size_t)layer * 2048 * 14176; c.dst = (bf16*)(WB + W_IN); c.K = 2048; c.N = 14176; c.mode = 1; c.half = 0; c.k0 = 32 * (it / 222); c.n0 = 64 * (it % 222); }
        else if (it < CV_B1) { const int r = it - CV_B0; c.src = in[I_WUQ] + (size_t)layer * 512 * 1536; c.dst = (bf16*)(WB + W_UQ); c.K = 512; c.N = 1536; c.mode = 0; c.half = 0; c.k0 = 32 * (r / 24); c.n0 = 64 * (r % 24); }
        else { const int r = it - CV_B1; c.src = in[I_WUKV] + (size_t)layer * 256 * 2048; c.dst = (bf16*)(WB + W_UKV); c.K = 256; c.N = 2048; c.mode = 0; c.half = 0; c.k0 = 32 * (r / 32); c.n0 = 64 * (r % 32); }
    }
    return c;
}
__device__ __forceinline__ void conv_run(int set, int layer, int first, int stride, const float* const* in, unsigned char* ws, int lane) {
    const int total = set == 0 ? CV_A4 : CV_B2;
    for (int it = first; it < total; it += stride) { const ConvItem c = conv_decode(set, it, layer, in, ws); float w[32]; conv_load(c, lane, w); conv_store(c, lane, w); }
}
struct AttnConv {
    const float* const* in; unsigned char* ws; int layer, gw, NGW, total, cnt, lane;
    ConvItem c; bool on;
    __device__ __forceinline__ void begin(float (&w)[32]) {
        const int it = cnt * NGW + gw; on = it < total;
        if (on) { ++cnt; c = it < CV_A4 ? conv_decode(0, it, layer, in, ws) : conv_decode(1, it - CV_A4, layer + 1, in, ws); conv_load(c, lane, w); }
    }
    __device__ __forceinline__ void end(const float (&w)[32]) { if (on) { conv_store(c, lane, w); on = false; } }
    __device__ __forceinline__ bool pending() const { return on; }
    static constexpr bool RIDES = true;
    __device__ __forceinline__ void decode() { const int it = cnt * NGW + gw; on = it < total; const int ic = on ? it : total - 1; cnt += on ? 1 : 0; c = ic < CV_A4 ? conv_decode(0, ic, layer, in, ws) : conv_decode(1, ic - CV_A4, layer + 1, in, ws); }
    __device__ __forceinline__ void part(float (&w)[32], int i) { conv_load1(conv_ptr(c, lane), (size_t)c.N, i, w); }
    __device__ __forceinline__ void rest(float (&w)[32]) { const float* p = conv_ptr(c, lane);
#pragma unroll
        for (int i = 4; i < 8; ++i) conv_load1(p, (size_t)c.N, i, w); }
    __device__ __forceinline__ void finish() { for (int it = cnt * NGW + gw; it < total; it += NGW) { const ConvItem ci = it < CV_A4 ? conv_decode(0, it, layer, in, ws) : conv_decode(1, it - CV_A4, layer + 1, in, ws); float w[32]; conv_load(ci, lane, w); conv_store(ci, lane, w); } }
};
struct NoConv { static constexpr bool RIDES = false; __device__ __forceinline__ void begin(float (&)[32]) {} __device__ __forceinline__ void end(const float (&)[32]) {} __device__ __forceinline__ bool pending() const { return false; }
    __device__ __forceinline__ void decode() {} __device__ __forceinline__ void part(float (&)[32], int) {} __device__ __forceinline__ void rest(float (&)[32]) {} };
template <class Epi> struct EpiConv {
    static constexpr bool PERM = Epi::PERM, AFTER_DRAIN = false;
    Epi e; const float* const* in; unsigned char* ws; int layer, set, gw, NGW, total, first; mutable int cnt;
    __device__ __forceinline__ bool keep(const pg8::Unit& u) const { return e.keep(u); }
    template <class ACC> __device__ __forceinline__ void operator()(ACC& acc, const pg8::Unit& u, int wr, int wc, int fr, int fq) const {
        const int it = first + cnt * NGW + gw; ++cnt; const bool on = it < total; const int lane = threadIdx.x & 63;
        ConvItem c; float w[32];
        if (on) { c = conv_decode(set, it, layer, in, ws); conv_load(c, lane, w); }
        e(acc, u, wr, wc, fr, fq);
        if (on) conv_store(c, lane, w);
    }
};
#define XB_TMO      128
#define XB_XCNT(j)  (256  + 64 * (j))
#define XB_XSUB(j)  (1280 + 64 * (j))
#define XB_XGEN(j)  (2304 + 64 * (j))
#define XB_TOP      3328
#define XB_TOPGEN   3392
#define XCD_BAR_WORDS 3456
#define XB_SPIN_CAP (1u << 18)

__device__ __forceinline__ unsigned xb_ld(unsigned* p)              { return __hip_atomic_load(p, __ATOMIC_RELAXED, __HIP_MEMORY_SCOPE_AGENT); }
__device__ __forceinline__ unsigned xb_add(unsigned* p, unsigned v) { return __hip_atomic_fetch_add(p, v, __ATOMIC_RELAXED, __HIP_MEMORY_SCOPE_AGENT); }
__device__ __forceinline__ unsigned xb_xcc_id() { return (unsigned)__builtin_amdgcn_s_getreg((3 << 11) | 20) & 0xFu; }
#define XB_SPIN(cond, bar) do { unsigned _sp = 0; while (cond) { __builtin_amdgcn_s_sleep(1); \
    if ((++_sp & 255u) == 0u) { if (xb_ld(&(bar)[XB_TMO])) break; if (_sp > XB_SPIN_CAP) { atomicAdd(&(bar)[XB_TMO], 1u); break; } } } } while (0)

struct XcdBarrier {
    unsigned* bar; unsigned x;
    volatile LAS unsigned* st;
};

__device__ __forceinline__ XcdBarrier xcd_barrier_post(unsigned* bar, volatile LAS unsigned* st) {
    XcdBarrier b; b.bar = bar; b.x = xb_xcc_id(); b.st = st;
    if (threadIdx.x == 0) (void)xb_add(&bar[XB_XCNT(b.x)], 1u);
    return b;
}
__device__ __forceinline__ void xcd_barrier_complete(unsigned* bar, unsigned x, unsigned& nloc, unsigned& nx) {
    const unsigned G = gridDim.x * gridDim.y * gridDim.z;
    unsigned sum, cnt, mine, sp = 0u;
    for (;;) {
        sum = 0u; cnt = 0u; mine = 0u;
#pragma unroll
        for (unsigned j = 0; j < 16; ++j) { const unsigned c = xb_ld(&bar[XB_XCNT(j)]); sum += c; cnt += (c > 0u) ? 1u : 0u; mine = (j == x) ? c : mine; }
        if (sum == G) break;
        __builtin_amdgcn_s_sleep(1);
        if ((++sp & 255u) == 0u) { if (xb_ld(&bar[XB_TMO])) break; if (sp > XB_SPIN_CAP) { atomicAdd(&bar[XB_TMO], 1u); break; } }
    }
    nloc = mine > 0u ? mine : 1u; nx = cnt > 0u ? cnt : 1u;
}

__device__ __forceinline__ void xcd_barrier(const XcdBarrier& b) {
    asm volatile("s_waitcnt vmcnt(0)" ::: "memory");
    __syncthreads();
    if (threadIdx.x == 0) {
        unsigned* bar = b.bar;
        __builtin_amdgcn_s_waitcnt(0);
        unsigned nloc = b.st[0], nx = b.st[1];
        if (nloc == 0u) { xcd_barrier_complete(bar, b.x, nloc, nx); b.st[0] = nloc; b.st[1] = nx; }
        const unsigned old = xb_add(&bar[XB_XSUB(b.x)], 1u);
        const unsigned gen = old / nloc;
        if (old + 1u == (gen + 1u) * nloc) {
            __builtin_amdgcn_fence(__ATOMIC_RELEASE, "agent");
            asm volatile("s_waitcnt vmcnt(0)" ::: "memory");
            const unsigned og = xb_add(&bar[XB_TOP], 1u);
            const unsigned tg = og / nx;
            if (og + 1u == (tg + 1u) * nx) xb_add(&bar[XB_TOPGEN], 1u);
            else XB_SPIN(xb_ld(&bar[XB_TOPGEN]) == tg, bar);
            __builtin_amdgcn_fence(__ATOMIC_ACQUIRE, "agent");
            xb_add(&bar[XB_XGEN(b.x)], 1u);
            asm volatile("s_waitcnt vmcnt(0)" ::: "memory");
        } else {
            XB_SPIN(xb_ld(&bar[XB_XGEN(b.x)]) == gen, bar);
            __builtin_amdgcn_fence(__ATOMIC_ACQUIRE, "agent");
            asm volatile("s_waitcnt vmcnt(0)" ::: "memory");
        }
    }
    __syncthreads();
}
#ifndef MLA_SDEPTH
#define MLA_SDEPTH 1
#endif
constexpr int NPHASE = 42;
#ifndef MK_N_LAUNCHES
#define MK_N_LAUNCHES 1
#endif
__device__ __forceinline__ void run_attn_gqa(Frame& F, int layer) {
    AttnConv cv; cv.in = F.in; cv.ws = F.ws; cv.layer = layer; cv.gw = F.gw; cv.NGW = F.NGW; cv.total = CV_A4 + (layer + 1 < NLAYER ? CV_B0 : 0); cv.cnt = 0; cv.lane = F.lane; cv.on = false;
    const bf16* Q = (const bf16*)(F.ws + WS_Q); const bf16* KG = (const bf16*)(F.ws + WS_KG); const bf16* VG = (const bf16*)(F.ws + WS_VG); bf16* OA = (bf16*)(F.ws + WS_O);
    for (int u = F.bid; u < 512; u += F.G) {
        size_t qrow, krow; int hq, seq;
        if (u < 256) { const int b = u >> 6, qb = u & 7; hq = (u >> 3) & 7; qrow = MCTX + (size_t)b * 2048 + qb * 256; krow = MCTX + (size_t)b * 2560; seq = 2560; }
        else { const int v = u - 256, b = v >> 3; hq = v & 7; qrow = (size_t)b * 256; krow = qrow; seq = 256; }
        att::attn_body_simple<128, 1024, 256, 256, 1024>(Q + qrow * 1024 + hq * 128, KG + krow * 256 + (hq >> 2) * 128, VG + krow * 256 + (hq >> 2) * 128, OA + qrow * 1024 + hq * 128, seq, (char*)F.lds, cv);
    }
    cv.finish();
}
__device__ __forceinline__ void run_attn_mla(Frame& F) {
    const bf16* QM = (const bf16*)(F.ws + WS_QM); const bf16* KM = (const bf16*)(F.ws + WS_KM); const bf16* VM = (const bf16*)(F.ws + WS_VM); bf16* OC = (bf16*)(F.ws + WS_O) + (size_t)2 * MROWS * 1024;
    for (int u = F.bid; u < 512; u += F.G) {
        size_t qrow, krow; int hq, seq;
        if (u < 256) { const int b = u >> 6, qb = u & 7; hq = (u >> 3) & 7; qrow = MCTX + (size_t)b * 2048 + qb * 256; krow = MCTX + (size_t)b * 2560; seq = 2560; }
        else { const int v = u - 256, b = v >> 3; hq = v & 7; qrow = (size_t)b * 256; krow = qrow; seq = 256; }
        NoConv nc; att::attn_body_simple<192, 1536, 1536, 1024, 1024>(QM + qrow * 1536 + hq * 192, KM + krow * 1536 + hq * 192, VM + krow * 1024 + hq * 128, OC + qrow * 1024 + hq * 128, seq, (char*)F.lds, nc);
    }
}
__device__ __forceinline__ void run_ssd(Frame& F, int layer) {
    const bf16* XBC = (const bf16*)(F.ws + WS_XBC); const float* DT = (const float*)(F.ws + WS_DT); bf16* YF = (bf16*)(F.ws + WS_YF); bf16* YB = (bf16*)(F.ws + WS_YB);
    for (int u = F.bid; u < 128; u += F.G) { const int b = u >> 5, h = (u >> 1) & 15, dir = u & 1;
        const float a_h = -expf(F.in[I_ALOG][(layer * 2 + dir) * 16 + h]);
        ssd::ssd_unit(F.lds, XBC, DT, dir ? YB : YF, MCTX + b * 2048, 16, h, dir, a_h, F.in[I_SSSD] + ((((size_t)b * 4 + layer) * 2 + dir) * 16 + h) * 8192, nullptr); }
    const int c0 = F.G > 128 ? F.bid - 128 : F.bid, cs = F.G > 128 ? F.G - 128 : F.G;
    if (c0 >= 0) for (int v = c0; v < 1024; v += cs) { const int b = v >> 5, h = (v >> 1) & 15, dir = v & 1;
        const float a_h = -expf(F.in[I_ALOG][(layer * 2 + dir) * 16 + h]);
        ssd::ssd_unit(F.lds, XBC, DT, dir ? YB : YF, b * 256, 2, h, dir, a_h, nullptr, F.out + O_SSD + ((((size_t)b * 4 + layer) * 2 + dir) * 16 + h) * 8192); }
}
__device__ __forceinline__ void s5_entry_state(Frame& F, const unsigned char* cd, const float* S5E, int b, int seg, int g, int layer, int dir, int lane, float& hr, float& hi) {
    const float* h0 = F.in[I_SS5] + ((((size_t)b * 4 + layer) * 2 + dir) * 2) * 4096 + g * 64; hr = h0[lane]; hi = h0[4096 + lane];
    const float zr = ((const float*)cd)[128 + lane], zi = ((const float*)cd)[192 + lane];
    const int n = dir ? 7 - seg : seg;
    float er[7], ei[7];
#pragma unroll
    for (int q = 0; q < 7; ++q) { const int qq = q < n ? q : 0; const int sp = dir ? 7 - qq : qq; const float* e = S5E + ((((size_t)b * 8 + sp) * 64 + g) * 2 + dir) * 128; er[q] = e[lane]; ei[q] = e[64 + lane]; }
#pragma unroll
    for (int q = 0; q < 7; ++q) { const float nr = zr * hr - zi * hi + er[q], ni = zr * hi + zi * hr + ei[q]; if (q < n) { hr = nr; hi = ni; } }
}
__device__ __forceinline__ void run_s5(Frame& F, int layer) {
    const bf16* PROJ = (const bf16*)(F.ws + WS_PROJ); bf16* S5PRE = (bf16*)(F.ws + WS_S5PRE); const float* S5E = (const float*)(F.ws + WS_S5E);
    LAS unsigned char* wl = F.lds + F.wave * s5::WAVE_LDS;
    for (int u = F.gw; u < 4096; u += F.NGW) {
        int lane_ = F.lane; asm volatile("" : "+v"(lane_)); const int lane = lane_;
        const int s = u >> 6, g = u & 63; const bool lat = s >= 32; const int b = lat ? (s - 32) >> 3 : s, seg = lat ? (s - 32) & 7 : 0;
        const size_t row0 = lat ? MCTX + (size_t)b * 2048 + seg * 256 : (size_t)b * 256;
        const unsigned char* cd0 = F.ws + WS_S5C + (size_t)((layer * 2 + 0) * 64 + g) * s5::CD_BYTES; const unsigned char* cd1 = cd0 + 64 * s5::CD_BYTES; const unsigned char* cg = F.ws + WS_S5G + ((size_t)layer * 64 + g) * s5::CG_BYTES;
        const bf16* U = PROJ + row0 * NIN + C_S5U + g * 16; bf16* outp = S5PRE + row0 * 1024 + g * 16;
        const float dch = F.in[I_S5D][layer * 1024 + g * 16 + (lane & 15)];
        s5::Ctx c;
        float hfr = 0.f, hfi = 0.f, hbr = 0.f, hbi = 0.f;
        if (lat) { s5_entry_state(F, cd0, S5E, b, seg, g, layer, 0, lane, hfr, hfi); s5_entry_state(F, cd1, S5E, b, seg, g, layer, 1, lane, hbr, hbi); }
        { s5::load_ctx(c, cd0, cg, lane, true);
          s5::s5_pass<false>(c, wl, lane, 0, U, NIN, outp, dch, hfr, hfi);
          if (!lat) { float* ho = F.out + O_S5 + ((((size_t)b * 4 + layer) * 2 + 0) * 2) * 4096 + g * 64; ho[lane] = hfr; ho[4096 + lane] = hfi; } }
        { s5::load_ctx(c, cd1, cg, lane, false);
          s5::s5_pass<true>(c, wl, lane, 1, U, NIN, outp, dch, hbr, hbi);
          if (!lat) { float* ho = F.out + O_S5 + ((((size_t)b * 4 + layer) * 2 + 1) * 2) * 4096 + g * 64; ho[lane] = hbr; ho[4096 + lane] = hbi; } }
    }
}
__device__ __forceinline__ bool launder(Frame& F) {
    asm volatile("" : "+v"(F.tid), "+v"(F.lane)); return true; }
__global__ void __launch_bounds__(NTHREADS, 2) skel_fwd(Args args) {
    extern __shared__ __attribute__((aligned(16))) unsigned char lds_raw[];
    Frame F;
    F.lds = (LAS unsigned char*)lds_raw;
    F.tid = threadIdx.x; F.lane = F.tid & 63; F.wave = __builtin_amdgcn_readfirstlane(F.tid >> 6);
    F.G = gridDim.x; F.bid = blockIdx.x; F.gw = F.bid * NWAVES + F.wave; F.NGW = F.G * NWAVES;
    F.in0 = args.in; F.out0 = args.out; F.ws0 = args.ws; F.in = F.in0; F.out = F.out0; F.ws = F.ws0;
    for (int u = F.tid; u < (LDS_BYTES - LDSCTL_OFF) / 4; u += NTHREADS) ((LAS unsigned*)(F.lds + LDSCTL_OFF))[u] = 0u;
    __syncthreads();
    const int lo = args.ph_lo, hi = args.ph_hi;
    unsigned* barw = (unsigned*)(F.ws + WS_CTL) + CW_BAR + args.li * XCD_BAR_WORDS;
    XcdBarrier bar; bar.bar = barw; bar.x = 0; bar.st = nullptr;
    if (hi - lo > 1) bar = xcd_barrier_post(barw, (volatile LAS unsigned*)(F.lds + MISC_OFF) + 8);
#ifndef SUB_MASK
#define SUB_MASK 0xffu
#endif
#define SUBON(b) (((SUB_MASK) >> (b)) & 1u)
#ifndef REP_MASK
#define REP_MASK 0u
#endif
#define REP(b) for (int rep_ = 0; rep_ < 1 + (int)(((REP_MASK) >> (b)) & 1u); ++rep_)
#ifndef PH_MASK
#define PH_MASK 0xffffffffu
#endif
#define IN(k) (lo <= (k) && (k) < hi)
#define INJ(j) ((((PH_MASK) >> (j)) & 1u) && IN(pb + (j)) && launder(F))
#define SEAM(k) do { if (IN(k) && IN((k) + 1)) xcd_barrier(bar); } while (0)
    bf16* WB = (bf16*)(F.ws + WS_W);
    bf16* const Win = (bf16*)((char*)WB + W_IN); bf16* const Wuq = (bf16*)((char*)WB + W_UQ); bf16* const Wukv = (bf16*)((char*)WB + W_UKV); bf16* const Wglu = (bf16*)((char*)WB + W_GLU);
    bf16* const Wbr = (bf16*)((char*)WB + W_BR); bf16* const Wout = (bf16*)((char*)WB + W_OUT); bf16* const Wfi = (bf16*)((char*)WB + W_FI); bf16* const Wfo = (bf16*)((char*)WB + W_FO);
    bf16* const H = (bf16*)(F.ws + WS_H); bf16* const PROJ = (bf16*)(F.ws + WS_PROJ); float* const X = (float*)(F.ws + WS_X);

    if (((PH_MASK >> 11) & 1u) && IN(0)) { phase_prologue(F); conv_run(1, 0, F.gw, F.NGW, F.in, F.ws, F.lane); phase_zero_pad(F); } SEAM(0);
    for (int layer = 0; layer < NLAYER; ++layer) {
        const int pb = 1 + 10 * layer; const float* MODL = (const float*)(F.ws + WS_MOD) + (size_t)layer * 5 * 12288;
        if (INJ(0)) { REP(9) phase_norm(F, layer, 0, layer == 0); } SEAM(pb + 0);
        if (INJ(1)) { pg8::Gemm g{H, Win, MROWS, NIN, 2048}; pg8::StaticOrder S; S.init(MROWS, NIN, F.G, F.bid);
            pg8::EpiInProj E{PROJ, NIN, 32};
            pg8::gemm_phase<pg8::EpiInProj, pg8::StaticOrder, true, true>(F.lds, g, S, E); } SEAM(pb + 1);
        if (INJ(2)) { REP(10) phase_prep(F, layer); } SEAM(pb + 2);
        if (INJ(3)) {
            if (SUBON(0)) { pg8::Gemm g{(bf16*)(F.ws + WS_AQ), Wuq, MROWS, 1536, 512}; pg8::StaticOrder S; S.init(MROWS, 1536, F.G, F.bid); pg8::EpiMlaQ E{(bf16*)(F.ws + WS_QM), (const float2*)(F.ws + WS_TAB) + 64 * 32};
              REP(15) pg8::gemm_phase<pg8::EpiMlaQ, pg8::StaticOrder, true, true>(F.lds, g, S, E); }
            if (SUBON(1)) { pg8::Gemm g{(bf16*)(F.ws + WS_ACKV), Wukv, KROWS, 2048, 256}; pg8::StaticOrder S; S.init(KROWS, 2048, F.G, (F.bid + (F.G >> 2)) % F.G  ); pg8::EpiMlaKV E{(bf16*)(F.ws + WS_KM), (bf16*)(F.ws + WS_VM)};
              REP(15) pg8::gemm_phase<pg8::EpiMlaKV, pg8::StaticOrder, true, true>(F.lds, g, S, E); }
            if (SUBON(2)) run_attn_gqa(F, layer);
            if (SUBON(3)) REP(3) run_ssd(F, layer);
            if (SUBON(4)) REP(4) run_s5(F, layer);
        } SEAM(pb + 3);
        if (INJ(4)) { if (SUBON(5)) REP(5) run_attn_mla(F); if (SUBON(6)) REP(6) phase_ssd_finish(F, layer);
            { pg8::Gemm g{(bf16*)(F.ws + WS_S5PRE), Wglu, MROWS, 2048, 1024}; pg8::StaticOrder S; S.init(MROWS, 2048, F.G, F.bid); pg8::EpiGated<0> E{(bf16*)(F.ws + WS_O) + (size_t)3 * MROWS * 1024, 1024};
              REP(15) pg8::gemm_phase<pg8::EpiGated<0>, pg8::StaticOrder, true, true>(F.lds, g, S, E); } } SEAM(pb + 4);
        if (INJ(5)) { pg8::Gemm g{(bf16*)(F.ws + WS_O), Wbr, 4 * MROWS, 4 * 2048, 1024}; pg8::BranchOrder S; S.so.init(MROWS, 2048, F.G, F.bid); pg8::EpiBranch E{PROJ, NIN, (bf16*)(F.ws + WS_GS)};
            REP(13) pg8::gemm_phase<pg8::EpiBranch, pg8::BranchOrder, true, true>(F.lds, g, S, E); } SEAM(pb + 5);
        if (INJ(6)) { pg8::Gemm g{(bf16*)(F.ws + WS_GS), Wout, MROWS, 2048, 2048}; pg8::StaticOrder S; S.init(MROWS, 2048, F.G, F.bid); pg8::EpiResid E{X, MODL, 4096, 1.0f};
            if ((REP_MASK >> 14) & 1u) { pg8::EpiResid E0{X, MODL, 4096, 0.0f}; pg8::gemm_phase<pg8::EpiResid, pg8::StaticOrder, true, true>(F.lds, g, S, E0); }
            pg8::gemm_phase<pg8::EpiResid, pg8::StaticOrder, true, true>(F.lds, g, S, E); } SEAM(pb + 6);
        if (INJ(7)) { REP(9) phase_norm(F, layer, 1, false); } SEAM(pb + 7);
        if (INJ(8)) { pg8::Gemm g{H, Wfi, MROWS, 11264, 2048}; pg8::StaticOrder S; S.init(MROWS, 11264, F.G, F.bid);
            EpiConv<pg8::EpiGated<1>> E{pg8::EpiGated<1>{PROJ  , FFN}, F.in, F.ws, layer + 1, 1, F.gw, F.NGW, layer + 1 < NLAYER ? CV_B2 : 0, CV_B0, 0};
            pg8::gemm_phase<EpiConv<pg8::EpiGated<1>>, pg8::StaticOrder, true, true>(F.lds, g, S, E);
            if (layer + 1 < NLAYER) conv_run(1, layer + 1, CV_B0 + E.cnt * F.NGW + F.gw, F.NGW, F.in, F.ws, F.lane); } SEAM(pb + 8);
        if (INJ(9)) { pg8::Gemm g{PROJ, Wfo, MROWS, 2048, FFN}; pg8::StaticOrder S; S.init(MROWS, 2048, F.G, F.bid); pg8::EpiResid E{X, MODL, 10240, 1.0f};
            if ((REP_MASK >> 14) & 1u) { pg8::EpiResid E0{X, MODL, 10240, 0.0f}; pg8::gemm_phase<pg8::EpiResid, pg8::StaticOrder, true, true>(F.lds, g, S, E0); }
            pg8::gemm_phase<pg8::EpiResid, pg8::StaticOrder, true, true>(F.lds, g, S, E); } SEAM(pb + 9);
    }
    if (((PH_MASK >> 12) & 1u) && IN(41)) phase_final_norm(F);
#undef IN
#undef INJ
#undef SEAM
}

extern "C" void kernel_launch(void* const* d_in, const int* in_sizes, int n_in, void* d_out, int out_size, void* d_ws, size_t ws_size, hipStream_t stream) {
    static int grid = 0;
    if (grid == 0) {
        if (n_in != 41 || out_size != (int)O_TOTAL || ws_size < WS_END) { fprintf(stderr, "kernel_launch: expected 41 inputs, %zu outputs, >= %zu bytes of workspace; got n_in %d out %d ws %zu\n", (size_t)O_TOTAL, (size_t)WS_END, n_in, out_size, ws_size); grid = -1; return; }
        int dev = 0, cus = 0, per_cu = 0;
        if (hipGetDevice(&dev) != hipSuccess || hipDeviceGetAttribute(&cus, hipDeviceAttributeMultiprocessorCount, dev) != hipSuccess) { grid = -1; return; }
        if (hipFuncSetAttribute((const void*)skel_fwd, hipFuncAttributeMaxDynamicSharedMemorySize, LDS_BYTES) != hipSuccess) { fprintf(stderr, "kernel_launch: hipFuncSetAttribute failed\n"); grid = -1; return; }
        if (hipOccupancyMaxActiveBlocksPerMultiprocessor(&per_cu, (const void*)skel_fwd, NTHREADS, LDS_BYTES) != hipSuccess || per_cu < 1) fprintf(stderr, "kernel_launch: occupancy query reports %d\n", per_cu);
        (void)hipGetLastError();
        grid = cus;
    }
    if (grid < 0) return;
    if (hipMemsetAsync((char*)d_ws + WS_CTL, 0, CTL_ZERO_BYTES, stream) != hipSuccess) return;
    Args a{};
    for (int i = 0; i < 41; ++i) a.in[i] = (const float*)d_in[i];
    a.out = (float*)d_out; a.ws = (unsigned char*)d_ws;
    constexpr int NL = MK_N_LAUNCHES;
    for (int li = 0; li < NL; ++li) {
        a.li = li; a.ph_lo = (int)((long)NPHASE * li / NL); a.ph_hi = (int)((long)NPHASE * (li + 1) / NL);
        hipLaunchKernelGGL(skel_fwd, dim3(grid), dim3(NTHREADS), LDS_BYTES, stream, a);
        const hipError_t le = hipPeekAtLastError();
        if (le != hipSuccess) { fprintf(stderr, "kernel_launch: launch %d failed: %s\n", li, hipGetErrorName(le)); break; }
    }
}
```

```cpp
#include <hip/hip_runtime.h>
#include <cstdio>
#include <cstdint>
#include <cmath>
#define MK_N_LAUNCHES 1
#define REP_MASK 0u
namespace pg8 {
#define PG8_LAS __attribute__((address_space(3)))
typedef unsigned short bf16_t;
typedef short bf16x8 __attribute__((ext_vector_type(8)));
typedef float f32x4 __attribute__((ext_vector_type(4)));
typedef unsigned u32x4 __attribute__((ext_vector_type(4)));
constexpr int BM = 256, BK = 64, HALF = 128, HTB = HALF * BK * 2  , STAGE_BYTES = 8 * HTB, NXCD = 8, WGM = 8;

__host__ __device__ __forceinline__ int lds_byte(int r, int c) { const int st = (r >> 4) * 2 + (c >> 5), rr = r & 15, cc = c & 31, ob = rr * 64 + cc * 2; return st * 1024 + (ob ^ (((ob >> 9) & 1) << 5)); }
__host__ __device__ __forceinline__ void stage_rc(int b, int& R, int& C) { const int st = b / 1024, sb = b % 1024, swz = sb ^ (((sb >> 9) & 1) << 5); R = (st >> 1) * 16 + swz / 64; C = (st & 1) * 32 + (swz % 64) / 2; }
__host__ __device__ __forceinline__ int perm32(int rho) { const int n = rho >> 4, i = rho & 15; return 8 * (i >> 2) + 4 * n + (i & 3); }

struct Unit { int pm, pn; };
struct Gemm { const bf16_t* A; const bf16_t* Bt; int M, N, K; };

struct StaticOrder {
    int nM, nN, nwg, G, c;
    __host__ __device__ void init(int M, int N, int G_, int c_) { nM = M / BM; nN = N / BM; nwg = nM * nN; G = G_; c = c_; }
    __host__ __device__ bool next(int i, Unit& u) const {
        const long L = (long)i * G + c; if (L >= nwg) return false;
        int wgid = (int)L; { const int q = nwg / NXCD, r = nwg % NXCD, xcd = wgid % NXCD, off = wgid / NXCD; wgid = (xcd < r ? xcd * (q + 1) : r * (q + 1) + (xcd - r) * q) + off; }
        const int nig = WGM * nN, gid = wgid / nig, fm = gid * WGM, gsz = (nM - fm) < WGM ? (nM - fm) : WGM;
        u.pm = fm + ((wgid % nig) % gsz); u.pn = (wgid % nig) / gsz; return true;
    }
    __device__ __forceinline__ void a_ready(const Unit&) const {}
    __device__ __forceinline__ void done(const Unit&) const {}
};
__device__ __forceinline__ unsigned cvt_pk_bf16(float lo, float hi) { typedef float f32x2_t_ __attribute__((ext_vector_type(2))); typedef __bf16 bf16x2_t_ __attribute__((ext_vector_type(2))); const f32x2_t_ v_ = {lo, hi}; const bf16x2_t_ b_ = __builtin_convertvector(v_, bf16x2_t_); return __builtin_bit_cast(unsigned, b_); }
__device__ __forceinline__ float bf_lo(unsigned w) { return __uint_as_float(w << 16); }
__device__ __forceinline__ float bf_hi(unsigned w) { return __uint_as_float(w & 0xffff0000u); }
__device__ __forceinline__ float sigmoid_f(float x) { return __builtin_amdgcn_rcpf(1.0f + __expf(-x)); }
__device__ __forceinline__ u32x4 pack8(const f32x4 a, const f32x4 b) { u32x4 w; w.x = cvt_pk_bf16(a[0], a[1]); w.y = cvt_pk_bf16(a[2], a[3]); w.z = cvt_pk_bf16(b[0], b[1]); w.w = cvt_pk_bf16(b[2], b[3]); return w; }

struct EpiInProj {
    static constexpr bool PERM = true, AFTER_DRAIN = false;
    __device__ __forceinline__ bool keep(const Unit&) const { return false; }
    bf16_t* O; int ldc; int nsig;
    __device__ __forceinline__ void operator()(const f32x4 (&acc)[2][2][4][2], const Unit& u, int wr, int wc, int fr, int fq) const {
        const int row0 = u.pm * BM + wr * 64 + fr, col0 = u.pn * BM + wc * 32 + 8 * fq; const bool sg = u.pn < nsig;
#pragma unroll
        for (int ai = 0; ai < 2; ++ai)
#pragma unroll
            for (int m = 0; m < 4; ++m) { bf16_t* rowp = O + (size_t)(row0 + ai * HALF + m * 16) * ldc + col0;
#pragma unroll
                for (int bj = 0; bj < 2; ++bj) { f32x4 v0 = acc[ai][bj][m][0], v1 = acc[ai][bj][m][1];
                    if (sg) {
#pragma unroll
                        for (int j = 0; j < 4; ++j) { v0[j] = sigmoid_f(v0[j]); v1[j] = sigmoid_f(v1[j]); } }
                    *(u32x4*)(rowp + bj * HALF) = pack8(v0, v1); } }
    }
};
struct EpiMlaQ {
    static constexpr bool PERM = false, AFTER_DRAIN = false;
    __device__ __forceinline__ bool keep(const Unit&) const { return false; }
    bf16_t* O; const float2* tab;
    __device__ __forceinline__ void operator()(const f32x4 (&acc)[2][2][4][2], const Unit& u, int wr, int wc, int fr, int fq) const {
        const int row0 = u.pm * BM + wr * 64 + fr; const bool lat = u.pm >= 32;
#pragma unroll
        for (int bj = 0; bj < 2; ++bj) {
            const int cg = u.pn * BM + bj * HALF + wc * 32;
            const int w = cg % 192; const bool rp = lat && (w >= 128); const int axis = (w - 128) >> 5;
#pragma unroll
            for (int ai = 0; ai < 2; ++ai)
#pragma unroll
                for (int m = 0; m < 4; ++m) { const int row = row0 + ai * HALF + m * 16; f32x4 x0 = acc[ai][bj][m][0], x1 = acc[ai][bj][m][1];
                    if (rp) { const int t = (row - 8192) & 2047; const int pos = axis ? (t & 63) : (t >> 6); const float2* tp = tab + pos * 16 + 4 * fq;
#pragma unroll
                        for (int j = 0; j < 4; ++j) { const float2 cs = tp[j]; const float a = x0[j], b = x1[j]; x0[j] = a * cs.x - b * cs.y; x1[j] = a * cs.y + b * cs.x; } }
                    bf16_t* p = O + (size_t)row * 1536 + cg + 4 * fq;
                    uint2 w0; w0.x = cvt_pk_bf16(x0[0], x0[1]); w0.y = cvt_pk_bf16(x0[2], x0[3]); uint2 w1; w1.x = cvt_pk_bf16(x1[0], x1[1]); w1.y = cvt_pk_bf16(x1[2], x1[3]);
                    *(uint2*)p = w0; *(uint2*)(p + 16) = w1; } }
    }
};
struct EpiMlaKV {
    static constexpr bool PERM = true, AFTER_DRAIN = false;
    __device__ __forceinline__ bool keep(const Unit&) const { return false; }
    bf16_t* Km; bf16_t* Vm;
    __device__ __forceinline__ void operator()(const f32x4 (&acc)[2][2][4][2], const Unit& u, int wr, int wc, int fr, int fq) const {
        const int row0 = u.pm * BM + wr * 64 + fr, c0 = wc * 32 + 8 * fq;
#pragma unroll
        for (int ai = 0; ai < 2; ++ai)
#pragma unroll
            for (int m = 0; m < 4; ++m) { const size_t row = (size_t)(row0 + ai * HALF + m * 16);
                *(u32x4*)(Km + row * 1536 + u.pn * 192 + c0) = pack8(acc[ai][0][m][0], acc[ai][0][m][1]);
                *(u32x4*)(Vm + row * 1024 + u.pn * 128 + c0) = pack8(acc[ai][1][m][0], acc[ai][1][m][1]); }
    }
};
template <int MODE> struct EpiGated {
    static constexpr bool PERM = true, AFTER_DRAIN = false;
    __device__ __forceinline__ bool keep(const Unit&) const { return false; }
    bf16_t* O; int ldc;
    __device__ __forceinline__ void operator()(const f32x4 (&acc)[2][2][4][2], const Unit& u, int wr, int wc, int fr, int fq) const {
        const int row0 = u.pm * BM + wr * 64 + fr, col0 = u.pn * HALF + wc * 32 + 8 * fq;
#pragma unroll
        for (int ai = 0; ai < 2; ++ai)
#pragma unroll
            for (int m = 0; m < 4; ++m) { f32x4 o[2];
#pragma unroll
                for (int n = 0; n < 2; ++n)
#pragma unroll
                    for (int j = 0; j < 4; ++j) { const float a = acc[ai][0][m][n][j], b = acc[ai][1][m][n][j]; o[n][j] = MODE == 0 ? a * sigmoid_f(b) : a * sigmoid_f(a) * b; }
                *(u32x4*)(O + (size_t)(row0 + ai * HALF + m * 16) * ldc + col0) = pack8(o[0], o[1]); }
    }
};
struct EpiBranch {
    static constexpr bool PERM = true, AFTER_DRAIN = false;
    const bf16_t* G; int ldg; bf16_t* GS;
    __device__ __forceinline__ bool keep(const Unit& u) const { return (u.pm >> 6) < 3; }
    __device__ __forceinline__ void operator()(f32x4 (&acc)[2][2][4][2], const Unit& u, int wr, int wc, int fr, int fq) const {
        const int br = u.pm >> 6, pm = u.pm & 63, pn = u.pn & 7;
        const int row0 = pm * BM + wr * 64 + fr, col0 = pn * BM + wc * 32 + 8 * fq;
#pragma unroll
        for (int ai = 0; ai < 2; ++ai) {
            u32x4 gc[4][2], gn[4][2];
#pragma unroll
            for (int m = 0; m < 4; ++m)
#pragma unroll
                for (int bj = 0; bj < 2; ++bj) { const bf16_t* gp = G + (size_t)(row0 + ai * HALF + m * 16) * ldg + br * 2048 + col0 + bj * HALF; gc[m][bj] = *(const u32x4*)gp; if (br < 3) gn[m][bj] = *(const u32x4*)(gp + 2048); }
#pragma unroll
            for (int m = 0; m < 4; ++m)
#pragma unroll
                for (int bj = 0; bj < 2; ++bj) { float c[8], n[8]; const u32x4 a = gc[m][bj];
                    c[0] = bf_lo(a.x); c[1] = bf_hi(a.x); c[2] = bf_lo(a.y); c[3] = bf_hi(a.y); c[4] = bf_lo(a.z); c[5] = bf_hi(a.z); c[6] = bf_lo(a.w); c[7] = bf_hi(a.w);
                    if (br < 3) { const u32x4 b = gn[m][bj]; n[0] = bf_lo(b.x); n[1] = bf_hi(b.x); n[2] = bf_lo(b.y); n[3] = bf_hi(b.y); n[4] = bf_lo(b.z); n[5] = bf_hi(b.z); n[6] = bf_lo(b.w); n[7] = bf_hi(b.w); }
#pragma unroll
                    for (int j = 0; j < 8; ++j) { float f = fmaxf(c[j], 1e-6f); if (br < 3) f *= __builtin_amdgcn_rcpf(fmaxf(n[j], 1e-6f)); acc[ai][bj][m][j >> 2][j & 3] *= f; }
                    if (br == 3) *(u32x4*)(GS + (size_t)(row0 + ai * HALF + m * 16) * 2048 + col0 + bj * HALF) = pack8(acc[ai][bj][m][0], acc[ai][bj][m][1]); }
        }
    }
};
struct EpiResid {
    static constexpr bool PERM = false, AFTER_DRAIN = false;
    __device__ __forceinline__ bool keep(const Unit&) const { return false; }
    float* X; const float* mod; int goff; float scale;
    __device__ __forceinline__ void operator()(const f32x4 (&acc)[2][2][4][2], const Unit& u, int wr, int wc, int fr, int fq) const {
        const int row0 = u.pm * BM + wr * 64 + fr, col0 = u.pn * BM + wc * 32 + 4 * fq;
        const int mrow = u.pm < 32 ? 0 : 1 + ((u.pm - 32) >> 3); const float* gp = mod + mrow * 12288 + goff + col0;
        f32x4 gv[2][2];
#pragma unroll
        for (int bj = 0; bj < 2; ++bj)
#pragma unroll
            for (int n = 0; n < 2; ++n) gv[bj][n] = *(const f32x4*)(gp + bj * HALF + n * 16) * scale;
#pragma unroll
        for (int ai = 0; ai < 2; ++ai) { f32x4 xv[4][2][2];
#pragma unroll
            for (int m = 0; m < 4; ++m)
#pragma unroll
                for (int bj = 0; bj < 2; ++bj)
#pragma unroll
                    for (int n = 0; n < 2; ++n) xv[m][bj][n] = *(const f32x4*)(X + (size_t)(row0 + ai * HALF + m * 16) * 2048 + col0 + bj * HALF + n * 16);
#pragma unroll
            for (int m = 0; m < 4; ++m)
#pragma unroll
                for (int bj = 0; bj < 2; ++bj)
#pragma unroll
                    for (int n = 0; n < 2; ++n) *(f32x4*)(X + (size_t)(row0 + ai * HALF + m * 16) * 2048 + col0 + bj * HALF + n * 16) = xv[m][bj][n] + gv[bj][n] * acc[ai][bj][m][n];
            asm volatile("" ::: "memory"); }
    }
};
struct BranchOrder {
    StaticOrder so;
    __device__ bool next(int i, Unit& u) const { Unit t; if (!so.next(i >> 2, t)) return false; const int br = i & 3; u.pm = br * 64 + t.pm; u.pn = br * 8 + t.pn; return true; }
    __device__ __forceinline__ void a_ready(const Unit&) const {}
    __device__ __forceinline__ void done(const Unit&) const {}
};
template <class Epi, class Sched, bool ALIGN_EPI = false, bool SP2 = false>
__device__ __forceinline__ void gemm_phase(PG8_LAS unsigned char* lds, const Gemm g, const Sched& S, const Epi& E) {
    int tid_ = threadIdx.x; asm volatile("" : "+v"(tid_));
    const int tid = tid_, wid = __builtin_amdgcn_readfirstlane(tid >> 6), lane = tid & 63, wr = wid >> 2, wc = wid & 3, fr = lane & 15, fq = lane >> 4;
    const int K = g.K, nt = K / BK;
    unsigned voffA[2], voffB[2];
#pragma unroll
    for (int i = 0; i < 2; ++i) { int R, C; stage_rc(tid * 16 + i * 8192, R, C); const int Rb = Epi::PERM ? ((R & ~31) + perm32(R & 31)) : R;
        voffA[i] = (unsigned)(R * K + C) * 2u; voffB[i] = (unsigned)(Rb * K + C) * 2u; }
    const size_t kstep = (size_t)(BK * 2);
    const size_t hstep = (size_t)HALF * K * 2;
    const size_t tstep = 2 * hstep;
    const unsigned ldsw = (unsigned)wid * 1024u;
    const int aoff = lds_byte(wr * 64 + fr, fq * 8), boff = lds_byte(wc * 32 + fr, fq * 8);
#define PG8_SA(b, h) (((b) * 2 + (h)) * HTB)
#define PG8_SB(b, h) ((4 + (b) * 2 + (h)) * HTB)
#define PG8_STAGE(bufoff, gbase, voff) do { _Pragma("unroll") for (int _i = 0; _i < 2; ++_i) \
        __builtin_amdgcn_global_load_lds((const unsigned*)((const char*)(gbase) + (voff)[_i]), (PG8_LAS unsigned*)(lds + (bufoff) + ldsw + _i * 8192), 16, 0, 0); } while (0)
#define PG8_LDA(dst, b, h) do { _Pragma("unroll") for (int m = 0; m < 4; ++m) _Pragma("unroll") for (int k = 0; k < 2; ++k) dst[m][k] = *(const PG8_LAS bf16x8*)(lds + PG8_SA(b, h) + aoff + m * 2048 + k * 1024); } while (0)
#define PG8_LDB(dst, b, h) do { _Pragma("unroll") for (int n = 0; n < 2; ++n) _Pragma("unroll") for (int k = 0; k < 2; ++k) dst[n][k] = *(const PG8_LAS bf16x8*)(lds + PG8_SB(b, h) + boff + n * 2048 + k * 1024); } while (0)
#define PG8_MMA(ai, bj, At, Bt) do { __builtin_amdgcn_s_setprio(1); _Pragma("unroll") for (int m = 0; m < 4; ++m) _Pragma("unroll") for (int n = 0; n < 2; ++n) _Pragma("unroll") for (int k = 0; k < 2; ++k) \
        acc[ai][bj][m][n] = __builtin_amdgcn_mfma_f32_16x16x32_bf16(Bt[n][k], At[m][k], acc[ai][bj][m][n], 0, 0, 0); __builtin_amdgcn_s_setprio(0); } while (0)
#define PG8_WAIT_V(n) asm volatile("s_waitcnt vmcnt(" #n ")" ::: "memory")
#define PG8_WAIT_L(n) asm volatile("s_waitcnt lgkmcnt(" #n ")" ::: "memory")
#define PG8_BAR __builtin_amdgcn_s_barrier()
#define PG8_SCHED __builtin_amdgcn_sched_barrier(0)
    Unit cur, nxt; int ui = 0;
    if (!S.next(0, cur)) return;
    f32x4 acc[2][2][4][2];
#pragma unroll
    for (int a = 0; a < 2; ++a)
#pragma unroll
        for (int b = 0; b < 2; ++b)
#pragma unroll
            for (int m = 0; m < 4; ++m)
#pragma unroll
                for (int n = 0; n < 2; ++n) acc[a][b][m][n] = (f32x4){0.f, 0.f, 0.f, 0.f};
    bf16x8 At[4][2], B0[2][2], B1[2][2];
    const char* cA = (const char*)g.A + (size_t)cur.pm * tstep; const char* cB = (const char*)g.Bt + (size_t)cur.pn * tstep;
    S.a_ready(cur);
    if constexpr (SP2) {
        PG8_STAGE(PG8_SB(0, 0), cB, voffB); PG8_STAGE(PG8_SB(0, 1), cB + hstep, voffB); PG8_STAGE(PG8_SA(0, 0), cA, voffA); PG8_STAGE(PG8_SA(0, 1), cA + hstep, voffA);
        if (wr == 1) PG8_BAR;
        PG8_WAIT_V(2); PG8_BAR;
        PG8_STAGE(PG8_SB(1, 0), cB + kstep, voffB); PG8_STAGE(PG8_SA(1, 0), cA + kstep, voffA); PG8_STAGE(PG8_SB(1, 1), cB + hstep + kstep, voffB);
        PG8_WAIT_V(6); PG8_BAR;
    } else {
        PG8_STAGE(PG8_SB(0, 0), cB, voffB); PG8_STAGE(PG8_SA(0, 0), cA, voffA); PG8_STAGE(PG8_SB(0, 1), cB + hstep, voffB); PG8_STAGE(PG8_SA(0, 1), cA + hstep, voffA);
        if (wr == 1) PG8_BAR;
        PG8_WAIT_V(4); PG8_BAR;
        PG8_STAGE(PG8_SB(1, 0), cB + kstep, voffB); PG8_STAGE(PG8_SA(1, 0), cA + kstep, voffA); PG8_STAGE(PG8_SB(1, 1), cB + hstep + kstep, voffB);
        PG8_WAIT_V(6); PG8_BAR;
    }
    for (;;) {
        const bool has_next = S.next(ui + 1, nxt);
        const char* nA = has_next ? (const char*)g.A + (size_t)nxt.pm * tstep : cA; const char* nB = has_next ? (const char*)g.Bt + (size_t)nxt.pn * tstep : cB;
#pragma clang loop unroll(disable)
        for (int t = 0; t < nt; t += 2) {
            const bool last = (t == nt - 2);
            const char* a1 = cA + (size_t)(t + 1) * kstep;
            const char* a2 = last ? nA : cA + (size_t)(t + 2) * kstep; const char* b2 = last ? nB : cB + (size_t)(t + 2) * kstep;
            const char* a3 = a2 + kstep; const char* b3 = b2 + kstep;
            if (last && has_next) S.a_ready(nxt);
            if constexpr (SP2) {
            PG8_LDB(B0, 0, 0); PG8_LDB(B1, 0, 1); PG8_SCHED; PG8_LDA(At, 0, 0); PG8_STAGE(PG8_SA(1, 1), a1 + hstep, voffA);
            PG8_WAIT_V(8); PG8_WAIT_L(0); PG8_BAR; PG8_MMA(0, 0, At, B0); PG8_MMA(0, 1, At, B1); PG8_BAR; PG8_SCHED;
            PG8_LDA(At, 0, 1); PG8_STAGE(PG8_SB(0, 0), b2, voffB); PG8_STAGE(PG8_SB(0, 1), b2 + hstep, voffB); PG8_STAGE(PG8_SA(0, 0), a2, voffA);
            PG8_WAIT_V(8); PG8_WAIT_L(0); PG8_BAR; PG8_MMA(1, 0, At, B0); PG8_MMA(1, 1, At, B1); PG8_BAR; PG8_SCHED;
            PG8_LDB(B0, 1, 0); PG8_LDB(B1, 1, 1); PG8_SCHED; PG8_LDA(At, 1, 0); PG8_STAGE(PG8_SA(0, 1), a2 + hstep, voffA);
            PG8_WAIT_V(8); PG8_WAIT_L(0); PG8_BAR; PG8_MMA(0, 0, At, B0); PG8_MMA(0, 1, At, B1); PG8_BAR; PG8_SCHED;
            PG8_LDA(At, 1, 1); PG8_STAGE(PG8_SB(1, 0), b3, voffB); PG8_STAGE(PG8_SB(1, 1), b3 + hstep, voffB); PG8_STAGE(PG8_SA(1, 0), a3, voffA);
            PG8_WAIT_V(8); PG8_WAIT_L(0); PG8_BAR; PG8_MMA(1, 0, At, B0); PG8_MMA(1, 1, At, B1); PG8_BAR; PG8_SCHED;
            } else {
            PG8_LDB(B0, 0, 0); PG8_SCHED; PG8_LDA(At, 0, 0); PG8_STAGE(PG8_SA(1, 1), a1 + hstep, voffA);
            PG8_WAIT_L(8); PG8_BAR; PG8_WAIT_L(0); PG8_MMA(0, 0, At, B0); PG8_BAR; PG8_SCHED;
            PG8_LDB(B1, 0, 1); PG8_STAGE(PG8_SB(0, 0), b2, voffB);
            PG8_BAR; PG8_WAIT_L(0); PG8_MMA(0, 1, At, B1); PG8_BAR;
            PG8_LDA(At, 0, 1); PG8_STAGE(PG8_SA(0, 0), a2, voffA);
            PG8_BAR; PG8_WAIT_L(0); PG8_MMA(1, 0, At, B0); PG8_BAR; PG8_SCHED;
            PG8_STAGE(PG8_SB(0, 1), b2 + hstep, voffB);
            PG8_WAIT_V(6); PG8_BAR; PG8_MMA(1, 1, At, B1); PG8_BAR;
            PG8_LDB(B0, 1, 0); PG8_SCHED; PG8_LDA(At, 1, 0); PG8_STAGE(PG8_SA(0, 1), a2 + hstep, voffA);
            PG8_WAIT_L(8); PG8_BAR; PG8_WAIT_L(0); PG8_MMA(0, 0, At, B0); PG8_BAR; PG8_SCHED;
            PG8_LDB(B1, 1, 1); PG8_STAGE(PG8_SB(1, 0), b3, voffB);
            PG8_BAR; PG8_WAIT_L(0); PG8_MMA(0, 1, At, B1); PG8_BAR;
            PG8_LDA(At, 1, 1); PG8_STAGE(PG8_SA(1, 0), a3, voffA);
            PG8_BAR; PG8_WAIT_L(0); PG8_MMA(1, 0, At, B0); PG8_BAR; PG8_SCHED;
            PG8_STAGE(PG8_SB(1, 1), b3 + hstep, voffB);
            PG8_WAIT_V(6); PG8_BAR; PG8_MMA(1, 1, At, B1); PG8_BAR;
            }
        }
        if constexpr (ALIGN_EPI) { if (wr == 0) PG8_BAR; }
        if constexpr (!Epi::AFTER_DRAIN) { E(acc, cur, wr, wc, fr, fq); S.done(cur); }
        if (!has_next) break;
        if (!E.keep(cur)) {
#pragma unroll
        for (int a = 0; a < 2; ++a)
#pragma unroll
            for (int b = 0; b < 2; ++b)
#pragma unroll
                for (int m = 0; m < 4; ++m)
#pragma unroll
                    for (int n = 0; n < 2; ++n) acc[a][b][m][n] = (f32x4){0.f, 0.f, 0.f, 0.f};
        }
        cur = nxt; cA = nA; cB = nB; ++ui;
        if constexpr (ALIGN_EPI) { if (wr == 1) PG8_BAR; }
    }
    PG8_WAIT_V(0);
    if constexpr (!ALIGN_EPI) { if (wr == 0) PG8_BAR; }
    PG8_BAR;
    if constexpr (Epi::AFTER_DRAIN) { E.fused(acc, cur, wr, wc, fr, fq, lds, wid, lane); S.done(cur); }
#undef PG8_SA
#undef PG8_SB
#undef PG8_STAGE
#undef PG8_LDA
#undef PG8_LDB
#undef PG8_MMA
#undef PG8_WAIT_V
#undef PG8_WAIT_L
#undef PG8_BAR
#undef PG8_SCHED
}
}
namespace att {
using bf16x8 = __attribute__((ext_vector_type(8))) short;
using s16x4  = __attribute__((ext_vector_type(4))) short;
using f32x16 = __attribute__((ext_vector_type(16))) float;
using u32x4  = __attribute__((ext_vector_type(4))) unsigned;
constexpr int NW = 8, QBLK = 32, KVBLK = 64, DV = 128;
constexpr float THR = 8.f;
#ifndef QKT_GRP
#define QKT_GRP 4
#endif
#define ATT_SBAR() __builtin_amdgcn_sched_barrier(0)
template <int DK> struct Cfg {
  static constexpr float SCALE = DK == 128 ? 0.088388347648318440f : 0.072168783648703220f;
  static constexpr int KROW = DK * 2;
  static constexpr int SHM_V = KVBLK * DV * 2, SHM_K = KVBLK * DK * 2;
  static constexpr int SHM = 2 * SHM_V + 2 * SHM_K + NW * 64 * 4;
  static constexpr int NKC = DK / 64;
};
__device__ __forceinline__ int crow(int r, int hi) { return (r & 3) + 8 * (r >> 2) + 4 * hi; }
__device__ __forceinline__ unsigned cvtpk(float lo, float hi) { typedef float f32x2_t_ __attribute__((ext_vector_type(2))); typedef __bf16 bf16x2_t_ __attribute__((ext_vector_type(2))); const f32x2_t_ v_ = {lo, hi}; const bf16x2_t_ b_ = __builtin_convertvector(v_, bf16x2_t_); return __builtin_bit_cast(unsigned, b_); }
template <int DK> __device__ __forceinline__ int kswz(int row, int colB) { return row * (DK * 2) + (colB ^ ((row & 7) << 4)); }

template <int DK> __device__ __forceinline__ void partialSM(f32x16& p0, f32x16& p1, float& m_reg, float& mn, float& alpha) {
  constexpr float SCALE = Cfg<DK>::SCALE; constexpr float C = SCALE * 1.4426950408889634f;
  float pmax = p0[0]; for (int r = 1; r < 16; ++r) pmax = fmaxf(pmax, p0[r]); for (int r = 0; r < 16; ++r) pmax = fmaxf(pmax, p1[r]);
  { auto rr = __builtin_amdgcn_permlane32_swap(__float_as_uint(pmax), __float_as_uint(pmax), false, false);
    pmax = fmaxf(__uint_as_float(rr[0]), __uint_as_float(rr[1])); }
  if (__builtin_expect(__all(pmax - m_reg <= THR / SCALE), 1)) { mn = m_reg; alpha = 1.f; }
  else { mn = fmaxf(m_reg, pmax); alpha = __builtin_amdgcn_exp2f((m_reg - mn) * C); m_reg = mn; }
  float mnC = -mn * C;
  for (int r = 0; r < 16; ++r) p0[r] = fmaf(p0[r], C, mnC); for (int r = 0; r < 16; ++r) p1[r] = fmaf(p1[r], C, mnC);
  for (int r = 0; r < 16; ++r) p0[r] = __builtin_amdgcn_exp2f(p0[r]);
}
__device__ __forceinline__ void finishSM(f32x16& p0, f32x16& p1, float alpha, float& l_reg, bf16x8& pa0, bf16x8& pa1, bf16x8& pa2, bf16x8& pa3) {
  for (int r = 0; r < 16; ++r) p1[r] = __builtin_amdgcn_exp2f(p1[r]);
  float ps = 0; for (int r = 0; r < 16; ++r) ps += p0[r]; for (int r = 0; r < 16; ++r) ps += p1[r];
  { auto rr = __builtin_amdgcn_permlane32_swap(__float_as_uint(ps), __float_as_uint(ps), false, false);
    ps = __uint_as_float(rr[0]) + __uint_as_float(rr[1]); }
  l_reg = l_reg * alpha + ps;
#define ATT_PK4(P, BASE, OUT) do { unsigned a0 = cvtpk(P[BASE + 0], P[BASE + 1]), a1 = cvtpk(P[BASE + 2], P[BASE + 3]);   \
    unsigned b0 = cvtpk(P[BASE + 4], P[BASE + 5]), b1 = cvtpk(P[BASE + 6], P[BASE + 7]);                              \
    auto r0 = __builtin_amdgcn_permlane32_swap(a0, b0, false, false); auto r1 = __builtin_amdgcn_permlane32_swap(a1, b1, false, false); \
    u32x4 w = {r0[0], r1[0], r0[1], r1[1]}; OUT = *reinterpret_cast<bf16x8*>(&w); } while (0)
  ATT_PK4(p0, 0, pa0); ATT_PK4(p0, 8, pa1); ATT_PK4(p1, 0, pa2); ATT_PK4(p1, 8, pa3);
#undef ATT_PK4
}
template <int DK> __device__ __forceinline__ void qkt(f32x16& p0, f32x16& p1, const char* Ks, const bf16x8* qr, int r32, int hi) {
  p0 = f32x16{}; p1 = f32x16{};
#pragma unroll
  for (int d0 = 0; d0 < DK / 16; ++d0) { int cb = (d0 * 16 + hi * 8) * 2;
    bf16x8 b0 = *reinterpret_cast<const bf16x8*>(Ks + kswz<DK>(r32, cb));
    bf16x8 b1 = *reinterpret_cast<const bf16x8*>(Ks + kswz<DK>(32 + r32, cb));
    const bf16x8 q = qr[d0];
    p0 = __builtin_amdgcn_mfma_f32_32x32x16_bf16(b0, q, p0, 0, 0, 0);
    p1 = __builtin_amdgcn_mfma_f32_32x32x16_bf16(b1, q, p1, 0, 0, 0);
  }
}
template <int DK, class HOOK> __device__ __forceinline__ void qkt_hook(f32x16& p0, f32x16& p1, const char* Ks, const bf16x8* qr, int r32, int hi, HOOK&& hook) {
  p0 = f32x16{}; p1 = f32x16{};
#pragma unroll
  for (int d0 = 0; d0 < DK / 16; ++d0) { int cb = (d0 * 16 + hi * 8) * 2;
    bf16x8 b0 = *reinterpret_cast<const bf16x8*>(Ks + kswz<DK>(r32, cb));
    bf16x8 b1 = *reinterpret_cast<const bf16x8*>(Ks + kswz<DK>(32 + r32, cb));
    const bf16x8 q = qr[d0];
    p0 = __builtin_amdgcn_mfma_f32_32x32x16_bf16(b0, q, p0, 0, 0, 0);
    p1 = __builtin_amdgcn_mfma_f32_32x32x16_bf16(b1, q, p1, 0, 0, 0);
    __builtin_amdgcn_sched_barrier(0); hook(d0); __builtin_amdgcn_sched_barrier(0);
  }
}
__device__ __forceinline__ int v_st(int k, int c) { const int kk = (k & ~0xC) | ((k & 4) << 1) | ((k & 8) >> 1); return ((kk >> 3) * 4 + (c >> 5)) * 512 + ((kk & 7) * 32 + (c & 31)) * 2; }
__device__ __forceinline__ int v_rd_base(int lane) { return ((lane & 3) << 3) | (((lane >> 2) & 3) << 6) | (((lane >> 4) & 1) << 5) | (((lane >> 5) & 1) << 8); }
constexpr int v_rd_off(int d0, int ks, int half) { return d0 * 512 + ks * 4096 + half * 2048; }
template <int OFF> __device__ __forceinline__ s16x4 tr_read(int vb) {
  s16x4 r; asm volatile("ds_read_b64_tr_b16 %0, %1 offset:%2" : "=&v"(r) : "v"(vb), "i"(OFF) : "memory"); return r;
}
template <int D0> __device__ __forceinline__ void pv_one(f32x16& od, int vb, bf16x8 pa0, bf16x8 pa1, bf16x8 pa2, bf16x8 pa3) {
  const s16x4 l0 = tr_read<v_rd_off(D0, 0, 0)>(vb), h0 = tr_read<v_rd_off(D0, 0, 1)>(vb), l1 = tr_read<v_rd_off(D0, 1, 0)>(vb), h1 = tr_read<v_rd_off(D0, 1, 1)>(vb);
  const s16x4 l2 = tr_read<v_rd_off(D0, 2, 0)>(vb), h2 = tr_read<v_rd_off(D0, 2, 1)>(vb), l3 = tr_read<v_rd_off(D0, 3, 0)>(vb), h3 = tr_read<v_rd_off(D0, 3, 1)>(vb);
  asm volatile("s_waitcnt lgkmcnt(0)" ::: "memory"); ATT_SBAR();
#define ATT_PK(L, H) (bf16x8){L[0], L[1], L[2], L[3], H[0], H[1], H[2], H[3]}
  od = __builtin_amdgcn_mfma_f32_32x32x16_bf16(pa0, ATT_PK(l0, h0), od, 0, 0, 0);
  od = __builtin_amdgcn_mfma_f32_32x32x16_bf16(pa1, ATT_PK(l1, h1), od, 0, 0, 0);
  od = __builtin_amdgcn_mfma_f32_32x32x16_bf16(pa2, ATT_PK(l2, h2), od, 0, 0, 0);
  od = __builtin_amdgcn_mfma_f32_32x32x16_bf16(pa3, ATT_PK(l3, h3), od, 0, 0, 0);
#undef ATT_PK
}
__device__ __forceinline__ void pv_d0(f32x16* o, int vb, bf16x8 pa0, bf16x8 pa1, bf16x8 pa2, bf16x8 pa3) {
  pv_one<0>(o[0], vb, pa0, pa1, pa2, pa3); pv_one<1>(o[1], vb, pa0, pa1, pa2, pa3); pv_one<2>(o[2], vb, pa0, pa1, pa2, pa3); pv_one<3>(o[3], vb, pa0, pa1, pa2, pa3);
}
template <int DK, int SDEPTH, int ldq, int ldk, int ldv, int ldo>
__device__ __forceinline__ void attn_body(const unsigned short* __restrict__ Qb, const unsigned short* __restrict__ Kh, const unsigned short* __restrict__ Vh,
                                          unsigned short* __restrict__ Ob, int seq, char* lds) {
  using C_ = Cfg<DK>; constexpr int SHM_V = C_::SHM_V, SHM_K = C_::SHM_K, NKC = C_::NKC, CPR = DK / 8;
  int tid_ = threadIdx.x; asm volatile("" : "+v"(tid_));
  const int tid = tid_, wid = tid >> 6, lane = tid & 63, r32 = lane & 31, hi = lane >> 5;
  char* V_lds = lds; char* K_lds = lds + 2 * SHM_V;
  float* ws = (float*)(lds + 2 * SHM_V + 2 * SHM_K) + wid * 64; float* li_l = ws; float* al_l = ws + 32;
  float m_reg = -1e30f, l_reg = 0; f32x16 o[4] = {}; bf16x8 qr[DK / 16];
  const unsigned short* Qw = Qb + (long)(wid * QBLK + r32) * ldq + hi * 8;
#pragma unroll
  for (int d0 = 0; d0 < DK / 16; ++d0) qr[d0] = *reinterpret_cast<const bf16x8*>(Qw + d0 * 16);
  const int sr = tid >> 4, sc = (tid & 15) * 8, vst0 = v_st(sr, sc), vst1 = v_st(32 + sr, sc);
  unsigned kgo[NKC], klo[NKC];
#pragma unroll
  for (int i = 0; i < NKC; ++i) { const int c = tid + 512 * i, kr_ = c / CPR, kc_ = (c % CPR) * 8; kgo[i] = (unsigned)(kr_ * ldk + kc_) * 2u; klo[i] = (unsigned)kswz<DK>(kr_, kc_ * 2); }
  const unsigned vgo0 = (unsigned)(sr * ldv + sc) * 2u, vgo1 = (unsigned)((32 + sr) * ldv + sc) * 2u;
  const int vb0 = (int)(uintptr_t)V_lds + v_rd_base(lane);
  struct { bf16x8 vs0, vs1; bf16x8 ks[NKC]; } sr_[SDEPTH];
#define ATT_SLOAD(i, k0) do { const char* _vt = (const char*)Vh + (size_t)(k0) * (ldv * 2); const char* _kt = (const char*)Kh + (size_t)(k0) * (ldk * 2); \
    sr_[i].vs0 = *reinterpret_cast<const bf16x8*>(_vt + vgo0); sr_[i].vs1 = *reinterpret_cast<const bf16x8*>(_vt + vgo1); \
    _Pragma("unroll") for (int _c = 0; _c < NKC; ++_c) sr_[i].ks[_c] = *reinterpret_cast<const bf16x8*>(_kt + kgo[_c]); } while (0)
#define ATT_SWRITE(b, i) do { *(bf16x8*)(V_lds + (b) * SHM_V + vst0) = sr_[i].vs0; *(bf16x8*)(V_lds + (b) * SHM_V + vst1) = sr_[i].vs1; \
    _Pragma("unroll") for (int _c = 0; _c < NKC; ++_c) *(bf16x8*)(K_lds + (b) * SHM_K + klo[_c]) = sr_[i].ks[_c]; } while (0)
#define ATT_SWAIT() do { if constexpr (SDEPTH == 2) asm volatile("s_waitcnt vmcnt(%0)" :: "n"(2 + NKC) : "memory"); else asm volatile("s_waitcnt vmcnt(0)" ::: "memory"); } while (0)
#define ATT_RESC(a) do { if (__any((a) < 1.f)) { if (hi == 0) al_l[r32] = (a); asm volatile("s_waitcnt lgkmcnt(0)" ::: "memory"); \
    for (int d = 0; d < 4; ++d) for (int r = 0; r < 16; ++r) o[d][r] *= al_l[crow(r, hi)]; } } while (0)
  f32x16 pA0, pA1, pB0, pB1; float mnA, mnB, alA, alB; bf16x8 pa0, pa1, pa2, pa3; const int NT = seq / KVBLK;
  constexpr int SE = 0, SO = SDEPTH - 1;
  ATT_SLOAD(SE, 0); asm volatile("s_waitcnt vmcnt(0)" ::: "memory"); ATT_SWRITE(0, SE); __syncthreads();
  qkt<DK>(pA0, pA1, K_lds, qr, r32, hi); partialSM<DK>(pA0, pA1, m_reg, mnA, alA);
  ATT_SLOAD(SO, KVBLK); if constexpr (SDEPTH == 2) { if (2 < NT) ATT_SLOAD(SE, 2 * KVBLK); }
  ATT_SWAIT(); ATT_SWRITE(1, SO); __syncthreads();
  for (int j = 1; j + 1 < NT; j += 2) {
    ATT_SBAR(); qkt<DK>(pB0, pB1, K_lds + SHM_K, qr, r32, hi);
    finishSM(pA0, pA1, alA, l_reg, pa0, pa1, pa2, pa3); ATT_SBAR();
    ATT_SLOAD(SO, (j + SDEPTH) * KVBLK); ATT_SBAR();
    pv_d0(o, vb0, pa0, pa1, pa2, pa3); partialSM<DK>(pB0, pB1, m_reg, mnB, alB);
    __syncthreads(); ATT_SWAIT(); ATT_SWRITE(0, SE);
    ATT_RESC(alB); __syncthreads();
    ATT_SBAR(); qkt<DK>(pA0, pA1, K_lds, qr, r32, hi);
    finishSM(pB0, pB1, alB, l_reg, pa0, pa1, pa2, pa3); ATT_SBAR();
    if (SDEPTH == 1 || j + 3 < NT) ATT_SLOAD(SE, (j + 1 + SDEPTH) * KVBLK); ATT_SBAR();
    pv_d0(o, vb0 + SHM_V, pa0, pa1, pa2, pa3); partialSM<DK>(pA0, pA1, m_reg, mnA, alA);
    __syncthreads(); if (SDEPTH == 1 || j + 3 < NT) ATT_SWAIT(); else asm volatile("s_waitcnt vmcnt(0)" ::: "memory"); ATT_SWRITE(1, SO);
    ATT_RESC(alA); __syncthreads();
  }
  ATT_SBAR(); qkt<DK>(pB0, pB1, K_lds + SHM_K, qr, r32, hi);
  finishSM(pA0, pA1, alA, l_reg, pa0, pa1, pa2, pa3); ATT_SBAR();
  pv_d0(o, vb0, pa0, pa1, pa2, pa3); partialSM<DK>(pB0, pB1, m_reg, mnB, alB);
  __syncthreads(); ATT_RESC(alB);
  finishSM(pB0, pB1, alB, l_reg, pa0, pa1, pa2, pa3); ATT_SBAR();
  pv_d0(o, vb0 + SHM_V, pa0, pa1, pa2, pa3);
  if (hi == 0) li_l[r32] = l_reg; asm volatile("s_waitcnt lgkmcnt(0)" ::: "memory");
  float rli[16];
#pragma unroll
  for (int r = 0; r < 16; ++r) rli[r] = __builtin_amdgcn_rcpf(li_l[crow(r, hi)]);
  unsigned short* Ow = Ob + (long)(wid * QBLK) * ldo;
#pragma unroll
  for (int r = 0; r < 16; ++r) { int orow = crow(r, hi);
#pragma unroll
    for (int d0 = 0; d0 < 4; ++d0) { const float v = o[d0][r] * rli[r]; unsigned u = __float_as_uint(v); u += 0x7fffu + ((u >> 16) & 1u); Ow[(long)orow * ldo + d0 * 32 + r32] = (unsigned short)(u >> 16); } }
  __syncthreads();
#undef ATT_SLOAD
#undef ATT_SWRITE
#undef ATT_SWAIT
#undef ATT_RESC
}
template <int DK, int ldq, int ldk, int ldv, int ldo, class CV>
__device__ __forceinline__ void attn_body_simple(const unsigned short* __restrict__ Qb, const unsigned short* __restrict__ Kh, const unsigned short* __restrict__ Vh,
                                                 unsigned short* __restrict__ Ob, int seq, char* lds, CV& cv) {
  using C_ = Cfg<DK>; constexpr int SHM_V = C_::SHM_V, SHM_K = C_::SHM_K, NKC = C_::NKC, CPR = DK / 8;
  int tid_ = threadIdx.x; asm volatile("" : "+v"(tid_));
  const int tid = tid_, wid = tid >> 6, lane = tid & 63, r32 = lane & 31, hi = lane >> 5;
  char* V_lds = lds; char* K_lds = lds + 2 * SHM_V;
  float* ws = (float*)(lds + 2 * SHM_V + 2 * SHM_K) + wid * 64; float* li_l = ws; float* al_l = ws + 32;
  float m_reg = -1e30f, l_reg = 0; f32x16 o[4] = {}; bf16x8 qr[DK / 16];
  const unsigned short* Qw = Qb + (long)(wid * QBLK + r32) * ldq + hi * 8;
#pragma unroll
  for (int d0 = 0; d0 < DK / 16; ++d0) qr[d0] = *reinterpret_cast<const bf16x8*>(Qw + d0 * 16);
  const int sr = tid >> 4, sc = (tid & 15) * 8, vst0 = v_st(sr, sc), vst1 = v_st(32 + sr, sc);
  unsigned kgo[NKC], klo[NKC];
#pragma unroll
  for (int i = 0; i < NKC; ++i) { const int c = tid + 512 * i, kr_ = c / CPR, kc_ = (c % CPR) * 8; kgo[i] = (unsigned)(kr_ * ldk + kc_) * 2u; klo[i] = (unsigned)kswz<DK>(kr_, kc_ * 2); }
  const unsigned vgo0 = (unsigned)(sr * ldv + sc) * 2u, vgo1 = (unsigned)((32 + sr) * ldv + sc) * 2u;
  const int vb0 = (int)(uintptr_t)V_lds + v_rd_base(lane);
  bf16x8 vs0, vs1, ks[NKC];
#define ATS_LOAD(k0) do { const char* _vt = (const char*)Vh + (size_t)(k0) * (ldv * 2); const char* _kt = (const char*)Kh + (size_t)(k0) * (ldk * 2); \
    vs0 = *reinterpret_cast<const bf16x8*>(_vt + vgo0); vs1 = *reinterpret_cast<const bf16x8*>(_vt + vgo1); \
    _Pragma("unroll") for (int _c = 0; _c < NKC; ++_c) ks[_c] = *reinterpret_cast<const bf16x8*>(_kt + kgo[_c]); } while (0)
#define ATS_WRITE(b) do { *(bf16x8*)(V_lds + (b) * SHM_V + vst0) = vs0; *(bf16x8*)(V_lds + (b) * SHM_V + vst1) = vs1; \
    _Pragma("unroll") for (int _c = 0; _c < NKC; ++_c) *(bf16x8*)(K_lds + (b) * SHM_K + klo[_c]) = ks[_c]; } while (0)
  const int NT = seq / KVBLK; float cw[32];
  ATS_LOAD(0); __builtin_amdgcn_s_waitcnt(0x0F70)  ; ATS_WRITE(0); __syncthreads();
#define ATT_TILE(J, B) do { const int j = (J); constexpr int b = (B); \
    if (b == 0) { cv.end(cw); cv.decode(); }                       \
    if (j + 1 < NT) ATS_LOAD((j + 1) * KVBLK); \
    ATT_SBAR(); \
    f32x16 p0, p1; float mn, al; bf16x8 pa0, pa1, pa2, pa3; \
    if constexpr (CV::RIDES && DK == 128) qkt_hook<DK>(p0, p1, K_lds + b * SHM_K, qr, r32, hi, [&](int d0) { if ((d0 & 1) == 0) cv.part(cw, b * 4 + (d0 >> 1)); });     \
    else qkt<DK>(p0, p1, K_lds + b * SHM_K, qr, r32, hi); \
    partialSM<DK>(p0, p1, m_reg, mn, al); \
    if (__any(al < 1.f)) { if (hi == 0) al_l[r32] = al; asm volatile("s_waitcnt lgkmcnt(0)" ::: "memory"); \
      for (int d = 0; d < 4; ++d) for (int r = 0; r < 16; ++r) o[d][r] *= al_l[crow(r, hi)]; } \
    finishSM(p0, p1, al, l_reg, pa0, pa1, pa2, pa3); ATT_SBAR(); \
    pv_d0(o, vb0 + b * SHM_V, pa0, pa1, pa2, pa3); \
    if (j + 1 < NT) { if constexpr (CV::RIDES && DK == 128) asm volatile("s_waitcnt vmcnt(4)" ::: "memory"); else asm volatile("s_waitcnt vmcnt(0)" ::: "memory"); ATS_WRITE(b ^ 1); } \
    __syncthreads(); } while (0)
  for (int jj = 0; jj < NT; jj += 2) {
    ATT_TILE(jj, 0);
    if (jj + 1 < NT) ATT_TILE(jj + 1, 1);
  }
#undef ATT_TILE
  if (NT & 1) cv.rest(cw);
  cv.end(cw);
  if (hi == 0) li_l[r32] = l_reg; asm volatile("s_waitcnt lgkmcnt(0)" ::: "memory");
  float rli[16];
#pragma unroll
  for (int r = 0; r < 16; ++r) rli[r] = __builtin_amdgcn_rcpf(li_l[crow(r, hi)]);
  unsigned short* Ow = Ob + (long)(wid * QBLK) * ldo;
#pragma unroll
  for (int r = 0; r < 16; ++r) { int orow = crow(r, hi);
#pragma unroll
    for (int d0 = 0; d0 < 4; ++d0) { const float v = o[d0][r] * rli[r]; unsigned u = __float_as_uint(v); u += 0x7fffu + ((u >> 16) & 1u); Ow[(long)orow * ldo + d0 * 32 + r32] = (unsigned short)(u >> 16); } }
  __syncthreads();
#undef ATS_LOAD
#undef ATS_WRITE
}
}
namespace ssd {
typedef short bf16x8 __attribute__((ext_vector_type(8)));
typedef short v4i16_t __attribute__((ext_vector_type(4)));
typedef float f32x4 __attribute__((ext_vector_type(4)));
typedef unsigned u32x2v __attribute__((ext_vector_type(2)));
typedef unsigned u32x4v __attribute__((ext_vector_type(4)));
#define SSD_LAS __attribute__((address_space(3)))
constexpr int T = 128, LD_B = 136, LD_X = 72, LD_A = 136, LD_S = 136;
constexpr int OFF_B = 0, OFF_X = OFF_B + T * LD_B * 2, OFF_XW = OFF_X + T * LD_X * 2, OFF_A = OFF_XW + T * LD_X * 2, OFF_S = OFF_A + T * LD_A * 2, OFF_E = OFF_S + 64 * LD_S * 2, OFF_W = OFF_E + 512, OFF_DT = OFF_W + 512, OFF_MISC = OFF_DT + 512, LDS_BYTES = OFF_MISC + 64;
static_assert(LDS_BYTES <= 131072, "ssd LDS");
__device__ __forceinline__ unsigned cvt_pk(float lo, float hi) { typedef float f32x2_t_ __attribute__((ext_vector_type(2))); typedef __bf16 bf16x2_t_ __attribute__((ext_vector_type(2))); const f32x2_t_ v_ = {lo, hi}; const bf16x2_t_ b_ = __builtin_convertvector(v_, bf16x2_t_); return __builtin_bit_cast(unsigned, b_); }
__device__ __forceinline__ bf16x8 tr8(const SSD_LAS unsigned char* p, int rowstride_bytes) {
    const v4i16_t a = __builtin_amdgcn_ds_read_tr16_b64_v4i16((SSD_LAS v4i16_t*)p);
    const v4i16_t b = __builtin_amdgcn_ds_read_tr16_b64_v4i16((SSD_LAS v4i16_t*)(p + 4 * rowstride_bytes));
    return (bf16x8){a[0], a[1], a[2], a[3], b[0], b[1], b[2], b[3]};
}
__device__ __forceinline__ void ssd_unit(SSD_LAS unsigned char* lds, const unsigned short* __restrict__ XBC, const float* __restrict__ DT, unsigned short* __restrict__ Y,
                                         int row0, int nc, int h, int dir, float a_h, const float* __restrict__ h0, float* __restrict__ hout) {
    int tid_ = threadIdx.x; asm volatile("" : "+v"(tid_));
    const int tid = tid_, w = tid >> 6, lane = tid & 63, li = lane & 15, g = lane >> 4, grp = h >> 3;
    SSD_LAS float* Es = (SSD_LAS float*)(lds + OFF_E); SSD_LAS float* Ws = (SSD_LAS float*)(lds + OFF_W); SSD_LAS float* Dts = (SSD_LAS float*)(lds + OFF_DT); SSD_LAS float* Misc = (SSD_LAS float*)(lds + OFF_MISC);
    f32x4 st[4];
#pragma unroll
    for (int pt = 0; pt < 4; ++pt) st[pt] = h0 ? *(const f32x4*)(h0 + (size_t)(16 * pt + li) * 128 + 16 * w + 4 * g) : (f32x4){0.f, 0.f, 0.f, 0.f};
#pragma unroll
    for (int pt = 0; pt < 4; ++pt) { u32x2v pk; pk.x = cvt_pk(st[pt][0], st[pt][1]); pk.y = cvt_pk(st[pt][2], st[pt][3]); *(SSD_LAS u32x2v*)(lds + OFF_S + ((16 * pt + li) * LD_S + 16 * w + 4 * g) * 2) = pk; }
    u32x4v bv[4]; u32x4v xv[2]; float dtv = 0.f;
#define SSD_PREFETCH(tq) do { _Pragma("unroll") for (int i = 0; i < 4; ++i) { const int ch = tid + 512 * i, r = ch >> 4, cc = (ch & 15) * 8; bv[i] = *(const u32x4v*)(XBC + (size_t)((tq) + r) * 1536 + 1024 + grp * 128 + cc); } \
        _Pragma("unroll") for (int i = 0; i < 2; ++i) { const int ch = tid + 512 * i, r = ch >> 3, cc = (ch & 7) * 8; xv[i] = *(const u32x4v*)(XBC + (size_t)((tq) + r) * 1536 + h * 64 + cc); } \
        dtv = DT[(size_t)((tq) + (tid & 127)) * 32 + dir * 16 + h]; } while (0)
    SSD_PREFETCH(row0 + (dir ? nc - 1 : 0) * T);
    for (int ci = 0; ci < nc; ++ci) {
        const int c = dir ? nc - 1 - ci : ci; const int t0 = row0 + c * T;
        bf16x8 cf[4];
#pragma unroll
        for (int k = 0; k < 4; ++k) cf[k] = *(const bf16x8*)(XBC + (size_t)(t0 + 16 * w + li) * 1536 + 1280 + grp * 128 + 32 * k + 8 * g);
        __builtin_amdgcn_sched_barrier(0);
        if (tid < 128) {
            const float da = dtv * a_h; float p = da;
#pragma unroll
            for (int o = 1; o < 64; o <<= 1) { const float q = __shfl_up(p, o); if (lane >= o) p += q; }
            if (lane == 63) Misc[w] = p;
            Dts[tid] = dtv; Es[tid] = p; Ws[tid] = da;
        }
        __syncthreads();
        if (tid < 128) {
            const float tot0 = Misc[0], tot = tot0 + Misc[1]; float P = Es[tid] + (w == 1 ? tot0 : 0.f); const float da = Ws[tid];
            const float E = dir ? tot - P + da : P;
            Es[tid] = E; Ws[tid] = __expf(tot - E) * Dts[tid];
            if (tid == 0) Misc[2] = tot;
        }
        __syncthreads();
#pragma unroll
        for (int i = 0; i < 4; ++i) { const int ch = tid + 512 * i, r = ch >> 4, cc = (ch & 15) * 8; *(SSD_LAS u32x4v*)(lds + OFF_B + (r * LD_B + cc) * 2) = bv[i]; }
#pragma unroll
        for (int i = 0; i < 2; ++i) { const int ch = tid + 512 * i, r = ch >> 3, cc = (ch & 7) * 8; *(SSD_LAS u32x4v*)(lds + OFF_X + (r * LD_X + cc) * 2) = xv[i];
            const float ws = Ws[r]; u32x4v o; const unsigned* xi = (const unsigned*)&xv[i]; unsigned* oo = (unsigned*)&o;
#pragma unroll
            for (int q = 0; q < 4; ++q) oo[q] = cvt_pk(__uint_as_float(xi[q] << 16) * ws, __uint_as_float(xi[q] & 0xffff0000u) * ws);
            *(SSD_LAS u32x4v*)(lds + OFF_XW + (r * LD_X + cc) * 2) = o; }
        SSD_PREFETCH(row0 + (ci + 1 < nc ? (dir ? nc - 2 - ci : ci + 1) : c) * T);
        __syncthreads();
#define SSD_SB() __builtin_amdgcn_sched_barrier(0)
        const int l = 16 * w + li; const float El = Es[l];
#pragma unroll
        for (int sp = 0; sp < 8; sp += 2) {
            bf16x8 a[2][4]; float es[2][4], ds[2][4];
#pragma unroll
            for (int t = 0; t < 2; ++t) {
#pragma unroll
                for (int k = 0; k < 4; ++k) a[t][k] = *(const SSD_LAS bf16x8*)(lds + OFF_B + ((16 * (sp + t) + li) * LD_B + 32 * k + 8 * g) * 2);
                const f32x4 e4 = *(const SSD_LAS f32x4*)(Es + 16 * (sp + t) + 4 * g), d4 = *(const SSD_LAS f32x4*)(Dts + 16 * (sp + t) + 4 * g);
#pragma unroll
                for (int j = 0; j < 4; ++j) { es[t][j] = e4[j]; ds[t][j] = d4[j]; } }
            SSD_SB();
            f32x4 acc[2] = {{0.f, 0.f, 0.f, 0.f}, {0.f, 0.f, 0.f, 0.f}};
#pragma unroll
            for (int k = 0; k < 4; ++k)
#pragma unroll
                for (int t = 0; t < 2; ++t) acc[t] = __builtin_amdgcn_mfma_f32_16x16x32_bf16(a[t][k], cf[k], acc[t], 0, 0, 0);
#pragma unroll
            for (int t = 0; t < 2; ++t) { float v[4];
#pragma unroll
                for (int j = 0; j < 4; ++j) { const int s_ = 16 * (sp + t) + 4 * g + j; const bool ok = dir ? (s_ >= l) : (s_ <= l); const float e = __expf(El - es[t][j]) * ds[t][j]; v[j] = ok ? acc[t][j] * e : 0.f; }
                u32x2v pk; pk.x = cvt_pk(v[0], v[1]); pk.y = cvt_pk(v[2], v[3]);
                *(SSD_LAS u32x2v*)(lds + OFF_A + (l * LD_A + 16 * (sp + t) + 4 * g) * 2) = pk; }
            SSD_SB();
        }
        asm volatile("s_waitcnt lgkmcnt(0)" ::: "memory");
        float el4[4];
        { const f32x4 e4 = *(const SSD_LAS f32x4*)(Es + 16 * w + 4 * g);
#pragma unroll
          for (int j = 0; j < 4; ++j) el4[j] = __expf(e4[j]); }
        unsigned short* yrow = Y + (size_t)(t0 + 16 * w + 4 * g) * 1024 + h * 64 + li;
        bf16x8 af[4];
#pragma unroll
        for (int k = 0; k < 4; ++k) af[k] = *(const SSD_LAS bf16x8*)(lds + OFF_A + (l * LD_A + 32 * k + 8 * g) * 2);
#pragma unroll
        for (int pt = 0; pt < 4; ++pt) {
            bf16x8 xb[4], sb[4];
#pragma unroll
            for (int k = 0; k < 4; ++k) { xb[k] = tr8(lds + OFF_X + ((32 * k + 8 * g + (li >> 2)) * LD_X + 16 * pt + 4 * (li & 3)) * 2, LD_X * 2);
                sb[k] = *(const SSD_LAS bf16x8*)(lds + OFF_S + ((16 * pt + li) * LD_S + 32 * k + 8 * g) * 2); }
            SSD_SB();
            f32x4 ya = {0.f, 0.f, 0.f, 0.f}, yb = {0.f, 0.f, 0.f, 0.f};
#pragma unroll
            for (int k = 0; k < 4; ++k) { ya = __builtin_amdgcn_mfma_f32_16x16x32_bf16(af[k], xb[k], ya, 0, 0, 0); yb = __builtin_amdgcn_mfma_f32_16x16x32_bf16(cf[k], sb[k], yb, 0, 0, 0); }
#pragma unroll
            for (int j = 0; j < 4; ++j) { const float yv = ya[j] + el4[j] * yb[j]; unsigned u = __float_as_uint(yv); u += 0x7fffu + ((u >> 16) & 1u); yrow[(size_t)j * 1024 + 16 * pt] = (unsigned short)(u >> 16); }
            SSD_SB();
        }
        __syncthreads();
        const float etot = __expf(Misc[2]);
        bf16x8 ba[4];
#pragma unroll
        for (int k = 0; k < 4; ++k) ba[k] = tr8(lds + OFF_B + ((32 * k + 8 * g + (li >> 2)) * LD_B + 16 * w + 4 * (li & 3)) * 2, LD_B * 2);
#pragma unroll
        for (int pt = 0; pt < 4; ++pt) { bf16x8 xw[4];
#pragma unroll
            for (int k = 0; k < 4; ++k) xw[k] = tr8(lds + OFF_XW + ((32 * k + 8 * g + (li >> 2)) * LD_X + 16 * pt + 4 * (li & 3)) * 2, LD_X * 2);
            SSD_SB();
            st[pt] *= etot;
#pragma unroll
            for (int k = 0; k < 4; ++k) st[pt] = __builtin_amdgcn_mfma_f32_16x16x32_bf16(ba[k], xw[k], st[pt], 0, 0, 0);
            u32x2v pk; pk.x = cvt_pk(st[pt][0], st[pt][1]); pk.y = cvt_pk(st[pt][2], st[pt][3]); *(SSD_LAS u32x2v*)(lds + OFF_S + ((16 * pt + li) * LD_S + 16 * w + 4 * g) * 2) = pk;
            SSD_SB(); }
        __syncthreads();
    }
#undef SSD_SB
#undef SSD_PREFETCH
    if (hout) {
#pragma unroll
        for (int pt = 0; pt < 4; ++pt) *(f32x4*)(hout + (size_t)(16 * pt + li) * 128 + 16 * w + 4 * g) = st[pt];
    }
}
}
namespace s5 {
typedef short bf16x8 __attribute__((ext_vector_type(8)));
typedef short bf16x4 __attribute__((ext_vector_type(4)));
typedef float f32x4 __attribute__((ext_vector_type(4)));
typedef float f32x2 __attribute__((ext_vector_type(2)));
typedef unsigned u32x2 __attribute__((ext_vector_type(2)));
typedef unsigned u32x4 __attribute__((ext_vector_type(4)));
#define S5_LAS __attribute__((address_space(3)))
constexpr int LD_BU = 136, LD_HS = 136;
constexpr int OFF_HS = 16 * LD_BU * 2, OFF_YL = OFF_HS + 16 * LD_HS * 2;
constexpr int WAVE_LDS = OFF_YL + 16 * 16 * 16 * 2;
constexpr int CD_BYTES = 1024 + 4096, CG_BYTES = 4096;
__device__ __forceinline__ unsigned short f2bf(float f) { unsigned u = __float_as_uint(f); u += 0x7fffu + ((u >> 16) & 1u); return (unsigned short)(u >> 16); }
__device__ __forceinline__ unsigned pk(float lo, float hi) { typedef float f2_ __attribute__((ext_vector_type(2))); typedef __bf16 b2_ __attribute__((ext_vector_type(2))); const f2_ v = {lo, hi}; const b2_ b = __builtin_convertvector(v, b2_); return __builtin_bit_cast(unsigned, b); }

__device__ __forceinline__ void make_consts(unsigned char* cd, unsigned char* cg  , const float* lam_re, const float* lam_im, float stepsz, const float* b_re, const float* b_im, const float* c_re, const float* c_im, int lane) {
    const int li = lane & 15, g = lane >> 4;
    float ar, ai, kr, ki;
    { const float lr = lam_re[lane], lm = lam_im[lane]; const float mag = expf(lr * stepsz); float sn, cs; sincosf(lm * stepsz, &sn, &cs); ar = mag * cs; ai = mag * sn;
      const float den = lr * lr + lm * lm; kr = ((ar - 1.0f) * lr + ai * lm) / den; ki = (ai * lr - (ar - 1.0f) * lm) / den; }
    float zr = ar, zi = ai;
#pragma unroll
    for (int i = 0; i < 8; ++i) { const float nr = zr * zr - zi * zi, ni = 2.0f * zr * zi; zr = nr; zi = ni; }
    float* cf = (float*)cd; cf[lane] = ar; cf[64 + lane] = ai; cf[128 + lane] = zr; cf[192 + lane] = zi;
#pragma unroll
    for (int ct = 0; ct < 8; ++ct) { const int k = 16 * ct + li, p = k >> 1; const bool im = k & 1; const float kkr = __shfl(kr, p), kki = __shfl(ki, p);
        const f32x4 br = *(const f32x4*)(b_re + p * 16 + 4 * g), bi = *(const f32x4*)(b_im + p * 16 + 4 * g); float v[4];
#pragma unroll
        for (int j = 0; j < 4; ++j) v[j] = im ? kkr * bi[j] + kki * br[j] : kkr * br[j] - kki * bi[j];
        u32x2 w; w.x = pk(v[0], v[1]); w.y = pk(v[2], v[3]); *(u32x2*)(cd + 1024 + (ct * 64 + lane) * 8) = w; }
    if (cg) {
#pragma unroll
        for (int kk = 0; kk < 4; ++kk) { const f32x4 vr = *(const f32x4*)(c_re + li * 64 + 16 * kk + 4 * g), vi = *(const f32x4*)(c_im + li * 64 + 16 * kk + 4 * g);
            u32x4 w; w.x = pk(vr[0], -vi[0]); w.y = pk(vr[1], -vi[1]); w.z = pk(vr[2], -vi[2]); w.w = pk(vr[3], -vi[3]); *(u32x4*)(cg + (kk * 64 + lane) * 16) = w; } }
}
struct Ctx {
    float ar, ai;
    bf16x4 bfr[8];
    bf16x8 cfr[4];
};
__device__ __forceinline__ void load_ctx(Ctx& c, const unsigned char* cd, const unsigned char* cg, int lane, bool with_c) {
    const float* cf = (const float*)cd; c.ar = cf[lane]; c.ai = cf[64 + lane];
#pragma unroll
    for (int ct = 0; ct < 8; ++ct) c.bfr[ct] = __builtin_bit_cast(bf16x4, *(const u32x2*)(cd + 1024 + (ct * 64 + lane) * 8));
    if (with_c) {
#pragma unroll
        for (int kk = 0; kk < 4; ++kk) c.cfr[kk] = __builtin_bit_cast(bf16x8, *(const u32x4*)(cg + (kk * 64 + lane) * 16)); }
}
template <bool NEWT, bool CURT, bool HSW, bool OLDT, bool POST>
__device__ __forceinline__ void step(const Ctx& c, S5_LAS unsigned char* BU, S5_LAS unsigned char* HS, S5_LAS unsigned char* YL  , int lane, int li, int g, int dir, const u32x2 unew, float& hr, float& hi,
                                     const unsigned short* __restrict__ uold, int ldu, unsigned short* __restrict__ outp, float dch) {
    unsigned bu[16]; bf16x8 hf[4]; f32x4 acc[8]; unsigned hs[16]; unsigned short yprev[4]; unsigned short uo[4];
    if (CURT) {
#pragma unroll
        for (int i = 0; i < 16; ++i) { const int t = dir ? 15 - i : i; bu[i] = *(const S5_LAS unsigned*)(BU + t * (LD_BU * 2) + lane * 4); } }
    if (OLDT) {
#pragma unroll
        for (int kk = 0; kk < 4; ++kk) hf[kk] = *(const S5_LAS bf16x8*)(HS + li * (LD_HS * 2) + (32 * kk + 8 * g) * 2);
        if (POST) {
#pragma unroll
            for (int j = 0; j < 4; ++j) { yprev[j] = *(const S5_LAS unsigned short*)(YL + ((4 * g + j) * 16 + li) * 2); uo[j] = uold[(size_t)(4 * g + j) * ldu + li]; }
            __builtin_amdgcn_sched_barrier(0); } }
    if (NEWT) { const bf16x4 uf = __builtin_bit_cast(bf16x4, unew);
#pragma unroll
        for (int ct = 0; ct < 8; ++ct) { acc[ct] = (f32x4){0.f, 0.f, 0.f, 0.f}; acc[ct] = __builtin_amdgcn_mfma_f32_16x16x16bf16_1k(c.bfr[ct], uf, acc[ct], 0, 0, 0); } }
    if (CURT) {
#pragma unroll
        for (int i = 0; i < 16; ++i) { const float br = __uint_as_float(bu[i] << 16), bi = __uint_as_float(bu[i] & 0xffff0000u);
            const float nr = c.ar * hr - c.ai * hi + br, ni = c.ar * hi + c.ai * hr + bi; hr = nr; hi = ni; if (HSW) hs[i] = pk(hr, hi); } }
    if (OLDT) { f32x4 y = {0.f, 0.f, 0.f, 0.f};
#pragma unroll
        for (int kk = 0; kk < 4; ++kk) y = __builtin_amdgcn_mfma_f32_16x16x32_bf16(hf[kk], c.cfr[kk], y, 0, 0, 0);
        if (!POST) {
#pragma unroll
            for (int j = 0; j < 4; ++j) *(S5_LAS unsigned short*)(YL + ((4 * g + j) * 16 + li) * 2) = f2bf(y[j]); }
        else {
#pragma unroll
            for (int j = 0; j < 4; ++j) { const float v = y[j] + __uint_as_float((unsigned)yprev[j] << 16) + dch * __uint_as_float((unsigned)uo[j] << 16); const float tt = 0.7978845608028654f * (v + 0.044715f * v * v * v);
                outp[(size_t)(4 * g + j) * 1024 + li] = f2bf(v * (1.0f - 1.0f / (1.0f + __expf(2.0f * tt)))); } } }
    if (NEWT) {
#pragma unroll
        for (int ct = 0; ct < 8; ++ct) { u32x2 w; w.x = pk(acc[ct][0], acc[ct][1]); w.y = pk(acc[ct][2], acc[ct][3]); *(S5_LAS u32x2*)(BU + (li * LD_BU + 16 * ct + 4 * g) * 2) = w; } }
    if (CURT && HSW) {
#pragma unroll
        for (int i = 0; i < 16; ++i) { const int t = dir ? 15 - i : i; *(S5_LAS unsigned*)(HS + t * (LD_HS * 2) + lane * 4) = hs[i]; } }
}
template <bool POST>
__device__ __forceinline__ void s5_pass(const Ctx& c, S5_LAS unsigned char* wl, int lane, int dir, const unsigned short* __restrict__ U, int ldu, unsigned short* __restrict__ OUT, float dch, float& hr, float& hi) {
    const int li = lane & 15, g = lane >> 4; constexpr int L = 256, ntile = 16;
    S5_LAS unsigned char* BU = wl; S5_LAS unsigned char* HS = wl + OFF_HS; S5_LAS unsigned char* YL = wl + OFF_YL;
#define S5_TB(ti) (dir ? L - 16 * ((ti) + 1) : 16 * (ti))
#define S5_ULOAD(ti) (*(const u32x2*)(U + (size_t)(S5_TB(ti) + li) * ldu + 4 * g))
#define S5_ARGS(ti) YL + S5_TB(ti) * 32, lane, li, g, dir
#define S5_ARGS2(ti) U + (size_t)S5_TB(ti) * ldu, ldu, OUT + (size_t)S5_TB(ti) * 1024, dch
    u32x2 u0 = S5_ULOAD(0), u1 = S5_ULOAD(1), u2 = S5_ULOAD(2);
    step<true, false, true, false, POST>(c, BU, HS, S5_ARGS(0), u0, hr, hi, S5_ARGS2(0));
    step<true, true, true, false, POST>(c, BU, HS, S5_ARGS(0), u1, hr, hi, S5_ARGS2(0));
    u0 = u2; u1 = S5_ULOAD(3); u2 = S5_ULOAD(4);
#pragma clang loop unroll(disable)
    for (int ti = 2; ti < ntile; ++ti) {
        const u32x2 uc = u0; u0 = u1; u1 = u2; if (ti + 3 < ntile) u2 = S5_ULOAD(ti + 3);
        step<true, true, true, true, POST>(c, BU, HS, S5_ARGS(ti - 2), uc, hr, hi, S5_ARGS2(ti - 2));
    }
    step<false, true, true, true, POST>(c, BU, HS, S5_ARGS(ntile - 2), u0, hr, hi, S5_ARGS2(ntile - 2));
    step<false, false, true, true, POST>(c, BU, HS, S5_ARGS(ntile - 1), u0, hr, hi, S5_ARGS2(ntile - 1));
#undef S5_ARGS
#undef S5_ARGS2
}
__device__ __forceinline__ void s5_epass(const Ctx& c, S5_LAS unsigned char* wl, int lane, int dir, const unsigned short* __restrict__ U, int ldu, float& hr, float& hi) {
    const int li = lane & 15, g = lane >> 4; constexpr int L = 256, ntile = 16;
    S5_LAS unsigned char* BU = wl; S5_LAS unsigned char* HS = wl + OFF_HS;
    u32x2 uu[16];
#pragma unroll
    for (int ti = 0; ti < 16; ++ti) uu[ti] = S5_ULOAD(ti);
    step<true, false, false, false, false>(c, BU, HS, HS, lane, li, g, dir, uu[0], hr, hi, nullptr, 0, nullptr, 0.f);
#pragma unroll
    for (int ti = 1; ti < ntile; ++ti) step<true, true, false, false, false>(c, BU, HS, HS, lane, li, g, dir, uu[ti], hr, hi, nullptr, 0, nullptr, 0.f);
    step<false, true, false, false, false>(c, BU, HS, HS, lane, li, g, dir, uu[0], hr, hi, nullptr, 0, nullptr, 0.f);
#undef S5_ULOAD
#undef S5_TB
}
}
typedef unsigned short bf16;
typedef float f32x4 __attribute__((ext_vector_type(4)));
typedef unsigned u32x4 __attribute__((ext_vector_type(4)));
typedef unsigned u32x2 __attribute__((ext_vector_type(2)));
#define LAS __attribute__((address_space(3)))
constexpr int NWAVES = 8, NTHREADS = 512;
constexpr int DM = 2048, MROWS = 16384, MCTX = 8192, KROWS = 18432, NLAYER = 4;
constexpr int NIN = 14336;
constexpr int C_GATE = 0, C_GQ = 8192, C_GK = 9216, C_GV = 9472, C_SZ = 9728, C_XBC = 10752, C_S5U = 12288, C_MQD = 13312, C_CKV = 13824, C_KPE = 14080, C_SDT = 14144, C_END = 14176;
constexpr int FFN = 5632;
constexpr float EPS = 1e-6f;
constexpr size_t MiB = 1u << 20;
constexpr size_t WS_CTL = 0, CTL_ZERO_BYTES = 1 * MiB;
constexpr size_t WS_MOD = 1 * MiB;
constexpr size_t WS_TAB = 2 * MiB;
constexpr size_t WS_X = 4 * MiB;
constexpr size_t WS_H = 132 * MiB;
constexpr size_t WS_PROJ = 196 * MiB;
constexpr size_t WS_W = 644 * MiB;
constexpr size_t W_IN = 0, W_UQ = W_IN + (size_t)NIN * 2048 * 2, W_UKV = W_UQ + (size_t)1536 * 512 * 2, W_GLU = W_UKV + (size_t)2048 * 256 * 2, W_BR = W_GLU + (size_t)2048 * 1024 * 2,
                 W_OUT = W_BR + (size_t)4 * 2048 * 1024 * 2, W_FI = W_OUT + (size_t)2048 * 2048 * 2, W_FO = W_FI + (size_t)11264 * 2048 * 2, W_END = W_FO + (size_t)2048 * 5632 * 2;
static_assert(W_END <= 154 * MiB, "weights region");
constexpr size_t WS_Q = 798 * MiB, WS_KG = 830 * MiB, WS_VG = 839 * MiB, WS_AQ = 848 * MiB, WS_ACKV = 864 * MiB, WS_QM = 873 * MiB, WS_KM = 921 * MiB, WS_VM = 975 * MiB,
                 WS_XBC = 1011 * MiB, WS_DT = 1059 * MiB, WS_YF = 1061 * MiB, WS_YB = 1125 * MiB, WS_SF = 1189 * MiB, WS_SB = 1253 * MiB, WS_S5PRE = 1317 * MiB,
                 WS_O = 1349 * MiB, WS_GSF = 1477 * MiB, WS_GS = 1605 * MiB, WS_END = 1669 * MiB;
constexpr size_t WS_S5C = WS_GSF, WS_S5G = WS_GSF + 4 * MiB, WS_S5E = WS_GSF + 8 * MiB;
constexpr int CW_BAR = 4096;
constexpr size_t O_YP = 0, O_YS = 16777216, O_GK = 33554432, O_GV = 41943040, O_CKV = 50331648, O_KPE = 58720256, O_SSD = 60817408, O_S5 = 94371840, O_TOTAL = 96468992;
constexpr int RING_BYTES = 131072, LDSCTL_OFF = 135168  , MISC_OFF = LDSCTL_OFF + 320, LDS_BYTES = 147456;

#define VM_WAIT() asm volatile("s_waitcnt vmcnt(0)" ::: "memory")
__device__ __forceinline__ unsigned f2bf(float f) { unsigned u = __float_as_uint(f); return (u + 0x7fffu + ((u >> 16) & 1u)) >> 16; }
__device__ __forceinline__ unsigned pk2(float lo, float hi) { typedef float f32x2_t_ __attribute__((ext_vector_type(2))); typedef __bf16 bf16x2_t_ __attribute__((ext_vector_type(2))); const f32x2_t_ v_ = {lo, hi}; const bf16x2_t_ b_ = __builtin_convertvector(v_, bf16x2_t_); return __builtin_bit_cast(unsigned, b_); }
__device__ __forceinline__ float bflo(unsigned w) { return __uint_as_float(w << 16); }
__device__ __forceinline__ float bfhi(unsigned w) { return __uint_as_float(w & 0xffff0000u); }
__device__ __forceinline__ void unpack8(const u32x4 w, float* f) { f[0] = bflo(w.x); f[1] = bfhi(w.x); f[2] = bflo(w.y); f[3] = bfhi(w.y); f[4] = bflo(w.z); f[5] = bfhi(w.z); f[6] = bflo(w.w); f[7] = bfhi(w.w); }
__device__ __forceinline__ u32x4 pack8f(const float* f) { u32x4 w; w.x = pk2(f[0], f[1]); w.y = pk2(f[2], f[3]); w.z = pk2(f[4], f[5]); w.w = pk2(f[6], f[7]); return w; }
__device__ __forceinline__ float wave_sum(float v) {
#pragma unroll
    for (int o = 1; o < 64; o <<= 1) v += __shfl_xor(v, o);
    return v;
}
__device__ __forceinline__ float sigm(float x) { return 1.0f / (1.0f + __expf(-x)); }

struct Args { const float* in[41]; float* out; unsigned char* ws; int ph_lo, ph_hi, li, pad; };
struct Frame {
    LAS unsigned char* lds; int tid, lane, wave, G, bid, gw, NGW;
    const float* const* in; float* out; unsigned char* ws;
    const float* const* in0; float* out0; unsigned char* ws0;
};
enum { I_XP = 0, I_XS, I_CGK, I_CGV, I_CCKV, I_CKPE, I_SSSD, I_SS5, I_C, I_CCTX, I_N1G, I_N2G, I_WMOD, I_BMOD, I_WIN, I_QNG, I_KNG, I_CONVW, I_CONVB, I_ALOG, I_DTB, I_SSDD, I_SSDNG,
       I_MQNG, I_WUQ, I_MKVNG, I_WUKV, I_LRE, I_LIM, I_LSTEP, I_BRE, I_BIM, I_CRE, I_CIM, I_S5D, I_WGLU, I_WBR, I_WOUT, I_WFI, I_WFO, I_FING };

__device__ __forceinline__ void transpose_item(const float* W, int K, int N, bf16* WT, int dst_row0, int k0, int n0, LAS float* scr, int lane) {
#pragma unroll 8
    for (int i = 0; i < 32; ++i) { const int kk = 2 * i + (lane >> 5); scr[kk * 33 + (lane & 31)] = W[(size_t)(k0 + kk) * N + n0 + (lane & 31)]; }
    asm volatile("s_waitcnt lgkmcnt(0)" ::: "memory");
    const int c = lane & 7;
#pragma unroll
    for (int j = 0; j < 4; ++j) { const int n = (lane >> 3) + 8 * j; const LAS float* s = scr + (8 * c) * 33 + n;
        u32x4 o; o.x = pk2(s[0 * 33], s[1 * 33]); o.y = pk2(s[2 * 33], s[3 * 33]); o.z = pk2(s[4 * 33], s[5 * 33]); o.w = pk2(s[6 * 33], s[7 * 33]);
        *(u32x4*)(WT + (size_t)(dst_row0 + n) * K + k0 + 8 * c) = o; }
    asm volatile("s_waitcnt lgkmcnt(0)" ::: "memory");
}
__device__ __forceinline__ int map_in(int c) {
    if (c < 12288) return c; if (c < 12320) return C_SDT + (c - 12288); if (c < 12832) return C_MQD + (c - 12320); if (c < 13152) return C_CKV + (c - 12832); return C_S5U + (c - 13152);
}
__device__ __forceinline__ int map_pair(int c, int half) {
    return c < half ? 256 * (c >> 7) + (c & 127) : 256 * ((c - half) >> 7) + 128 + ((c - half) & 127);
}
__device__ __forceinline__ void phase_zero_pad(Frame& F) {
    bf16* Wi = (bf16*)((char*)(F.ws + WS_W) + W_IN); const u32x4 z = {0u, 0u, 0u, 0u};
    for (int r = F.gw; r < NIN - C_END; r += F.NGW) { u32x4* p = (u32x4*)(Wi + (size_t)(C_END + r) * 2048);
#pragma unroll
        for (int j = 0; j < 4; ++j) p[F.lane + 64 * j] = z; }
}
__device__ __forceinline__ void phase_prologue(Frame& F) {
    LAS float* sc = (LAS float*)F.lds;
    LAS float* part = (LAS float*)(F.lds + 40960);
    float* MOD = (float*)(F.ws + WS_MOD);
    for (int i = F.tid; i < 5 * 2048; i += NTHREADS) { const int v = i >> 11, k = i & 2047; const float x = v == 0 ? F.in[I_CCTX][k] : F.in[I_C][(v - 1) * 2048 + k]; sc[i] = x * sigm(x); }
    __syncthreads();
    for (int it = F.bid; it < 192; it += F.G) {
        const int l = it / 48, cg = it % 48; const float* W = F.in[I_WMOD] + (size_t)l * 2048 * 12288 + 256 * cg + 4 * F.lane;
        f32x4 acc[5];
#pragma unroll
        for (int v = 0; v < 5; ++v) acc[v] = (f32x4){0.f, 0.f, 0.f, 0.f};
        const int k0 = 256 * F.wave;
#pragma unroll 16
        for (int k = 0; k < 256; ++k) { const f32x4 w = *(const f32x4*)(W + (size_t)(k0 + k) * 12288);
#pragma unroll
            for (int v = 0; v < 5; ++v) acc[v] += sc[v * 2048 + k0 + k] * w; }
#pragma unroll
        for (int v = 0; v < 5; ++v) *(LAS f32x4*)(part + (F.wave * 5 + v) * 256 + 4 * F.lane) = acc[v];
        __syncthreads();
        for (int o = F.tid; o < 1280; o += NTHREADS) { const int v = o >> 8, col = o & 255; float s = F.in[I_BMOD][l * 12288 + 256 * cg + col];
#pragma unroll
            for (int w = 0; w < 8; ++w) s += part[(w * 5 + v) * 256 + col];
            MOD[((size_t)l * 5 + v) * 12288 + 256 * cg + col] = s; }
        __syncthreads();
    }
    for (int i = F.gw; i < NLAYER * 2 * 64; i += F.NGW) { const int layer = i >> 7, dir = (i >> 6) & 1, g = i & 63; const size_t pg = (size_t)(layer * 2 + dir) * 64 + g;
        s5::make_consts(F.ws + WS_S5C + (size_t)i * s5::CD_BYTES, dir == 0 ? F.ws + WS_S5G + ((size_t)layer * 64 + g) * s5::CG_BYTES : nullptr, F.in[I_LRE] + pg * 64, F.in[I_LIM] + pg * 64, expf(F.in[I_LSTEP][pg]),
                        F.in[I_BRE] + ((size_t)layer * 64 + g) * 1024, F.in[I_BIM] + ((size_t)layer * 64 + g) * 1024, F.in[I_CRE] + ((size_t)layer * 64 + g) * 1024, F.in[I_CIM] + ((size_t)layer * 64 + g) * 1024, F.lane); }
    if (F.bid == F.G - 1) {
        float2* tA = (float2*)(F.ws + WS_TAB); float2* tC = tA + 64 * 32;
        for (int i = F.tid; i < 64 * 32; i += NTHREADS) { const int pos = i >> 5, f = i & 31; const float a = (float)pos * expf(-(float)f * (9.210340371976184f / 32.0f)); float sn, cs; sincosf(a, &sn, &cs); tA[i] = make_float2(cs, sn); }
        for (int i = F.tid; i < 64 * 16; i += NTHREADS) { const int pos = i >> 4, f = i & 15; const float a = (float)pos * expf(-(float)f * (9.210340371976184f / 16.0f)); float sn, cs; sincosf(a, &sn, &cs); tC[i] = make_float2(cs, sn); }
    }
}
__device__ __forceinline__ void phase_norm(Frame& F, int layer, int which  , bool from_input) {
    float* X = (float*)(F.ws + WS_X); bf16* H = (bf16*)(F.ws + WS_H); const float* MOD = (const float*)(F.ws + WS_MOD) + (size_t)layer * 5 * 12288;
    const float* gw = F.in[which ? I_N2G : I_N1G] + layer * 2048;
    for (int m = F.gw; m < MROWS; m += F.NGW) {
        const float* src = from_input ? (m < MCTX ? F.in[I_XP] + (size_t)m * DM : F.in[I_XS] + (size_t)(m - MCTX) * DM) : X + (size_t)m * DM;
        const int mrow = m < MCTX ? 0 : 1 + ((m - MCTX) >> 11); const float* sh = MOD + mrow * 12288 + (which ? 3 : 0) * 2048; const float* scl = sh + 2048;
        f32x4 v[8]; float ss = 0.f;
#pragma unroll
        for (int j = 0; j < 8; ++j) { v[j] = *(const f32x4*)(src + 4 * F.lane + 256 * j); ss += v[j][0] * v[j][0] + v[j][1] * v[j][1] + v[j][2] * v[j][2] + v[j][3] * v[j][3]; }
        if (from_input) {
#pragma unroll
            for (int j = 0; j < 8; ++j) *(f32x4*)(X + (size_t)m * DM + 4 * F.lane + 256 * j) = v[j]; }
        const float rstd = rsqrtf(wave_sum(ss) * (1.0f / DM) + EPS);
#pragma unroll
        for (int j = 0; j < 8; ++j) { const int c = 4 * F.lane + 256 * j; const f32x4 g = *(const f32x4*)(gw + c), s1 = *(const f32x4*)(scl + c), s0 = *(const f32x4*)(sh + c);
            const f32x4 o = v[j] * rstd * g * (1.0f + s1) + s0; u32x2 w; w.x = pk2(o[0], o[1]); w.y = pk2(o[2], o[3]); *(u32x2*)(H + (size_t)m * DM + c) = w; }
    }
}
__device__ __forceinline__ void phase_final_norm(Frame& F) {
    const float* X = (const float*)(F.ws + WS_X); const float* gw = F.in[I_FING];
    for (int m = F.gw; m < MROWS; m += F.NGW) {
        f32x4 v[8]; float ss = 0.f;
#pragma unroll
        for (int j = 0; j < 8; ++j) { v[j] = *(const f32x4*)(X + (size_t)m * DM + 4 * F.lane + 256 * j); ss += v[j][0] * v[j][0] + v[j][1] * v[j][1] + v[j][2] * v[j][2] + v[j][3] * v[j][3]; }
        const float rstd = rsqrtf(wave_sum(ss) * (1.0f / DM) + EPS);
#pragma unroll
        for (int j = 0; j < 8; ++j) { const int c = 4 * F.lane + 256 * j; *(f32x4*)(F.out + O_YP + (size_t)m * DM + c) = v[j] * rstd * *(const f32x4*)(gw + c); }
    }
}
__device__ __forceinline__ void phase_prep(Frame& F, int layer) {
    const bf16* PROJ = (const bf16*)(F.ws + WS_PROJ);
    bf16* Q = (bf16*)(F.ws + WS_Q); bf16* KG = (bf16*)(F.ws + WS_KG); bf16* VG = (bf16*)(F.ws + WS_VG); bf16* AQ = (bf16*)(F.ws + WS_AQ); bf16* ACKV = (bf16*)(F.ws + WS_ACKV);
    bf16* KM = (bf16*)(F.ws + WS_KM); bf16* XBC = (bf16*)(F.ws + WS_XBC); float* DT = (float*)(F.ws + WS_DT);
    const float2* tA = (const float2*)(F.ws + WS_TAB); const float2* tC = tA + 64 * 32;
    const int lane = F.lane;
    for (int vr = F.gw; vr < KROWS; vr += F.NGW) {
        if (vr >= MROWS) {
            const int c = vr - MROWS, b = c >> 9, j = c & 511; const size_t kr = MCTX + (size_t)b * 2560 + 2048 + j; const size_t ci = ((size_t)b * 4 + layer) * 512 + j;
            { const f32x4 a = *(const f32x4*)(F.in[I_CGK] + ci * 256 + 4 * lane); u32x2 w; w.x = pk2(a[0], a[1]); w.y = pk2(a[2], a[3]); *(u32x2*)(KG + kr * 256 + 4 * lane) = w; }
            { const f32x4 a = *(const f32x4*)(F.in[I_CGV] + ci * 256 + 4 * lane); u32x2 w; w.x = pk2(a[0], a[1]); w.y = pk2(a[2], a[3]); *(u32x2*)(VG + kr * 256 + 4 * lane) = w; }
            { const f32x4 a = *(const f32x4*)(F.in[I_CCKV] + ci * 256 + 4 * lane); u32x2 w; w.x = pk2(a[0], a[1]); w.y = pk2(a[2], a[3]); *(u32x2*)(ACKV + kr * 256 + 4 * lane) = w; }
            { const bf16 kp = (bf16)f2bf(F.in[I_CKPE][ci * 64 + lane]);
#pragma unroll
              for (int hh = 0; hh < 8; ++hh) KM[kr * 1536 + hh * 192 + 128 + lane] = kp; }
            continue;
        }
        const int m = vr; const bool lat = m >= MCTX; const int bb = lat ? (m - MCTX) >> 11 : m >> 8; const int t = lat ? (m - MCTX) & 2047 : m & 255; const int L = lat ? 2048 : 256;
        const size_t kr = lat ? MCTX + (size_t)bb * 2560 + t : (size_t)m; const int rowpos = t >> 6, colpos = t & 63;
        const bf16* pr = PROJ + (size_t)m * NIN; const size_t orow = ((size_t)bb * 4 + layer) * 256 + t;
        const int j8 = lane & 7, ax = j8 >> 2, fo = (j8 & 3) * 8;
        const u32x4 ldq0 = *(const u32x4*)(pr + C_GQ + (lane >> 3) * 128 + ax * 64 + fo), ldq1 = *(const u32x4*)(pr + C_GQ + (lane >> 3) * 128 + ax * 64 + fo + 32);
        const u32x4 ldk0 = *(const u32x4*)(pr + C_GK + ((lane >> 3) & 1) * 128 + ax * 64 + fo), ldk1 = *(const u32x4*)(pr + C_GK + ((lane >> 3) & 1) * 128 + ax * 64 + fo + 32);
        const u32x4 ldv = *(const u32x4*)(pr + C_GV + 8 * (lane & 31));
        const u32x4 ldqd = *(const u32x4*)(pr + C_MQD + 8 * lane);
        const u32x4 ldck = *(const u32x4*)(pr + C_CKV + 8 * (lane & 31));
        const int axp = (lane >> 1) & 1, fop = (lane & 1) * 8;
        const u32x4 ldp0 = *(const u32x4*)(pr + C_KPE + axp * 32 + fop), ldp1 = *(const u32x4*)(pr + C_KPE + axp * 32 + fop + 16);
        u32x4 ldc[3][5];
#pragma unroll
        for (int i = 0; i < 3; ++i)
#pragma unroll
            for (int k = 0; k < 5; ++k) { const int tt = t + k - 2; const bool ok = tt >= 0 && tt < L; ldc[i][k] = *(const u32x4*)(pr + (ok ? (ptrdiff_t)(k - 2) * NIN : 0) + C_XBC + 8 * lane + 512 * i); if (!ok) ldc[i][k] = (u32x4){0u, 0u, 0u, 0u}; }
        const unsigned short lddt = pr[C_SDT + (lane & 31)];
        { const float2* tp = tA + (ax ? colpos : rowpos) * 32 + fo;
          { const int hq = lane >> 3; float x0[8], x1[8]; unpack8(ldq0, x0); unpack8(ldq1, x1);
            float ss = 0.f;
#pragma unroll
            for (int e = 0; e < 8; ++e) ss += x0[e] * x0[e] + x1[e] * x1[e];
            ss += __shfl_xor(ss, 1); ss += __shfl_xor(ss, 2); ss += __shfl_xor(ss, 4);
            const float rstd = rsqrtf(ss * (1.0f / 128.0f) + EPS); const float* gq = F.in[I_QNG] + layer * 128 + ax * 64 + fo;
#pragma unroll
            for (int e = 0; e < 8; ++e) { float a = x0[e] * rstd * gq[e], b = x1[e] * rstd * gq[32 + e]; if (lat) { const float2 cs = tp[e]; const float a2 = a * cs.x - b * cs.y; b = a * cs.y + b * cs.x; a = a2; } x0[e] = a; x1[e] = b; }
            bf16* q = Q + (size_t)m * 1024 + hq * 128 + ax * 64 + fo; *(u32x4*)q = pack8f(x0); *(u32x4*)(q + 32) = pack8f(x1); }
          { const int kh = (lane >> 3) & 1; float x0[8], x1[8]; unpack8(ldk0, x0); unpack8(ldk1, x1);
            float ss = 0.f;
#pragma unroll
            for (int e = 0; e < 8; ++e) ss += x0[e] * x0[e] + x1[e] * x1[e];
            ss += __shfl_xor(ss, 1); ss += __shfl_xor(ss, 2); ss += __shfl_xor(ss, 4);
            const float rstd = rsqrtf(ss * (1.0f / 128.0f) + EPS); const float* gk = F.in[I_KNG] + layer * 128 + ax * 64 + fo;
#pragma unroll
            for (int e = 0; e < 8; ++e) { x0[e] *= rstd * gk[e]; x1[e] *= rstd * gk[32 + e]; }
            if (lane < 16) {
            if (!lat) { float* o = F.out + O_GK + orow * 256 + kh * 128 + ax * 64 + fo; *(f32x4*)o = (f32x4){x0[0], x0[1], x0[2], x0[3]}; *(f32x4*)(o + 4) = (f32x4){x0[4], x0[5], x0[6], x0[7]};
                        *(f32x4*)(o + 32) = (f32x4){x1[0], x1[1], x1[2], x1[3]}; *(f32x4*)(o + 36) = (f32x4){x1[4], x1[5], x1[6], x1[7]}; }
            else {
#pragma unroll
                for (int e = 0; e < 8; ++e) { const float2 cs = tp[e]; const float a = x0[e], b = x1[e]; x0[e] = a * cs.x - b * cs.y; x1[e] = a * cs.y + b * cs.x; } }
            bf16* k = KG + kr * 256 + kh * 128 + ax * 64 + fo; *(u32x4*)k = pack8f(x0); *(u32x4*)(k + 32) = pack8f(x1); } }
          if (lane < 32) { *(u32x4*)(VG + kr * 256 + 8 * lane) = ldv;
            if (!lat) { float x[8]; unpack8(ldv, x); float* o = F.out + O_GV + orow * 256 + 8 * lane; *(f32x4*)o = (f32x4){x[0], x[1], x[2], x[3]}; *(f32x4*)(o + 4) = (f32x4){x[4], x[5], x[6], x[7]}; } }
        }
        { float x[8]; unpack8(ldqd, x); float ss = 0.f;
#pragma unroll
          for (int e = 0; e < 8; ++e) ss += x[e] * x[e];
          const float rstd = rsqrtf(wave_sum(ss) * (1.0f / 512.0f) + EPS); const float* g = F.in[I_MQNG] + layer * 512 + 8 * lane;
#pragma unroll
          for (int e = 0; e < 8; ++e) x[e] *= rstd * g[e];
          *(u32x4*)(AQ + (size_t)m * 512 + 8 * lane) = pack8f(x); }
        { float x[8]; float ss = 0.f; unpack8(ldck, x);
          if (lane < 32) {
#pragma unroll
            for (int e = 0; e < 8; ++e) ss += x[e] * x[e]; }
          ss = wave_sum(ss);
          if (lane < 32) { const float rstd = rsqrtf(ss * (1.0f / 256.0f) + EPS); const float* g = F.in[I_MKVNG] + layer * 256 + 8 * lane;
#pragma unroll
            for (int e = 0; e < 8; ++e) x[e] *= rstd * g[e];
            *(u32x4*)(ACKV + kr * 256 + 8 * lane) = pack8f(x);
            if (!lat) { float* o = F.out + O_CKV + orow * 256 + 8 * lane; *(f32x4*)o = (f32x4){x[0], x[1], x[2], x[3]}; *(f32x4*)(o + 4) = (f32x4){x[4], x[5], x[6], x[7]}; } }
          if (lane < 4) { float x0[8], x1[8]; unpack8(ldp0, x0); unpack8(ldp1, x1);
            if (!lat) { float* o = F.out + O_KPE + orow * 64 + axp * 32 + fop; *(f32x4*)o = (f32x4){x0[0], x0[1], x0[2], x0[3]}; *(f32x4*)(o + 4) = (f32x4){x0[4], x0[5], x0[6], x0[7]};
                        *(f32x4*)(o + 16) = (f32x4){x1[0], x1[1], x1[2], x1[3]}; *(f32x4*)(o + 20) = (f32x4){x1[4], x1[5], x1[6], x1[7]}; }
            else { const float2* tp = tC + (axp ? colpos : rowpos) * 16 + fop;
#pragma unroll
                for (int e = 0; e < 8; ++e) { const float2 cs = tp[e]; const float a = x0[e], b = x1[e]; x0[e] = a * cs.x - b * cs.y; x1[e] = a * cs.y + b * cs.x; } }
            const u32x4 w0 = pack8f(x0), w1 = pack8f(x1);
#pragma unroll
            for (int hh = 0; hh < 8; ++hh) { bf16* k = KM + kr * 1536 + hh * 192 + 128 + axp * 32 + fop; *(u32x4*)k = w0; *(u32x4*)(k + 16) = w1; } }
        }
        { const float* cw = F.in[I_CONVW] + (size_t)layer * 5 * 1536; const float* cb = F.in[I_CONVB] + layer * 1536;
#pragma unroll
          for (int i = 0; i < 3; ++i) { const int ch = 8 * lane + 512 * i; float acc[8];
            { const f32x4 b0 = *(const f32x4*)(cb + ch), b1 = *(const f32x4*)(cb + ch + 4); acc[0] = b0[0]; acc[1] = b0[1]; acc[2] = b0[2]; acc[3] = b0[3]; acc[4] = b1[0]; acc[5] = b1[1]; acc[6] = b1[2]; acc[7] = b1[3]; }
#pragma unroll
            for (int k = 0; k < 5; ++k) { float x[8]; unpack8(ldc[i][k], x);
                const f32x4 w0 = *(const f32x4*)(cw + k * 1536 + ch), w1 = *(const f32x4*)(cw + k * 1536 + ch + 4);
                acc[0] += w0[0] * x[0]; acc[1] += w0[1] * x[1]; acc[2] += w0[2] * x[2]; acc[3] += w0[3] * x[3]; acc[4] += w1[0] * x[4]; acc[5] += w1[1] * x[5]; acc[6] += w1[2] * x[6]; acc[7] += w1[3] * x[7]; }
#pragma unroll
            for (int e = 0; e < 8; ++e) acc[e] = acc[e] * sigm(acc[e]);
            *(u32x4*)(XBC + (size_t)m * 1536 + ch) = pack8f(acc); }
          if (lane < 32) { const float raw = __uint_as_float((unsigned)lddt << 16) + F.in[I_DTB][layer * 32 + lane]; const float ey = __expf(raw); DT[(size_t)m * 32 + lane] = raw > 20.f ? raw : (ey < 1e-3f ? ey * (1.0f - 0.5f * ey) : __logf(1.0f + ey)); }
        }
    }
    { LAS unsigned char* wl = F.lds + F.wave * s5::WAVE_LDS; float* S5E = (float*)(F.ws + WS_S5E);
      for (int e = F.gw; e < 4096; e += F.NGW) { const int b = e >> 10, seg = (e >> 7) & 7, g = (e >> 1) & 63, dir = e & 1;
        s5::Ctx c; s5::load_ctx(c, F.ws + WS_S5C + (size_t)((layer * 2 + dir) * 64 + g) * s5::CD_BYTES, nullptr, lane, false);
        float hr = 0.f, hi = 0.f;
        s5::s5_epass(c, wl, lane, dir, PROJ + (size_t)(MCTX + b * 2048 + seg * 256) * NIN + C_S5U + g * 16, NIN, hr, hi);
        float* eo = S5E + ((((size_t)b * 8 + seg) * 64 + g) * 2 + dir) * 128; eo[lane] = hr; eo[64 + lane] = hi; } }
}
__device__ __forceinline__ void phase_ssd_finish(Frame& F, int layer) {
    const bf16* PROJ = (const bf16*)(F.ws + WS_PROJ); const bf16* XBC = (const bf16*)(F.ws + WS_XBC); const bf16* YF = (const bf16*)(F.ws + WS_YF); const bf16* YB = (const bf16*)(F.ws + WS_YB);
    bf16* OB = (bf16*)(F.ws + WS_O) + (size_t)1 * MROWS * 1024; const int lane = F.lane;
    const float dh = F.in[I_SSDD][layer * 16 + (lane >> 2)]; const float* g = F.in[I_SSDNG] + layer * 1024 + 16 * lane;
    for (int m = F.gw; m < MROWS; m += F.NGW) {
        float x[16], z[16], y[16]; unpack8(*(const u32x4*)(XBC + (size_t)m * 1536 + 16 * lane), x); unpack8(*(const u32x4*)(XBC + (size_t)m * 1536 + 16 * lane + 8), x + 8);
        unpack8(*(const u32x4*)(PROJ + (size_t)m * NIN + C_SZ + 16 * lane), z); unpack8(*(const u32x4*)(PROJ + (size_t)m * NIN + C_SZ + 16 * lane + 8), z + 8);
        float ss = 0.f; float yf[16], yb[16];
        unpack8(*(const u32x4*)(YF + (size_t)m * 1024 + 16 * lane), yf); unpack8(*(const u32x4*)(YF + (size_t)m * 1024 + 16 * lane + 8), yf + 8);
        unpack8(*(const u32x4*)(YB + (size_t)m * 1024 + 16 * lane), yb); unpack8(*(const u32x4*)(YB + (size_t)m * 1024 + 16 * lane + 8), yb + 8);
#pragma unroll
        for (int i = 0; i < 16; ++i) { const float v = (yf[i] + yb[i] + dh * x[i]) * (z[i] * sigm(z[i])); y[i] = v; ss += v * v; }
        const float rstd = rsqrtf(wave_sum(ss) * (1.0f / 1024.0f) + EPS);
#pragma unroll
        for (int i = 0; i < 16; ++i) y[i] *= rstd * g[i];
        *(u32x4*)(OB + (size_t)m * 1024 + 16 * lane) = pack8f(y); *(u32x4*)(OB + (size_t)m * 1024 + 16 * lane + 8) = pack8f(y + 8);
    }
}
struct ConvItem { const float* src; bf16* dst; int K, N, mode, half, k0, n0; };
typedef float cvf4 __attribute__((ext_vector_type(4)));
__device__ __forceinline__ const float* conv_ptr(const ConvItem& c, int lane) { const int n4 = c.n0 + 4 * (lane & 15); return c.src + (size_t)(c.k0 + 8 * (lane >> 4)) * c.N + (n4 < c.N ? n4 : c.N - 4); }
__device__ __forceinline__ void conv_load1(const float* p, size_t N, int i, float (&w)[32]) { const cvf4 v = *(const cvf4*)(p + (size_t)i * N); w[4 * i] = v[0]; w[4 * i + 1] = v[1]; w[4 * i + 2] = v[2]; w[4 * i + 3] = v[3]; }
__device__ __forceinline__ void conv_load(const ConvItem& c, int lane, float (&w)[32]) {
    const float* p = conv_ptr(c, lane);
#pragma unroll
    for (int i = 0; i < 8; ++i) conv_load1(p, (size_t)c.N, i, w);
}
__device__ __forceinline__ void conv_store(const ConvItem& c, int lane, const float (&w)[32]) {
    const int n4 = c.n0 + 4 * (lane & 15);
    if (n4 < c.N) {
#pragma unroll
        for (int j = 0; j < 4; ++j) { const int n = n4 + j; const int row = c.mode == 0 ? n : (c.mode == 1 ? map_in(n) : map_pair(n, c.half)); bf16* d = c.dst + (size_t)row * c.K + c.k0 + 8 * (lane >> 4);
            u32x4 o; o.x = pk2(w[j], w[4 + j]); o.y = pk2(w[8 + j], w[12 + j]); o.z = pk2(w[16 + j], w[20 + j]); o.w = pk2(w[24 + j], w[28 + j]); *(u32x4*)d = o; } }
}
constexpr int CV_A0 = 64 * 176, CV_A1 = CV_A0 + 176 * 32, CV_A2 = CV_A1 + 64 * 32, CV_A3 = CV_A2 + 4 * 32 * 32, CV_A4 = CV_A3 + 32 * 32;
constexpr int CV_B0 = 64 * 222, CV_B1 = CV_B0 + 16 * 24, CV_B2 = CV_B1 + 8 * 32;
__device__ __forceinline__ ConvItem conv_decode(int set, int it, int layer, const float* const* in, unsigned char* ws) {
    ConvItem c; char* WB = (char*)(ws + WS_W);
    if (set == 0) {
        if (it < CV_A0) { c.src = in[I_WFI] + (size_t)layer * 2048 * 11264; c.dst = (bf16*)(WB + W_FI); c.K = 2048; c.N = 11264; c.mode = 2; c.half = 5632; c.k0 = 32 * (it / 176); c.n0 = 64 * (it % 176); }
        else if (it < CV_A1) { const int r = it - CV_A0; c.src = in[I_WFO] + (size_t)layer * 5632 * 2048; c.dst = (bf16*)(WB + W_FO); c.K = 5632; c.N = 2048; c.mode = 0; c.half = 0; c.k0 = 32 * (r / 32); c.n0 = 64 * (r % 32); }
        else if (it < CV_A2) { const int r = it - CV_A1; c.src = in[I_WOUT] + (size_t)layer * 2048 * 2048; c.dst = (bf16*)(WB + W_OUT); c.K = 2048; c.N = 2048; c.mode = 0; c.half = 0; c.k0 = 32 * (r / 32); c.n0 = 64 * (r % 32); }
        else if (it < CV_A3) { const int r = it - CV_A2, br = r >> 10, q = r & 1023; c.src = in[I_WBR] + ((size_t)layer * 4 + br) * 1024 * 2048; c.dst = (bf16*)(WB + W_BR) + (size_t)br * 2048 * 1024; c.K = 1024; c.N = 2048; c.mode = 0; c.half = 0; c.k0 = 32 * (q / 32); c.n0 = 64 * (q % 32); }
        else { const int r = it - CV_A3; c.src = in[I_WGLU] + (size_t)layer * 1024 * 2048; c.dst = (bf16*)(WB + W_GLU); c.K = 1024; c.N = 2048; c.mode = 2; c.half = 1024; c.k0 = 32 * (r / 32); c.n0 = 64 * (r % 32); }
    } else {
        if (it < CV_B0) { c.src = in[I_WIN] + (size_t)layer * 2048 * 14176; c.dst = (bf16*)(WB + W_IN); c.K = 2048; c.N = 14176; c.mode = 1; c.half = 0; c.k0 = 32 * (it / 222); c.n0 = 64 * (it % 222); }
        else if (it < CV_B1) { const int r = it - CV_B0; c.src = in[I_WUQ] + (size_t)layer * 512 * 1536; c.dst = (bf16*)(WB + W_UQ); c.K = 512; c.N = 1536; c.mode = 0; c.half = 0; c.k0 = 32 * (r / 24); c.n0 = 64 * (r % 24); }
        else { const int r = it - CV_B1; c.src = in[I_WUKV] + (size_t)layer * 256 * 2048; c.dst = (bf16*)(WB + W_UKV); c.K = 256; c.N = 2048; c.mode = 0; c.half = 0; c.k0 = 32 * (r / 32); c.n0 = 64 * (r % 32); }
    }
    return c;
}
__device__ __forceinline__ void conv_run(int set, int layer, int first, int stride, const float* const* in, unsigned char* ws, int lane) {
    const int total = set == 0 ? CV_A4 : CV_B2;
    for (int it = first; it < total; it += stride) { const ConvItem c = conv_decode(set, it, layer, in, ws); float w[32]; conv_load(c, lane, w); conv_store(c, lane, w); }
}
struct AttnConv {
    const float* const* in; unsigned char* ws; int layer, gw, NGW, total, cnt, lane;
    ConvItem c; bool on;
    __device__ __forceinline__ void begin(float (&w)[32]) {
        const int it = cnt * NGW + gw; on = it < total;
        if (on) { ++cnt; c = it < CV_A4 ? conv_decode(0, it, layer, in, ws) : conv_decode(1, it - CV_A4, layer + 1, in, ws); conv_load(c, lane, w); }
    }
    __device__ __forceinline__ void end(const float (&w)[32]) { if (on) { conv_store(c, lane, w); on = false; } }
    __device__ __forceinline__ bool pending() const { return on; }
    static constexpr bool RIDES = true;
    __device__ __forceinline__ void decode() { const int it = cnt * NGW + gw; on = it < total; const int ic = on ? it : total - 1; cnt += on ? 1 : 0; c = ic < CV_A4 ? conv_decode(0, ic, layer, in, ws) : conv_decode(1, ic - CV_A4, layer + 1, in, ws); }
    __device__ __forceinline__ void part(float (&w)[32], int i) { conv_load1(conv_ptr(c, lane), (size_t)c.N, i, w); }
    __device__ __forceinline__ void rest(float (&w)[32]) { const float* p = conv_ptr(c, lane);
#pragma unroll
        for (int i = 4; i < 8; ++i) conv_load1(p, (size_t)c.N, i, w); }
    __device__ __forceinline__ void finish() { for (int it = cnt * NGW + gw; it < total; it += NGW) { const ConvItem ci = it < CV_A4 ? conv_decode(0, it, layer, in, ws) : conv_decode(1, it - CV_A4, layer + 1, in, ws); float w[32]; conv_load(ci, lane, w); conv_store(ci, lane, w); } }
};
struct NoConv { static constexpr bool RIDES = false; __device__ __forceinline__ void begin(float (&)[32]) {} __device__ __forceinline__ void end(const float (&)[32]) {} __device__ __forceinline__ bool pending() const { return false; }
    __device__ __forceinline__ void decode() {} __device__ __forceinline__ void part(float (&)[32], int) {} __device__ __forceinline__ void rest(float (&)[32]) {} };
template <class Epi> struct EpiConv {
    static constexpr bool PERM = Epi::PERM, AFTER_DRAIN = false;
    Epi e; const float* const* in; unsigned char* ws; int layer, set, gw, NGW, total, first; mutable int cnt;
    __device__ __forceinline__ bool keep(const pg8::Unit& u) const { return e.keep(u); }
    template <class ACC> __device__ __forceinline__ void operator()(ACC& acc, const pg8::Unit& u, int wr, int wc, int fr, int fq) const {
        const int it = first + cnt * NGW + gw; ++cnt; const bool on = it < total; const int lane = threadIdx.x & 63;
        ConvItem c; float w[32];
        if (on) { c = conv_decode(set, it, layer, in, ws); conv_load(c, lane, w); }
        e(acc, u, wr, wc, fr, fq);
        if (on) conv_store(c, lane, w);
    }
};
#define XB_TMO      128
#define XB_XCNT(j)  (256  + 64 * (j))
#define XB_XSUB(j)  (1280 + 64 * (j))
#define XB_XGEN(j)  (2304 + 64 * (j))
#define XB_TOP      3328
#define XB_TOPGEN   3392
#define XCD_BAR_WORDS 3456
#define XB_SPIN_CAP (1u << 18)

__device__ __forceinline__ unsigned xb_ld(unsigned* p)              { return __hip_atomic_load(p, __ATOMIC_RELAXED, __HIP_MEMORY_SCOPE_AGENT); }
__device__ __forceinline__ unsigned xb_add(unsigned* p, unsigned v) { return __hip_atomic_fetch_add(p, v, __ATOMIC_RELAXED, __HIP_MEMORY_SCOPE_AGENT); }
__device__ __forceinline__ unsigned xb_xcc_id() { return (unsigned)__builtin_amdgcn_s_getreg((3 << 11) | 20) & 0xFu; }
#define XB_SPIN(cond, bar) do { unsigned _sp = 0; while (cond) { __builtin_amdgcn_s_sleep(1); \
    if ((++_sp & 255u) == 0u) { if (xb_ld(&(bar)[XB_TMO])) break; if (_sp > XB_SPIN_CAP) { atomicAdd(&(bar)[XB_TMO], 1u); break; } } } } while (0)

struct XcdBarrier {
    unsigned* bar; unsigned x;
    volatile LAS unsigned* st;
};

__device__ __forceinline__ XcdBarrier xcd_barrier_post(unsigned* bar, volatile LAS unsigned* st) {
    XcdBarrier b; b.bar = bar; b.x = xb_xcc_id(); b.st = st;
    if (threadIdx.x == 0) (void)xb_add(&bar[XB_XCNT(b.x)], 1u);
    return b;
}
__device__ __forceinline__ void xcd_barrier_complete(unsigned* bar, unsigned x, unsigned& nloc, unsigned& nx) {
    const unsigned G = gridDim.x * gridDim.y * gridDim.z;
    unsigned sum, cnt, mine, sp = 0u;
    for (;;) {
        sum = 0u; cnt = 0u; mine = 0u;
#pragma unroll
        for (unsigned j = 0; j < 16; ++j) { const unsigned c = xb_ld(&bar[XB_XCNT(j)]); sum += c; cnt += (c > 0u) ? 1u : 0u; mine = (j == x) ? c : mine; }
        if (sum == G) break;
        __builtin_amdgcn_s_sleep(1);
        if ((++sp & 255u) == 0u) { if (xb_ld(&bar[XB_TMO])) break; if (sp > XB_SPIN_CAP) { atomicAdd(&bar[XB_TMO], 1u); break; } }
    }
    nloc = mine > 0u ? mine : 1u; nx = cnt > 0u ? cnt : 1u;
}

__device__ __forceinline__ void xcd_barrier(const XcdBarrier& b) {
    asm volatile("s_waitcnt vmcnt(0)" ::: "memory");
    __syncthreads();
    if (threadIdx.x == 0) {
        unsigned* bar = b.bar;
        __builtin_amdgcn_s_waitcnt(0);
        unsigned nloc = b.st[0], nx = b.st[1];
        if (nloc == 0u) { xcd_barrier_complete(bar, b.x, nloc, nx); b.st[0] = nloc; b.st[1] = nx; }
        const unsigned old = xb_add(&bar[XB_XSUB(b.x)], 1u);
        const unsigned gen = old / nloc;
        if (old + 1u == (gen + 1u) * nloc) {
            __builtin_amdgcn_fence(__ATOMIC_RELEASE, "agent");
            asm volatile("s_waitcnt vmcnt(0)" ::: "memory");
            const unsigned og = xb_add(&bar[XB_TOP], 1u);
            const unsigned tg = og / nx;
            if (og + 1u == (tg + 1u) * nx) xb_add(&bar[XB_TOPGEN], 1u);
            else XB_SPIN(xb_ld(&bar[XB_TOPGEN]) == tg, bar);
            __builtin_amdgcn_fence(__ATOMIC_ACQUIRE, "agent");
            xb_add(&bar[XB_XGEN(b.x)], 1u);
            asm volatile("s_waitcnt vmcnt(0)" ::: "memory");
        } else {
            XB_SPIN(xb_ld(&bar[XB_XGEN(b.x)]) == gen, bar);
            __builtin_amdgcn_fence(__ATOMIC_ACQUIRE, "agent");
            asm volatile("s_waitcnt vmcnt(0)" ::: "memory");
        }
    }
    __syncthreads();
}
#ifndef MLA_SDEPTH
#define MLA_SDEPTH 1
#endif
constexpr int NPHASE = 42;
#ifndef MK_N_LAUNCHES
#define MK_N_LAUNCHES 1
#endif
__device__ __forceinline__ void run_attn_gqa(Frame& F, int layer) {
    AttnConv cv; cv.in = F.in; cv.ws = F.ws; cv.layer = layer; cv.gw = F.gw; cv.NGW = F.NGW; cv.total = CV_A4 + (layer + 1 < NLAYER ? CV_B0 : 0); cv.cnt = 0; cv.lane = F.lane; cv.on = false;
    const bf16* Q = (const bf16*)(F.ws + WS_Q); const bf16* KG = (const bf16*)(F.ws + WS_KG); const bf16* VG = (const bf16*)(F.ws + WS_VG); bf16* OA = (bf16*)(F.ws + WS_O);
    for (int u = F.bid; u < 512; u += F.G) {
        size_t qrow, krow; int hq, seq;
        if (u < 256) { const int b = u >> 6, qb = u & 7; hq = (u >> 3) & 7; qrow = MCTX + (size_t)b * 2048 + qb * 256; krow = MCTX + (size_t)b * 2560; seq = 2560; }
        else { const int v = u - 256, b = v >> 3; hq = v & 7; qrow = (size_t)b * 256; krow = qrow; seq = 256; }
        att::attn_body_simple<128, 1024, 256, 256, 1024>(Q + qrow * 1024 + hq * 128, KG + krow * 256 + (hq >> 2) * 128, VG + krow * 256 + (hq >> 2) * 128, OA + qrow * 1024 + hq * 128, seq, (char*)F.lds, cv);
    }
    cv.finish();
}
__device__ __forceinline__ void run_attn_mla(Frame& F) {
    const bf16* QM = (const bf16*)(F.ws + WS_QM); const bf16* KM = (const bf16*)(F.ws + WS_KM); const bf16* VM = (const bf16*)(F.ws + WS_VM); bf16* OC = (bf16*)(F.ws + WS_O) + (size_t)2 * MROWS * 1024;
    for (int u = F.bid; u < 512; u += F.G) {
        size_t qrow, krow; int hq, seq;
        if (u < 256) { const int b = u >> 6, qb = u & 7; hq = (u >> 3) & 7; qrow = MCTX + (size_t)b * 2048 + qb * 256; krow = MCTX + (size_t)b * 2560; seq = 2560; }
        else { const int v = u - 256, b = v >> 3; hq = v & 7; qrow = (size_t)b * 256; krow = qrow; seq = 256; }
        NoConv nc; att::attn_body_simple<192, 1536, 1536, 1024, 1024>(QM + qrow * 1536 + hq * 192, KM + krow * 1536 + hq * 192, VM + krow * 1024 + hq * 128, OC + qrow * 1024 + hq * 128, seq, (char*)F.lds, nc);
    }
}
__device__ __forceinline__ void run_ssd(Frame& F, int layer) {
    const bf16* XBC = (const bf16*)(F.ws + WS_XBC); const float* DT = (const float*)(F.ws + WS_DT); bf16* YF = (bf16*)(F.ws + WS_YF); bf16* YB = (bf16*)(F.ws + WS_YB);
    for (int u = F.bid; u < 128; u += F.G) { const int b = u >> 5, h = (u >> 1) & 15, dir = u & 1;
        const float a_h = -expf(F.in[I_ALOG][(layer * 2 + dir) * 16 + h]);
        ssd::ssd_unit(F.lds, XBC, DT, dir ? YB : YF, MCTX + b * 2048, 16, h, dir, a_h, F.in[I_SSSD] + ((((size_t)b * 4 + layer) * 2 + dir) * 16 + h) * 8192, nullptr); }
    const int c0 = F.G > 128 ? F.bid - 128 : F.bid, cs = F.G > 128 ? F.G - 128 : F.G;
    if (c0 >= 0) for (int v = c0; v < 1024; v += cs) { const int b = v >> 5, h = (v >> 1) & 15, dir = v & 1;
        const float a_h = -expf(F.in[I_ALOG][(layer * 2 + dir) * 16 + h]);
        ssd::ssd_unit(F.lds, XBC, DT, dir ? YB : YF, b * 256, 2, h, dir, a_h, nullptr, F.out + O_SSD + ((((size_t)b * 4 + layer) * 2 + dir) * 16 + h) * 8192); }
}
__device__ __forceinline__ void s5_entry_state(Frame& F, const unsigned char* cd, const float* S5E, int b, int seg, int g, int layer, int dir, int lane, float& hr, float& hi) {
    const float* h0 = F.in[I_SS5] + ((((size_t)b * 4 + layer) * 2 + dir) * 2) * 4096 + g * 64; hr = h0[lane]; hi = h0[4096 + lane];
    const float zr = ((const float*)cd)[128 + lane], zi = ((const float*)cd)[192 + lane];
    const int n = dir ? 7 - seg : seg;
    float er[7], ei[7];
#pragma unroll
    for (int q = 0; q < 7; ++q) { const int qq = q < n ? q : 0; const int sp = dir ? 7 - qq : qq; const float* e = S5E + ((((size_t)b * 8 + sp) * 64 + g) * 2 + dir) * 128; er[q] = e[lane]; ei[q] = e[64 + lane]; }
#pragma unroll
    for (int q = 0; q < 7; ++q) { const float nr = zr * hr - zi * hi + er[q], ni = zr * hi + zi * hr + ei[q]; if (q < n) { hr = nr; hi = ni; } }
}
__device__ __forceinline__ void run_s5(Frame& F, int layer) {
    const bf16* PROJ = (const bf16*)(F.ws + WS_PROJ); bf16* S5PRE = (bf16*)(F.ws + WS_S5PRE); const float* S5E = (const float*)(F.ws + WS_S5E);
    LAS unsigned char* wl = F.lds + F.wave * s5::WAVE_LDS;
    for (int u = F.gw; u < 4096; u += F.NGW) {
        int lane_ = F.lane; asm volatile("" : "+v"(lane_)); const int lane = lane_;
        const int s = u >> 6, g = u & 63; const bool lat = s >= 32; const int b = lat ? (s - 32) >> 3 : s, seg = lat ? (s - 32) & 7 : 0;
        const size_t row0 = lat ? MCTX + (size_t)b * 2048 + seg * 256 : (size_t)b * 256;
        const unsigned char* cd0 = F.ws + WS_S5C + (size_t)((layer * 2 + 0) * 64 + g) * s5::CD_BYTES; const unsigned char* cd1 = cd0 + 64 * s5::CD_BYTES; const unsigned char* cg = F.ws + WS_S5G + ((size_t)layer * 64 + g) * s5::CG_BYTES;
        const bf16* U = PROJ + row0 * NIN + C_S5U + g * 16; bf16* outp = S5PRE + row0 * 1024 + g * 16;
        const float dch = F.in[I_S5D][layer * 1024 + g * 16 + (lane & 15)];
        s5::Ctx c;
        float hfr = 0.f, hfi = 0.f, hbr = 0.f, hbi = 0.f;
        if (lat) { s5_entry_state(F, cd0, S5E, b, seg, g, layer, 0, lane, hfr, hfi); s5_entry_state(F, cd1, S5E, b, seg, g, layer, 1, lane, hbr, hbi); }
        { s5::load_ctx(c, cd0, cg, lane, true);
          s5::s5_pass<false>(c, wl, lane, 0, U, NIN, outp, dch, hfr, hfi);
          if (!lat) { float* ho = F.out + O_S5 + ((((size_t)b * 4 + layer) * 2 + 0) * 2) * 4096 + g * 64; ho[lane] = hfr; ho[4096 + lane] = hfi; } }
        { s5::load_ctx(c, cd1, cg, lane, false);
          s5::s5_pass<true>(c, wl, lane, 1, U, NIN, outp, dch, hbr, hbi);
          if (!lat) { float* ho = F.out + O_S5 + ((((size_t)b * 4 + layer) * 2 + 1) * 2) * 4096 + g * 64; ho[lane] = hbr; ho[4096 + lane] = hbi; } }
    }
}
__device__ __forceinline__ bool launder(Frame& F) {
    asm volatile("" : "+v"(F.tid), "+v"(F.lane)); return true; }
__global__ void __launch_bounds__(NTHREADS, 2) skel_fwd(Args args) {
    extern __shared__ __attribute__((aligned(16))) unsigned char lds_raw[];
    Frame F;
    F.lds = (LAS unsigned char*)lds_raw;
    F.tid = threadIdx.x; F.lane = F.tid & 63; F.wave = __builtin_amdgcn_readfirstlane(F.tid >> 6);
    F.G = gridDim.x; F.bid = blockIdx.x; F.gw = F.bid * NWAVES + F.wave; F.NGW = F.G * NWAVES;
    F.in0 = args.in; F.out0 = args.out; F.ws0 = args.ws; F.in = F.in0; F.out = F.out0; F.ws = F.ws0;
    for (int u = F.tid; u < (LDS_BYTES - LDSCTL_OFF) / 4; u += NTHREADS) ((LAS unsigned*)(F.lds + LDSCTL_OFF))[u] = 0u;
    __syncthreads();
    const int lo = args.ph_lo, hi = args.ph_hi;
    unsigned* barw = (unsigned*)(F.ws + WS_CTL) + CW_BAR + args.li * XCD_BAR_WORDS;
    XcdBarrier bar; bar.bar = barw; bar.x = 0; bar.st = nullptr;
    if (hi - lo > 1) bar = xcd_barrier_post(barw, (volatile LAS unsigned*)(F.lds + MISC_OFF) + 8);
#ifndef SUB_MASK
#define SUB_MASK 0xffu
#endif
#define SUBON(b) (((SUB_MASK) >> (b)) & 1u)
#ifndef REP_MASK
#define REP_MASK 0u
#endif
#define REP(b) for (int rep_ = 0; rep_ < 1 + (int)(((REP_MASK) >> (b)) & 1u); ++rep_)
#ifndef PH_MASK
#define PH_MASK 0xffffffffu
#endif
#define IN(k) (lo <= (k) && (k) < hi)
#define INJ(j) ((((PH_MASK) >> (j)) & 1u) && IN(pb + (j)) && launder(F))
#define SEAM(k) do { if (IN(k) && IN((k) + 1)) xcd_barrier(bar); } while (0)
    bf16* WB = (bf16*)(F.ws + WS_W);
    bf16* const Win = (bf16*)((char*)WB + W_IN); bf16* const Wuq = (bf16*)((char*)WB + W_UQ); bf16* const Wukv = (bf16*)((char*)WB + W_UKV); bf16* const Wglu = (bf16*)((char*)WB + W_GLU);
    bf16* const Wbr = (bf16*)((char*)WB + W_BR); bf16* const Wout = (bf16*)((char*)WB + W_OUT); bf16* const Wfi = (bf16*)((char*)WB + W_FI); bf16* const Wfo = (bf16*)((char*)WB + W_FO);
    bf16* const H = (bf16*)(F.ws + WS_H); bf16* const PROJ = (bf16*)(F.ws + WS_PROJ); float* const X = (float*)(F.ws + WS_X);

    if (((PH_MASK >> 11) & 1u) && IN(0)) { phase_prologue(F); conv_run(1, 0, F.gw, F.NGW, F.in, F.ws, F.lane); phase_zero_pad(F); } SEAM(0);
    for (int layer = 0; layer < NLAYER; ++layer) {
        const int pb = 1 + 10 * layer; const float* MODL = (const float*)(F.ws + WS_MOD) + (size_t)layer * 5 * 12288;
        if (INJ(0)) { REP(9) phase_norm(F, layer, 0, layer == 0); } SEAM(pb + 0);
        if (INJ(1)) { pg8::Gemm g{H, Win, MROWS, NIN, 2048}; pg8::StaticOrder S; S.init(MROWS, NIN, F.G, F.bid);
            pg8::EpiInProj E{PROJ, NIN, 32};
            pg8::gemm_phase<pg8::EpiInProj, pg8::StaticOrder, true, true>(F.lds, g, S, E); } SEAM(pb + 1);
        if (INJ(2)) { REP(10) phase_prep(F, layer); } SEAM(pb + 2);
        if (INJ(3)) {
            if (SUBON(0)) { pg8::Gemm g{(bf16*)(F.ws + WS_AQ), Wuq, MROWS, 1536, 512}; pg8::StaticOrder S; S.init(MROWS, 1536, F.G, F.bid); pg8::EpiMlaQ E{(bf16*)(F.ws + WS_QM), (const float2*)(F.ws + WS_TAB) + 64 * 32};
              REP(15) pg8::gemm_phase<pg8::EpiMlaQ, pg8::StaticOrder, true, true>(F.lds, g, S, E); }
            if (SUBON(1)) { pg8::Gemm g{(bf16*)(F.ws + WS_ACKV), Wukv, KROWS, 2048, 256}; pg8::StaticOrder S; S.init(KROWS, 2048, F.G, (F.bid + (F.G >> 2)) % F.G  ); pg8::EpiMlaKV E{(bf16*)(F.ws + WS_KM), (bf16*)(F.ws + WS_VM)};
              REP(15) pg8::gemm_phase<pg8::EpiMlaKV, pg8::StaticOrder, true, true>(F.lds, g, S, E); }
            if (SUBON(2)) run_attn_gqa(F, layer);
            if (SUBON(3)) REP(3) run_ssd(F, layer);
            if (SUBON(4)) REP(4) run_s5(F, layer);
        } SEAM(pb + 3);
        if (INJ(4)) { if (SUBON(5)) REP(5) run_attn_mla(F); if (SUBON(6)) REP(6) phase_ssd_finish(F, layer);
            { pg8::Gemm g{(bf16*)(F.ws + WS_S5PRE), Wglu, MROWS, 2048, 1024}; pg8::StaticOrder S; S.init(MROWS, 2048, F.G, F.bid); pg8::EpiGated<0> E{(bf16*)(F.ws + WS_O) + (size_t)3 * MROWS * 1024, 1024};
              REP(15) pg8::gemm_phase<pg8::EpiGated<0>, pg8::StaticOrder, true, true>(F.lds, g, S, E); } } SEAM(pb + 4);
        if (INJ(5)) { pg8::Gemm g{(bf16*)(F.ws + WS_O), Wbr, 4 * MROWS, 4 * 2048, 1024}; pg8::BranchOrder S; S.so.init(MROWS, 2048, F.G, F.bid); pg8::EpiBranch E{PROJ, NIN, (bf16*)(F.ws + WS_GS)};
            REP(13) pg8::gemm_phase<pg8::EpiBranch, pg8::BranchOrder, true, true>(F.lds, g, S, E); } SEAM(pb + 5);
        if (INJ(6)) { pg8::Gemm g{(bf16*)(F.ws + WS_GS), Wout, MROWS, 2048, 2048}; pg8::StaticOrder S; S.init(MROWS, 2048, F.G, F.bid); pg8::EpiResid E{X, MODL, 4096, 1.0f};
            if ((REP_MASK >> 14) & 1u) { pg8::EpiResid E0{X, MODL, 4096, 0.0f}; pg8::gemm_phase<pg8::EpiResid, pg8::StaticOrder, true, true>(F.lds, g, S, E0); }
            pg8::gemm_phase<pg8::EpiResid, pg8::StaticOrder, true, true>(F.lds, g, S, E); } SEAM(pb + 6);
        if (INJ(7)) { REP(9) phase_norm(F, layer, 1, false); } SEAM(pb + 7);
        if (INJ(8)) { pg8::Gemm g{H, Wfi, MROWS, 11264, 2048}; pg8::StaticOrder S; S.init(MROWS, 11264, F.G, F.bid);
            EpiConv<pg8::EpiGated<1>> E{pg8::EpiGated<1>{PROJ  , FFN}, F.in, F.ws, layer + 1, 1, F.gw, F.NGW, layer + 1 < NLAYER ? CV_B2 : 0, CV_B0, 0};
            pg8::gemm_phase<EpiConv<pg8::EpiGated<1>>, pg8::StaticOrder, true, true>(F.lds, g, S, E);
            if (layer + 1 < NLAYER) conv_run(1, layer + 1, CV_B0 + E.cnt * F.NGW + F.gw, F.NGW, F.in, F.ws, F.lane); } SEAM(pb + 8);
        if (INJ(9)) { pg8::Gemm g{PROJ, Wfo, MROWS, 2048, FFN}; pg8::StaticOrder S; S.init(MROWS, 2048, F.G, F.bid); pg8::EpiResid E{X, MODL, 10240, 1.0f};
            if ((REP_MASK >> 14) & 1u) { pg8::EpiResid E0{X, MODL, 10240, 0.0f}; pg8::gemm_phase<pg8::EpiResid, pg8::StaticOrder, true, true>(F.lds, g, S, E0); }
            pg8::gemm_phase<pg8::EpiResid, pg8::StaticOrder, true, true>(F.lds, g, S, E); } SEAM(pb + 9);
    }
    if (((PH_MASK >> 12) & 1u) && IN(41)) phase_final_norm(F);
#undef IN
#undef INJ
#undef SEAM
}

extern "C" void kernel_launch(void* const* d_in, const int* in_sizes, int n_in, void* d_out, int out_size, void* d_ws, size_t ws_size, hipStream_t stream) {
    static int grid = 0;
    if (grid == 0) {
        if (n_in != 41 || out_size != (int)O_TOTAL || ws_size < WS_END) { fprintf(stderr, "kernel_launch: expected 41 inputs, %zu outputs, >= %zu bytes of workspace; got n_in %d out %d ws %zu\n", (size_t)O_TOTAL, (size_t)WS_END, n_in, out_size, ws_size); grid = -1; return; }
        int dev = 0, cus = 0, per_cu = 0;
        if (hipGetDevice(&dev) != hipSuccess || hipDeviceGetAttribute(&cus, hipDeviceAttributeMultiprocessorCount, dev) != hipSuccess) { grid = -1; return; }
        if (hipFuncSetAttribute((const void*)skel_fwd, hipFuncAttributeMaxDynamicSharedMemorySize, LDS_BYTES) != hipSuccess) { fprintf(stderr, "kernel_launch: hipFuncSetAttribute failed\n"); grid = -1; return; }
        if (hipOccupancyMaxActiveBlocksPerMultiprocessor(&per_cu, (const void*)skel_fwd, NTHREADS, LDS_BYTES) != hipSuccess || per_cu < 1) fprintf(stderr, "kernel_launch: occupancy query reports %d\n", per_cu);
        (void)hipGetLastError();
        grid = cus;
    }
    if (grid < 0) return;
    if (hipMemsetAsync((char*)d_ws + WS_CTL, 0, CTL_ZERO_BYTES, stream) != hipSuccess) return;
    Args a{};
    for (int i = 0; i < 41; ++i) a.in[i] = (const float*)d_in[i];
    a.out = (float*)d_out; a.ws = (unsigned char*)d_ws;
    constexpr int NL = MK_N_LAUNCHES;
    for (int li = 0; li < NL; ++li) {
        a.li = li; a.ph_lo = (int)((long)NPHASE * li / NL); a.ph_hi = (int)((long)NPHASE * (li + 1) / NL);
        hipLaunchKernelGGL(skel_fwd, dim3(grid), dim3(NTHREADS), LDS_BYTES, stream, a);
        const hipError_t le = hipPeekAtLastError();
        if (le != hipSuccess) { fprintf(stderr, "kernel_launch: launch %d failed: %s\n", li, hipGetErrorName(le)); break; }
    }
}
```

```cpp
#include <hip/hip_runtime.h>
#include <cstdio>
#include <cstdint>
#include <cmath>
#define MK_N_LAUNCHES 1
#define REP_MASK 0u
namespace pg8 {
#define PG8_LAS __attribute__((address_space(3)))
typedef unsigned short bf16_t;
typedef short bf16x8 __attribute__((ext_vector_type(8)));
typedef float f32x4 __attribute__((ext_vector_type(4)));
typedef unsigned u32x4 __attribute__((ext_vector_type(4)));
constexpr int BM = 256, BK = 64, HALF = 128, HTB = HALF * BK * 2  , STAGE_BYTES = 8 * HTB, NXCD = 8, WGM = 8;

__host__ __device__ __forceinline__ int lds_byte(int r, int c) { const int st = (r >> 4) * 2 + (c >> 5), rr = r & 15, cc = c & 31, ob = rr * 64 + cc * 2; return st * 1024 + (ob ^ (((ob >> 9) & 1) << 5)); }
__host__ __device__ __forceinline__ void stage_rc(int b, int& R, int& C) { const int st = b / 1024, sb = b % 1024, swz = sb ^ (((sb >> 9) & 1) << 5); R = (st >> 1) * 16 + swz / 64; C = (st & 1) * 32 + (swz % 64) / 2; }
__host__ __device__ __forceinline__ int perm32(int rho) { const int n = rho >> 4, i = rho & 15; return 8 * (i >> 2) + 4 * n + (i & 3); }

struct Unit { int pm, pn; };
struct Gemm { const bf16_t* A; const bf16_t* Bt; int M, N, K; };

struct StaticOrder {
    int nM, nN, nwg, G, c;
    __host__ __device__ void init(int M, int N, int G_, int c_) { nM = M / BM; nN = N / BM; nwg = nM * nN; G = G_; c = c_; }
    __host__ __device__ bool next(int i, Unit& u) const {
        const long L = (long)i * G + c; if (L >= nwg) return false;
        int wgid = (int)L; { const int q = nwg / NXCD, r = nwg % NXCD, xcd = wgid % NXCD, off = wgid / NXCD; wgid = (xcd < r ? xcd * (q + 1) : r * (q + 1) + (xcd - r) * q) + off; }
        const int nig = WGM * nN, gid = wgid / nig, fm = gid * WGM, gsz = (nM - fm) < WGM ? (nM - fm) : WGM;
        u.pm = fm + ((wgid % nig) % gsz); u.pn = (wgid % nig) / gsz; return true;
    }
    __device__ __forceinline__ void a_ready(const Unit&) const {}
    __device__ __forceinline__ void done(const Unit&) const {}
};
__device__ __forceinline__ unsigned cvt_pk_bf16(float lo, float hi) { typedef float f32x2_t_ __attribute__((ext_vector_type(2))); typedef __bf16 bf16x2_t_ __attribute__((ext_vector_type(2))); const f32x2_t_ v_ = {lo, hi}; const bf16x2_t_ b_ = __builtin_convertvector(v_, bf16x2_t_); return __builtin_bit_cast(unsigned, b_); }
__device__ __forceinline__ float bf_lo(unsigned w) { return __uint_as_float(w << 16); }
__device__ __forceinline__ float bf_hi(unsigned w) { return __uint_as_float(w & 0xffff0000u); }
__device__ __forceinline__ float sigmoid_f(float x) { return __builtin_amdgcn_rcpf(1.0f + __expf(-x)); }
__device__ __forceinline__ u32x4 pack8(const f32x4 a, const f32x4 b) { u32x4 w; w.x = cvt_pk_bf16(a[0], a[1]); w.y = cvt_pk_bf16(a[2], a[3]); w.z = cvt_pk_bf16(b[0], b[1]); w.w = cvt_pk_bf16(b[2], b[3]); return w; }

struct EpiInProj {
    static constexpr bool PERM = true, AFTER_DRAIN = false;
    __device__ __forceinline__ bool keep(const Unit&) const { return false; }
    bf16_t* O; int ldc; int nsig;
    __device__ __forceinline__ void operator()(const f32x4 (&acc)[2][2][4][2], const Unit& u, int wr, int wc, int fr, int fq) const {
        const int row0 = u.pm * BM + wr * 64 + fr, col0 = u.pn * BM + wc * 32 + 8 * fq; const bool sg = u.pn < nsig;
#pragma unroll
        for (int ai = 0; ai < 2; ++ai)
#pragma unroll
            for (int m = 0; m < 4; ++m) { bf16_t* rowp = O + (size_t)(row0 + ai * HALF + m * 16) * ldc + col0;
#pragma unroll
                for (int bj = 0; bj < 2; ++bj) { f32x4 v0 = acc[ai][bj][m][0], v1 = acc[ai][bj][m][1];
                    if (sg) {
#pragma unroll
                        for (int j = 0; j < 4; ++j) { v0[j] = sigmoid_f(v0[j]); v1[j] = sigmoid_f(v1[j]); } }
                    *(u32x4*)(rowp + bj * HALF) = pack8(v0, v1); } }
    }
};
struct EpiMlaQ {
    static constexpr bool PERM = false, AFTER_DRAIN = false;
    __device__ __forceinline__ bool keep(const Unit&) const { return false; }
    bf16_t* O; const float2* tab;
    __device__ __forceinline__ void operator()(const f32x4 (&acc)[2][2][4][2], const Unit& u, int wr, int wc, int fr, int fq) const {
        const int row0 = u.pm * BM + wr * 64 + fr; const bool lat = u.pm >= 32;
#pragma unroll
        for (int bj = 0; bj < 2; ++bj) {
            const int cg = u.pn * BM + bj * HALF + wc * 32;
            const int w = cg % 192; const bool rp = lat && (w >= 128); const int axis = (w - 128) >> 5;
#pragma unroll
            for (int ai = 0; ai < 2; ++ai)
#pragma unroll
                for (int m = 0; m < 4; ++m) { const int row = row0 + ai * HALF + m * 16; f32x4 x0 = acc[ai][bj][m][0], x1 = acc[ai][bj][m][1];
                    if (rp) { const int t = (row - 8192) & 2047; const int pos = axis ? (t & 63) : (t >> 6); const float2* tp = tab + pos * 16 + 4 * fq;
#pragma unroll
                        for (int j = 0; j < 4; ++j) { const float2 cs = tp[j]; const float a = x0[j], b = x1[j]; x0[j] = a * cs.x - b * cs.y; x1[j] = a * cs.y + b * cs.x; } }
                    bf16_t* p = O + (size_t)row * 1536 + cg + 4 * fq;
                    uint2 w0; w0.x = cvt_pk_bf16(x0[0], x0[1]); w0.y = cvt_pk_bf16(x0[2], x0[3]); uint2 w1; w1.x = cvt_pk_bf16(x1[0], x1[1]); w1.y = cvt_pk_bf16(x1[2], x1[3]);
                    *(uint2*)p = w0; *(uint2*)(p + 16) = w1; } }
    }
};
struct EpiMlaKV {
    static constexpr bool PERM = true, AFTER_DRAIN = false;
    __device__ __forceinline__ bool keep(const Unit&) const { return false; }
    bf16_t* Km; bf16_t* Vm;
    __device__ __forceinline__ void operator()(const f32x4 (&acc)[2][2][4][2], const Unit& u, int wr, int wc, int fr, int fq) const {
        const int row0 = u.pm * BM + wr * 64 + fr, c0 = wc * 32 + 8 * fq;
#pragma unroll
        for (int ai = 0; ai < 2; ++ai)
#pragma unroll
            for (int m = 0; m < 4; ++m) { const size_t row = (size_t)(row0 + ai * HALF + m * 16);
                *(u32x4*)(Km + row * 1536 + u.pn * 192 + c0) = pack8(acc[ai][0][m][0], acc[ai][0][m][1]);
                *(u32x4*)(Vm + row * 1024 + u.pn * 128 + c0) = pack8(acc[ai][1][m][0], acc[ai][1][m][1]); }
    }
};
template <int MODE> struct EpiGated {
    static constexpr bool PERM = true, AFTER_DRAIN = false;
    __device__ __forceinline__ bool keep(const Unit&) const { return false; }
    bf16_t* O; int ldc;
    __device__ __forceinline__ void operator()(const f32x4 (&acc)[2][2][4][2], const Unit& u, int wr, int wc, int fr, int fq) const {
        const int row0 = u.pm * BM + wr * 64 + fr, col0 = u.pn * HALF + wc * 32 + 8 * fq;
#pragma unroll
        for (int ai = 0; ai < 2; ++ai)
#pragma unroll
            for (int m = 0; m < 4; ++m) { f32x4 o[2];
#pragma unroll
                for (int n = 0; n < 2; ++n)
#pragma unroll
                    for (int j = 0; j < 4; ++j) { const float a = acc[ai][0][m][n][j], b = acc[ai][1][m][n][j]; o[n][j] = MODE == 0 ? a * sigmoid_f(b) : a * sigmoid_f(a) * b; }
                *(u32x4*)(O + (size_t)(row0 + ai * HALF + m * 16) * ldc + col0) = pack8(o[0], o[1]); }
    }
};
struct EpiBranch {
    static constexpr bool PERM = true, AFTER_DRAIN = false;
    const bf16_t* G; int ldg; bf16_t* GS;
    __device__ __forceinline__ bool keep(const Unit& u) const { return (u.pm >> 6) < 3; }
    __device__ __forceinline__ void operator()(f32x4 (&acc)[2][2][4][2], const Unit& u, int wr, int wc, int fr, int fq) const {
        const int br = u.pm >> 6, pm = u.pm & 63, pn = u.pn & 7;
        const int row0 = pm * BM + wr * 64 + fr, col0 = pn * BM + wc * 32 + 8 * fq;
#pragma unroll
        for (int ai = 0; ai < 2; ++ai) {
            u32x4 gc[4][2], gn[4][2];
#pragma unroll
            for (int m = 0; m < 4; ++m)
#pragma unroll
                for (int bj = 0; bj < 2; ++bj) { const bf16_t* gp = G + (size_t)(row0 + ai * HALF + m * 16) * ldg + br * 2048 + col0 + bj * HALF; gc[m][bj] = *(const u32x4*)gp; if (br < 3) gn[m][bj] = *(const u32x4*)(gp + 2048); }
#pragma unroll
            for (int m = 0; m < 4; ++m)
#pragma unroll
                for (int bj = 0; bj < 2; ++bj) { float c[8], n[8]; const u32x4 a = gc[m][bj];
                    c[0] = bf_lo(a.x); c[1] = bf_hi(a.x); c[2] = bf_lo(a.y); c[3] = bf_hi(a.y); c[4] = bf_lo(a.z); c[5] = bf_hi(a.z); c[6] = bf_lo(a.w); c[7] = bf_hi(a.w);
                    if (br < 3) { const u32x4 b = gn[m][bj]; n[0] = bf_lo(b.x); n[1] = bf_hi(b.x); n[2] = bf_lo(b.y); n[3] = bf_hi(b.y); n[4] = bf_lo(b.z); n[5] = bf_hi(b.z); n[6] = bf_lo(b.w); n[7] = bf_hi(b.w); }
#pragma unroll
                    for (int j = 0; j < 8; ++j) { float f = fmaxf(c[j], 1e-6f); if (br < 3) f *= __builtin_amdgcn_rcpf(fmaxf(n[j], 1e-6f)); acc[ai][bj][m][j >> 2][j & 3] *= f; }
                    if (br == 3) *(u32x4*)(GS + (size_t)(row0 + ai * HALF + m * 16) * 2048 + col0 + bj * HALF) = pack8(acc[ai][bj][m][0], acc[ai][bj][m][1]); }
        }
    }
};
struct EpiResid {
    static constexpr bool PERM = false, AFTER_DRAIN = false;
    __device__ __forceinline__ bool keep(const Unit&) const { return false; }
    float* X; const float* mod; int goff; float scale;
    __device__ __forceinline__ void operator()(const f32x4 (&acc)[2][2][4][2], const Unit& u, int wr, int wc, int fr, int fq) const {
        const int row0 = u.pm * BM + wr * 64 + fr, col0 = u.pn * BM + wc * 32 + 4 * fq;
        const int mrow = u.pm < 32 ? 0 : 1 + ((u.pm - 32) >> 3); const float* gp = mod + mrow * 12288 + goff + col0;
        f32x4 gv[2][2];
#pragma unroll
        for (int bj = 0; bj < 2; ++bj)
#pragma unroll
            for (int n = 0; n < 2; ++n) gv[bj][n] = *(const f32x4*)(gp + bj * HALF + n * 16) * scale;
#pragma unroll
        for (int ai = 0; ai < 2; ++ai) { f32x4 xv[4][2][2];
#pragma unroll
            for (int m = 0; m < 4; ++m)
#pragma unroll
                for (int bj = 0; bj < 2; ++bj)
#pragma unroll
                    for (int n = 0; n < 2; ++n) xv[m][bj][n] = *(const f32x4*)(X + (size_t)(row0 + ai * HALF + m * 16) * 2048 + col0 + bj * HALF + n * 16);
#pragma unroll
            for (int m = 0; m < 4; ++m)
#pragma unroll
                for (int bj = 0; bj < 2; ++bj)
#pragma unroll
                    for (int n = 0; n < 2; ++n) *(f32x4*)(X + (size_t)(row0 + ai * HALF + m * 16) * 2048 + col0 + bj * HALF + n * 16) = xv[m][bj][n] + gv[bj][n] * acc[ai][bj][m][n];
            asm volatile("" ::: "memory"); }
    }
};
struct BranchOrder {
    StaticOrder so;
    __device__ bool next(int i, Unit& u) const { Unit t; if (!so.next(i >> 2, t)) return false; const int br = i & 3; u.pm = br * 64 + t.pm; u.pn = br * 8 + t.pn; return true; }
    __device__ __forceinline__ void a_ready(const Unit&) const {}
    __device__ __forceinline__ void done(const Unit&) const {}
};
template <class Epi, class Sched, bool ALIGN_EPI = false, bool SP2 = false>
__device__ __forceinline__ void gemm_phase(PG8_LAS unsigned char* lds, const Gemm g, const Sched& S, const Epi& E) {
    int tid_ = threadIdx.x; asm volatile("" : "+v"(tid_));
    const int tid = tid_, wid = __builtin_amdgcn_readfirstlane(tid >> 6), lane = tid & 63, wr = wid >> 2, wc = wid & 3, fr = lane & 15, fq = lane >> 4;
    const int K = g.K, nt = K / BK;
    unsigned voffA[2], voffB[2];
#pragma unroll
    for (int i = 0; i < 2; ++i) { int R, C; stage_rc(tid * 16 + i * 8192, R, C); const int Rb = Epi::PERM ? ((R & ~31) + perm32(R & 31)) : R;
        voffA[i] = (unsigned)(R * K + C) * 2u; voffB[i] = (unsigned)(Rb * K + C) * 2u; }
    const size_t kstep = (size_t)(BK * 2);
    const size_t hstep = (size_t)HALF * K * 2;
    const size_t tstep = 2 * hstep;
    const unsigned ldsw = (unsigned)wid * 1024u;
    const int aoff = lds_byte(wr * 64 + fr, fq * 8), boff = lds_byte(wc * 32 + fr, fq * 8);
#define PG8_SA(b, h) (((b) * 2 + (h)) * HTB)
#define PG8_SB(b, h) ((4 + (b) * 2 + (h)) * HTB)
#define PG8_STAGE(bufoff, gbase, voff) do { _Pragma("unroll") for (int _i = 0; _i < 2; ++_i) \
        __builtin_amdgcn_global_load_lds((const unsigned*)((const char*)(gbase) + (voff)[_i]), (PG8_LAS unsigned*)(lds + (bufoff) + ldsw + _i * 8192), 16, 0, 0); } while (0)
#define PG8_LDA(dst, b, h) do { _Pragma("unroll") for (int m = 0; m < 4; ++m) _Pragma("unroll") for (int k = 0; k < 2; ++k) dst[m][k] = *(const PG8_LAS bf16x8*)(lds + PG8_SA(b, h) + aoff + m * 2048 + k * 1024); } while (0)
#define PG8_LDB(dst, b, h) do { _Pragma("unroll") for (int n = 0; n < 2; ++n) _Pragma("unroll") for (int k = 0; k < 2; ++k) dst[n][k] = *(const PG8_LAS bf16x8*)(lds + PG8_SB(b, h) + boff + n * 2048 + k * 1024); } while (0)
#define PG8_MMA(ai, bj, At, Bt) do { __builtin_amdgcn_s_setprio(1); _Pragma("unroll") for (int m = 0; m < 4; ++m) _Pragma("unroll") for (int n = 0; n < 2; ++n) _Pragma("unroll") for (int k = 0; k < 2; ++k) \
        acc[ai][bj][m][n] = __builtin_amdgcn_mfma_f32_16x16x32_bf16(Bt[n][k], At[m][k], acc[ai][bj][m][n], 0, 0, 0); __builtin_amdgcn_s_setprio(0); } while (0)
#define PG8_WAIT_V(n) asm volatile("s_waitcnt vmcnt(" #n ")" ::: "memory")
#define PG8_WAIT_L(n) asm volatile("s_waitcnt lgkmcnt(" #n ")" ::: "memory")
#define PG8_BAR __builtin_amdgcn_s_barrier()
#define PG8_SCHED __builtin_amdgcn_sched_barrier(0)
    Unit cur, nxt; int ui = 0;
    if (!S.next(0, cur)) return;
    f32x4 acc[2][2][4][2];
#pragma unroll
    for (int a = 0; a < 2; ++a)
#pragma unroll
        for (int b = 0; b < 2; ++b)
#pragma unroll
            for (int m = 0; m < 4; ++m)
#pragma unroll
                for (int n = 0; n < 2; ++n) acc[a][b][m][n] = (f32x4){0.f, 0.f, 0.f, 0.f};
    bf16x8 At[4][2], B0[2][2], B1[2][2];
    const char* cA = (const char*)g.A + (size_t)cur.pm * tstep; const char* cB = (const char*)g.Bt + (size_t)cur.pn * tstep;
    S.a_ready(cur);
    if constexpr (SP2) {
        PG8_STAGE(PG8_SB(0, 0), cB, voffB); PG8_STAGE(PG8_SB(0, 1), cB + hstep, voffB); PG8_STAGE(PG8_SA(0, 0), cA, voffA); PG8_STAGE(PG8_SA(0, 1), cA + hstep, voffA);
        if (wr == 1) PG8_BAR;
        PG8_WAIT_V(2); PG8_BAR;
        PG8_STAGE(PG8_SB(1, 0), cB + kstep, voffB); PG8_STAGE(PG8_SA(1, 0), cA + kstep, voffA); PG8_STAGE(PG8_SB(1, 1), cB + hstep + kstep, voffB);
        PG8_WAIT_V(6); PG8_BAR;
    } else {
        PG8_STAGE(PG8_SB(0, 0), cB, voffB); PG8_STAGE(PG8_SA(0, 0), cA, voffA); PG8_STAGE(PG8_SB(0, 1), cB + hstep, voffB); PG8_STAGE(PG8_SA(0, 1), cA + hstep, voffA);
        if (wr == 1) PG8_BAR;
        PG8_WAIT_V(4); PG8_BAR;
        PG8_STAGE(PG8_SB(1, 0), cB + kstep, voffB); PG8_STAGE(PG8_SA(1, 0), cA + kstep, voffA); PG8_STAGE(PG8_SB(1, 1), cB + hstep + kstep, voffB);
        PG8_WAIT_V(6); PG8_BAR;
    }
    for (;;) {
        const bool has_next = S.next(ui + 1, nxt);
        const char* nA = has_next ? (const char*)g.A + (size_t)nxt.pm * tstep : cA; const char* nB = has_next ? (const char*)g.Bt + (size_t)nxt.pn * tstep : cB;
#pragma clang loop unroll(disable)
        for (int t = 0; t < nt; t += 2) {
            const bool last = (t == nt - 2);
            const char* a1 = cA + (size_t)(t + 1) * kstep;
            const char* a2 = last ? nA : cA + (size_t)(t + 2) * kstep; const char* b2 = last ? nB : cB + (size_t)(t + 2) * kstep;
            const char* a3 = a2 + kstep; const char* b3 = b2 + kstep;
            if (last && has_next) S.a_ready(nxt);
            if constexpr (SP2) {
            PG8_LDB(B0, 0, 0); PG8_LDB(B1, 0, 1); PG8_SCHED; PG8_LDA(At, 0, 0); PG8_STAGE(PG8_SA(1, 1), a1 + hstep, voffA);
            PG8_WAIT_V(8); PG8_WAIT_L(0); PG8_BAR; PG8_MMA(0, 0, At, B0); PG8_MMA(0, 1, At, B1); PG8_BAR; PG8_SCHED;
            PG8_LDA(At, 0, 1); PG8_STAGE(PG8_SB(0, 0), b2, voffB); PG8_STAGE(PG8_SB(0, 1), b2 + hstep, voffB); PG8_STAGE(PG8_SA(0, 0), a2, voffA);
            PG8_WAIT_V(8); PG8_WAIT_L(0); PG8_BAR; PG8_MMA(1, 0, At, B0); PG8_MMA(1, 1, At, B1); PG8_BAR; PG8_SCHED;
            PG8_LDB(B0, 1, 0); PG8_LDB(B1, 1, 1); PG8_SCHED; PG8_LDA(At, 1, 0); PG8_STAGE(PG8_SA(0, 1), a2 + hstep, voffA);
            PG8_WAIT_V(8); PG8_WAIT_L(0); PG8_BAR; PG8_MMA(0, 0, At, B0); PG8_MMA(0, 1, At, B1); PG8_BAR; PG8_SCHED;
            PG8_LDA(At, 1, 1); PG8_STAGE(PG8_SB(1, 0), b3, voffB); PG8_STAGE(PG8_SB(1, 1), b3 + hstep, voffB); PG8_STAGE(PG8_SA(1, 0), a3, voffA);
            PG8_WAIT_V(8); PG8_WAIT_L(0); PG8_BAR; PG8_MMA(1, 0, At, B0); PG8_MMA(1, 1, At, B1); PG8_BAR; PG8_SCHED;
            } else {
            PG8_LDB(B0, 0, 0); PG8_SCHED; PG8_LDA(At, 0, 0); PG8_STAGE(PG8_SA(1, 1), a1 + hstep, voffA);
            PG8_WAIT_L(8); PG8_BAR; PG8_WAIT_L(0); PG8_MMA(0, 0, At, B0); PG8_BAR; PG8_SCHED;
            PG8_LDB(B1, 0, 1); PG8_STAGE(PG8_SB(0, 0), b2, voffB);
            PG8_BAR; PG8_WAIT_L(0); PG8_MMA(0, 1, At, B1); PG8_BAR;
            PG8_LDA(At, 0, 1); PG8_STAGE(PG8_SA(0, 0), a2, voffA);
            PG8_BAR; PG8_WAIT_L(0); PG8_MMA(1, 0, At, B0); PG8_BAR; PG8_SCHED;
            PG8_STAGE(PG8_SB(0, 1), b2 + hstep, voffB);
            PG8_WAIT_V(6); PG8_BAR; PG8_MMA(1, 1, At, B1); PG8_BAR;
            PG8_LDB(B0, 1, 0); PG8_SCHED; PG8_LDA(At, 1, 0); PG8_STAGE(PG8_SA(0, 1), a2 + hstep, voffA);
            PG8_WAIT_L(8); PG8_BAR; PG8_WAIT_L(0); PG8_MMA(0, 0, At, B0); PG8_BAR; PG8_SCHED;
            PG8_LDB(B1, 1, 1); PG8_STAGE(PG8_SB(1, 0), b3, voffB);
            PG8_BAR; PG8_WAIT_L(0); PG8_MMA(0, 1, At, B1); PG8_BAR;
            PG8_LDA(At, 1, 1); PG8_STAGE(PG8_SA(1, 0), a3, voffA);
            PG8_BAR; PG8_WAIT_L(0); PG8_MMA(1, 0, At, B0); PG8_BAR; PG8_SCHED;
            PG8_STAGE(PG8_SB(1, 1), b3 + hstep, voffB);
            PG8_WAIT_V(6); PG8_BAR; PG8_MMA(1, 1, At, B1); PG8_BAR;
            }
        }
        if constexpr (ALIGN_EPI) { if (wr == 0) PG8_BAR; }
        if constexpr (!Epi::AFTER_DRAIN) { E(acc, cur, wr, wc, fr, fq); S.done(cur); }
        if (!has_next) break;
        if (!E.keep(cur)) {
#pragma unroll
        for (int a = 0; a < 2; ++a)
#pragma unroll
            for (int b = 0; b < 2; ++b)
#pragma unroll
                for (int m = 0; m < 4; ++m)
#pragma unroll
                    for (int n = 0; n < 2; ++n) acc[a][b][m][n] = (f32x4){0.f, 0.f, 0.f, 0.f};
        }
        cur = nxt; cA = nA; cB = nB; ++ui;
        if constexpr (ALIGN_EPI) { if (wr == 1) PG8_BAR; }
    }
    PG8_WAIT_V(0);
    if constexpr (!ALIGN_EPI) { if (wr == 0) PG8_BAR; }
    PG8_BAR;
    if constexpr (Epi::AFTER_DRAIN) { E.fused(acc, cur, wr, wc, fr, fq, lds, wid, lane); S.done(cur); }
#undef PG8_SA
#undef PG8_SB
#undef PG8_STAGE
#undef PG8_LDA
#undef PG8_LDB
#undef PG8_MMA
#undef PG8_WAIT_V
#undef PG8_WAIT_L
#undef PG8_BAR
#undef PG8_SCHED
}
}
namespace att {
using bf16x8 = __attribute__((ext_vector_type(8))) short;
using s16x4  = __attribute__((ext_vector_type(4))) short;
using f32x16 = __attribute__((ext_vector_type(16))) float;
using u32x4  = __attribute__((ext_vector_type(4))) unsigned;
constexpr int NW = 8, QBLK = 32, KVBLK = 64, DV = 128;
constexpr float THR = 8.f;
#ifndef QKT_GRP
#define QKT_GRP 4
#endif
#define ATT_SBAR() __builtin_amdgcn_sched_barrier(0)
template <int DK> struct Cfg {
  static constexpr float SCALE = DK == 128 ? 0.088388347648318440f : 0.072168783648703220f;
  static constexpr int KROW = DK * 2;
  static constexpr int SHM_V = KVBLK * DV * 2, SHM_K = KVBLK * DK * 2;
  static constexpr int SHM = 2 * SHM_V + 2 * SHM_K + NW * 64 * 4;
  static constexpr int NKC = DK / 64;
};
__device__ __forceinline__ int crow(int r, int hi) { return (r & 3) + 8 * (r >> 2) + 4 * hi; }
__device__ __forceinline__ unsigned cvtpk(float lo, float hi) { typedef float f32x2_t_ __attribute__((ext_vector_type(2))); typedef __bf16 bf16x2_t_ __attribute__((ext_vector_type(2))); const f32x2_t_ v_ = {lo, hi}; const bf16x2_t_ b_ = __builtin_convertvector(v_, bf16x2_t_); return __builtin_bit_cast(unsigned, b_); }
template <int DK> __device__ __forceinline__ int kswz(int row, int colB) { return row * (DK * 2) + (colB ^ ((row & 7) << 4)); }

template <int DK> __device__ __forceinline__ void partialSM(f32x16& p0, f32x16& p1, float& m_reg, float& mn, float& alpha) {
  constexpr float SCALE = Cfg<DK>::SCALE; constexpr float C = SCALE * 1.4426950408889634f;
  float pmax = p0[0]; for (int r = 1; r < 16; ++r) pmax = fmaxf(pmax, p0[r]); for (int r = 0; r < 16; ++r) pmax = fmaxf(pmax, p1[r]);
  { auto rr = __builtin_amdgcn_permlane32_swap(__float_as_uint(pmax), __float_as_uint(pmax), false, false);
    pmax = fmaxf(__uint_as_float(rr[0]), __uint_as_float(rr[1])); }
  if (__builtin_expect(__all(pmax - m_reg <= THR / SCALE), 1)) { mn = m_reg; alpha = 1.f; }
  else { mn = fmaxf(m_reg, pmax); alpha = __builtin_amdgcn_exp2f((m_reg - mn) * C); m_reg = mn; }
  float mnC = -mn * C;
  for (int r = 0; r < 16; ++r) p0[r] = fmaf(p0[r], C, mnC); for (int r = 0; r < 16; ++r) p1[r] = fmaf(p1[r], C, mnC);
  for (int r = 0; r < 16; ++r) p0[r] = __builtin_amdgcn_exp2f(p0[r]);
}
__device__ __forceinline__ void finishSM(f32x16& p0, f32x16& p1, float alpha, float& l_reg, bf16x8& pa0, bf16x8& pa1, bf16x8& pa2, bf16x8& pa3) {
  for (int r = 0; r < 16; ++r) p1[r] = __builtin_amdgcn_exp2f(p1[r]);
  float ps = 0; for (int r = 0; r < 16; ++r) ps += p0[r]; for (int r = 0; r < 16; ++r) ps += p1[r];
  { auto rr = __builtin_amdgcn_permlane32_swap(__float_as_uint(ps), __float_as_uint(ps), false, false);
    ps = __uint_as_float(rr[0]) + __uint_as_float(rr[1]); }
  l_reg = l_reg * alpha + ps;
#define ATT_PK4(P, BASE, OUT) do { unsigned a0 = cvtpk(P[BASE + 0], P[BASE + 1]), a1 = cvtpk(P[BASE + 2], P[BASE + 3]);   \
    unsigned b0 = cvtpk(P[BASE + 4], P[BASE + 5]), b1 = cvtpk(P[BASE + 6], P[BASE + 7]);                              \
    auto r0 = __builtin_amdgcn_permlane32_swap(a0, b0, false, false); auto r1 = __builtin_amdgcn_permlane32_swap(a1, b1, false, false); \
    u32x4 w = {r0[0], r1[0], r0[1], r1[1]}; OUT = *reinterpret_cast<bf16x8*>(&w); } while (0)
  ATT_PK4(p0, 0, pa0); ATT_PK4(p0, 8, pa1); ATT_PK4(p1, 0, pa2); ATT_PK4(p1, 8, pa3);
#undef ATT_PK4
}
#ifndef QKT_AHEAD
#define QKT_AHEAD 1
#endif
#ifndef QKT_AHEAD_GQA
#define QKT_AHEAD_GQA 1
#endif
template <int DK, class HOOK> __device__ __forceinline__ void qkt_hook(f32x16& p0, f32x16& p1, const char* Ks, const bf16x8* qr, int r32, int hi, HOOK&& hook) {
  constexpr int NS = DK / 16, AH = DK == 128 ? QKT_AHEAD_GQA : QKT_AHEAD, RING = AH + 1;
  p0 = f32x16{}; p1 = f32x16{};
  bf16x8 kb[RING][2];
#pragma unroll
  for (int d0 = 0; d0 < AH; ++d0) { const int cb = (d0 * 16 + hi * 8) * 2; kb[d0][0] = *reinterpret_cast<const bf16x8*>(Ks + kswz<DK>(r32, cb)); kb[d0][1] = *reinterpret_cast<const bf16x8*>(Ks + kswz<DK>(32 + r32, cb)); }
#pragma unroll
  for (int d0 = 0; d0 < NS; ++d0) {
    if (d0 + AH < NS) { const int cb = ((d0 + AH) * 16 + hi * 8) * 2; kb[(d0 + AH) % RING][0] = *reinterpret_cast<const bf16x8*>(Ks + kswz<DK>(r32, cb)); kb[(d0 + AH) % RING][1] = *reinterpret_cast<const bf16x8*>(Ks + kswz<DK>(32 + r32, cb)); }
    __builtin_amdgcn_sched_barrier(0);
    const bf16x8 q = qr[d0];
    p0 = __builtin_amdgcn_mfma_f32_32x32x16_bf16(kb[d0 % RING][0], q, p0, 0, 0, 0);
    p1 = __builtin_amdgcn_mfma_f32_32x32x16_bf16(kb[d0 % RING][1], q, p1, 0, 0, 0);
    hook(d0); __builtin_amdgcn_sched_barrier(0);
  }
}
template <int DK> __device__ __forceinline__ void qkt(f32x16& p0, f32x16& p1, const char* Ks, const bf16x8* qr, int r32, int hi) { qkt_hook<DK>(p0, p1, Ks, qr, r32, hi, [](int) {}); }
__device__ __forceinline__ int v_st(int k, int c) { const int kk = (k & ~0xC) | ((k & 4) << 1) | ((k & 8) >> 1); return ((kk >> 3) * 4 + (c >> 5)) * 512 + ((kk & 7) * 32 + (c & 31)) * 2; }
__device__ __forceinline__ int v_rd_base(int lane) { return ((lane & 3) << 3) | (((lane >> 2) & 3) << 6) | (((lane >> 4) & 1) << 5) | (((lane >> 5) & 1) << 8); }
constexpr int v_rd_off(int d0, int ks, int half) { return d0 * 512 + ks * 4096 + half * 2048; }
template <int OFF> __device__ __forceinline__ s16x4 tr_read(int vb) {
  s16x4 r; asm volatile("ds_read_b64_tr_b16 %0, %1 offset:%2" : "=&v"(r) : "v"(vb), "i"(OFF) : "memory"); return r;
}
template <int D0> __device__ __forceinline__ void pv_one(f32x16& od, int vb, bf16x8 pa0, bf16x8 pa1, bf16x8 pa2, bf16x8 pa3) {
  const s16x4 l0 = tr_read<v_rd_off(D0, 0, 0)>(vb), h0 = tr_read<v_rd_off(D0, 0, 1)>(vb), l1 = tr_read<v_rd_off(D0, 1, 0)>(vb), h1 = tr_read<v_rd_off(D0, 1, 1)>(vb);
  const s16x4 l2 = tr_read<v_rd_off(D0, 2, 0)>(vb), h2 = tr_read<v_rd_off(D0, 2, 1)>(vb), l3 = tr_read<v_rd_off(D0, 3, 0)>(vb), h3 = tr_read<v_rd_off(D0, 3, 1)>(vb);
  asm volatile("s_waitcnt lgkmcnt(0)" ::: "memory"); ATT_SBAR();
#define ATT_PK(L, H) (bf16x8){L[0], L[1], L[2], L[3], H[0], H[1], H[2], H[3]}
  od = __builtin_amdgcn_mfma_f32_32x32x16_bf16(pa0, ATT_PK(l0, h0), od, 0, 0, 0);
  od = __builtin_amdgcn_mfma_f32_32x32x16_bf16(pa1, ATT_PK(l1, h1), od, 0, 0, 0);
  od = __builtin_amdgcn_mfma_f32_32x32x16_bf16(pa2, ATT_PK(l2, h2), od, 0, 0, 0);
  od = __builtin_amdgcn_mfma_f32_32x32x16_bf16(pa3, ATT_PK(l3, h3), od, 0, 0, 0);
#undef ATT_PK
}
__device__ __forceinline__ void pv_d0(f32x16* o, int vb, bf16x8 pa0, bf16x8 pa1, bf16x8 pa2, bf16x8 pa3) {
  pv_one<0>(o[0], vb, pa0, pa1, pa2, pa3); pv_one<1>(o[1], vb, pa0, pa1, pa2, pa3); pv_one<2>(o[2], vb, pa0, pa1, pa2, pa3); pv_one<3>(o[3], vb, pa0, pa1, pa2, pa3);
}
template <int DK, int SDEPTH, int ldq, int ldk, int ldv, int ldo>
__device__ __forceinline__ void attn_body(const unsigned short* __restrict__ Qb, const unsigned short* __restrict__ Kh, const unsigned short* __restrict__ Vh,
                                          unsigned short* __restrict__ Ob, int seq, char* lds) {
  using C_ = Cfg<DK>; constexpr int SHM_V = C_::SHM_V, SHM_K = C_::SHM_K, NKC = C_::NKC, CPR = DK / 8;
  int tid_ = threadIdx.x; asm volatile("" : "+v"(tid_));
  const int tid = tid_, wid = tid >> 6, lane = tid & 63, r32 = lane & 31, hi = lane >> 5;
  char* V_lds = lds; char* K_lds = lds + 2 * SHM_V;
  float* ws = (float*)(lds + 2 * SHM_V + 2 * SHM_K) + wid * 64; float* li_l = ws; float* al_l = ws + 32;
  float m_reg = -1e30f, l_reg = 0; f32x16 o[4] = {}; bf16x8 qr[DK / 16];
  const unsigned short* Qw = Qb + (long)(wid * QBLK + r32) * ldq + hi * 8;
#pragma unroll
  for (int d0 = 0; d0 < DK / 16; ++d0) qr[d0] = *reinterpret_cast<const bf16x8*>(Qw + d0 * 16);
  const int sr = tid >> 4, sc = (tid & 15) * 8, vst0 = v_st(sr, sc), vst1 = v_st(32 + sr, sc);
  unsigned kgo[NKC], klo[NKC];
#pragma unroll
  for (int i = 0; i < NKC; ++i) { const int c = tid + 512 * i, kr_ = c / CPR, kc_ = (c % CPR) * 8; kgo[i] = (unsigned)(kr_ * ldk + kc_) * 2u; klo[i] = (unsigned)kswz<DK>(kr_, kc_ * 2); }
  const unsigned vgo0 = (unsigned)(sr * ldv + sc) * 2u, vgo1 = (unsigned)((32 + sr) * ldv + sc) * 2u;
  const int vb0 = (int)(uintptr_t)V_lds + v_rd_base(lane);
  struct { bf16x8 vs0, vs1; bf16x8 ks[NKC]; } sr_[SDEPTH];
#define ATT_SLOAD(i, k0) do { const char* _vt = (const char*)Vh + (size_t)(k0) * (ldv * 2); const char* _kt = (const char*)Kh + (size_t)(k0) * (ldk * 2); \
    sr_[i].vs0 = *reinterpret_cast<const bf16x8*>(_vt + vgo0); sr_[i].vs1 = *reinterpret_cast<const bf16x8*>(_vt + vgo1); \
    _Pragma("unroll") for (int _c = 0; _c < NKC; ++_c) sr_[i].ks[_c] = *reinterpret_cast<const bf16x8*>(_kt + kgo[_c]); } while (0)
#define ATT_SWRITE(b, i) do { *(bf16x8*)(V_lds + (b) * SHM_V + vst0) = sr_[i].vs0; *(bf16x8*)(V_lds + (b) * SHM_V + vst1) = sr_[i].vs1; \
    _Pragma("unroll") for (int _c = 0; _c < NKC; ++_c) *(bf16x8*)(K_lds + (b) * SHM_K + klo[_c]) = sr_[i].ks[_c]; } while (0)
#define ATT_SWAIT() do { if constexpr (SDEPTH == 2) asm volatile("s_waitcnt vmcnt(%0)" :: "n"(2 + NKC) : "memory"); else asm volatile("s_waitcnt vmcnt(0)" ::: "memory"); } while (0)
#define ATT_RESC(a) do { if (__any((a) < 1.f)) { if (hi == 0) al_l[r32] = (a); asm volatile("s_waitcnt lgkmcnt(0)" ::: "memory"); \
    for (int d = 0; d < 4; ++d) for (int r = 0; r < 16; ++r) o[d][r] *= al_l[crow(r, hi)]; } } while (0)
  f32x16 pA0, pA1, pB0, pB1; float mnA, mnB, alA, alB; bf16x8 pa0, pa1, pa2, pa3; const int NT = seq / KVBLK;
  constexpr int SE = 0, SO = SDEPTH - 1;
  ATT_SLOAD(SE, 0); asm volatile("s_waitcnt vmcnt(0)" ::: "memory"); ATT_SWRITE(0, SE); __syncthreads();
  qkt<DK>(pA0, pA1, K_lds, qr, r32, hi); partialSM<DK>(pA0, pA1, m_reg, mnA, alA);
  ATT_SLOAD(SO, KVBLK); if constexpr (SDEPTH == 2) { if (2 < NT) ATT_SLOAD(SE, 2 * KVBLK); }
  ATT_SWAIT(); ATT_SWRITE(1, SO); __syncthreads();
  for (int j = 1; j + 1 < NT; j += 2) {
    ATT_SBAR(); qkt<DK>(pB0, pB1, K_lds + SHM_K, qr, r32, hi);
    finishSM(pA0, pA1, alA, l_reg, pa0, pa1, pa2, pa3); ATT_SBAR();
    ATT_SLOAD(SO, (j + SDEPTH) * KVBLK); ATT_SBAR();
    pv_d0(o, vb0, pa0, pa1, pa2, pa3); partialSM<DK>(pB0, pB1, m_reg, mnB, alB);
    __syncthreads(); ATT_SWAIT(); ATT_SWRITE(0, SE);
    ATT_RESC(alB); __syncthreads();
    ATT_SBAR(); qkt<DK>(pA0, pA1, K_lds, qr, r32, hi);
    finishSM(pB0, pB1, alB, l_reg, pa0, pa1, pa2, pa3); ATT_SBAR();
    if (SDEPTH == 1 || j + 3 < NT) ATT_SLOAD(SE, (j + 1 + SDEPTH) * KVBLK); ATT_SBAR();
    pv_d0(o, vb0 + SHM_V, pa0, pa1, pa2, pa3); partialSM<DK>(pA0, pA1, m_reg, mnA, alA);
    __syncthreads(); if (SDEPTH == 1 || j + 3 < NT) ATT_SWAIT(); else asm volatile("s_waitcnt vmcnt(0)" ::: "memory"); ATT_SWRITE(1, SO);
    ATT_RESC(alA); __syncthreads();
  }
  ATT_SBAR(); qkt<DK>(pB0, pB1, K_lds + SHM_K, qr, r32, hi);
  finishSM(pA0, pA1, alA, l_reg, pa0, pa1, pa2, pa3); ATT_SBAR();
  pv_d0(o, vb0, pa0, pa1, pa2, pa3); partialSM<DK>(pB0, pB1, m_reg, mnB, alB);
  __syncthreads(); ATT_RESC(alB);
  finishSM(pB0, pB1, alB, l_reg, pa0, pa1, pa2, pa3); ATT_SBAR();
  pv_d0(o, vb0 + SHM_V, pa0, pa1, pa2, pa3);
  if (hi == 0) li_l[r32] = l_reg; asm volatile("s_waitcnt lgkmcnt(0)" ::: "memory");
  float rli[16];
#pragma unroll
  for (int r = 0; r < 16; ++r) rli[r] = __builtin_amdgcn_rcpf(li_l[crow(r, hi)]);
  unsigned short* Ow = Ob + (long)(wid * QBLK) * ldo;
#pragma unroll
  for (int r = 0; r < 16; ++r) { int orow = crow(r, hi);
#pragma unroll
    for (int d0 = 0; d0 < 4; ++d0) { const float v = o[d0][r] * rli[r]; unsigned u = __float_as_uint(v); u += 0x7fffu + ((u >> 16) & 1u); Ow[(long)orow * ldo + d0 * 32 + r32] = (unsigned short)(u >> 16); } }
  __syncthreads();
#undef ATT_SLOAD
#undef ATT_SWRITE
#undef ATT_SWAIT
#undef ATT_RESC
}
template <int DK, int ldq, int ldk, int ldv, int ldo, class CV>
__device__ __forceinline__ void attn_body_simple(const unsigned short* __restrict__ Qb, const unsigned short* __restrict__ Kh, const unsigned short* __restrict__ Vh,
                                                 unsigned short* __restrict__ Ob, int seq, char* lds, CV& cv) {
  using C_ = Cfg<DK>; constexpr int SHM_V = C_::SHM_V, SHM_K = C_::SHM_K, NKC = C_::NKC, CPR = DK / 8;
  int tid_ = threadIdx.x; asm volatile("" : "+v"(tid_));
  const int tid = tid_, wid = tid >> 6, lane = tid & 63, r32 = lane & 31, hi = lane >> 5;
  char* V_lds = lds; char* K_lds = lds + 2 * SHM_V;
  float* ws = (float*)(lds + 2 * SHM_V + 2 * SHM_K) + wid * 64; float* li_l = ws; float* al_l = ws + 32;
  float m_reg = -1e30f, l_reg = 0; f32x16 o[4] = {}; bf16x8 qr[DK / 16];
  const unsigned short* Qw = Qb + (long)(wid * QBLK + r32) * ldq + hi * 8;
#pragma unroll
  for (int d0 = 0; d0 < DK / 16; ++d0) qr[d0] = *reinterpret_cast<const bf16x8*>(Qw + d0 * 16);
  const int sr = tid >> 4, sc = (tid & 15) * 8, vst0 = v_st(sr, sc), vst1 = v_st(32 + sr, sc);
  unsigned kgo[NKC], klo[NKC];
#pragma unroll
  for (int i = 0; i < NKC; ++i) { const int c = tid + 512 * i, kr_ = c / CPR, kc_ = (c % CPR) * 8; kgo[i] = (unsigned)(kr_ * ldk + kc_) * 2u; klo[i] = (unsigned)kswz<DK>(kr_, kc_ * 2); }
  const unsigned vgo0 = (unsigned)(sr * ldv + sc) * 2u, vgo1 = (unsigned)((32 + sr) * ldv + sc) * 2u;
  const int vb0 = (int)(uintptr_t)V_lds + v_rd_base(lane);
  bf16x8 vs0, vs1, ks[NKC];
#define ATS_LOAD(k0) do { const char* _vt = (const char*)Vh + (size_t)(k0) * (ldv * 2); const char* _kt = (const char*)Kh + (size_t)(k0) * (ldk * 2); \
    vs0 = *reinterpret_cast<const bf16x8*>(_vt + vgo0); vs1 = *reinterpret_cast<const bf16x8*>(_vt + vgo1); \
    _Pragma("unroll") for (int _c = 0; _c < NKC; ++_c) ks[_c] = *reinterpret_cast<const bf16x8*>(_kt + kgo[_c]); } while (0)
#define ATS_WRITE(b) do { *(bf16x8*)(V_lds + (b) * SHM_V + vst0) = vs0; *(bf16x8*)(V_lds + (b) * SHM_V + vst1) = vs1; \
    _Pragma("unroll") for (int _c = 0; _c < NKC; ++_c) *(bf16x8*)(K_lds + (b) * SHM_K + klo[_c]) = ks[_c]; } while (0)
  const int NT = seq / KVBLK; float cw[32];
  ATS_LOAD(0); __builtin_amdgcn_s_waitcnt(0x0F70)  ; ATS_WRITE(0); __syncthreads();
#define ATT_TILE(J, B) do { const int j = (J); constexpr int b = (B); \
    if (b == 0) { cv.end(cw); cv.decode(); }                       \
    if (j + 1 < NT) ATS_LOAD((j + 1) * KVBLK); \
    ATT_SBAR(); \
    f32x16 p0, p1; float mn, al; bf16x8 pa0, pa1, pa2, pa3; \
    if constexpr (CV::RIDES && DK == 128) qkt_hook<DK>(p0, p1, K_lds + b * SHM_K, qr, r32, hi, [&](int d0) { if ((d0 & 1) == 0) cv.part(cw, b * 4 + (d0 >> 1)); });     \
    else qkt<DK>(p0, p1, K_lds + b * SHM_K, qr, r32, hi); \
    partialSM<DK>(p0, p1, m_reg, mn, al); \
    if (__any(al < 1.f)) { if (hi == 0) al_l[r32] = al; asm volatile("s_waitcnt lgkmcnt(0)" ::: "memory"); \
      for (int d = 0; d < 4; ++d) for (int r = 0; r < 16; ++r) o[d][r] *= al_l[crow(r, hi)]; } \
    finishSM(p0, p1, al, l_reg, pa0, pa1, pa2, pa3); ATT_SBAR(); \
    pv_d0(o, vb0 + b * SHM_V, pa0, pa1, pa2, pa3); \
    if (j + 1 < NT) { if constexpr (CV::RIDES && DK == 128) asm volatile("s_waitcnt vmcnt(4)" ::: "memory"); else asm volatile("s_waitcnt vmcnt(0)" ::: "memory"); ATS_WRITE(b ^ 1); } \
    __syncthreads(); } while (0)
  for (int jj = 0; jj < NT; jj += 2) {
    ATT_TILE(jj, 0);
    if (jj + 1 < NT) ATT_TILE(jj + 1, 1);
  }
#undef ATT_TILE
  if (NT & 1) cv.rest(cw);
  cv.end(cw);
  if (hi == 0) li_l[r32] = l_reg; asm volatile("s_waitcnt lgkmcnt(0)" ::: "memory");
  float rli[16];
#pragma unroll
  for (int r = 0; r < 16; ++r) rli[r] = __builtin_amdgcn_rcpf(li_l[crow(r, hi)]);
  unsigned short* Ow = Ob + (long)(wid * QBLK) * ldo;
#pragma unroll
  for (int r = 0; r < 16; ++r) { int orow = crow(r, hi);
#pragma unroll
    for (int d0 = 0; d0 < 4; ++d0) { const float v = o[d0][r] * rli[r]; unsigned u = __float_as_uint(v); u += 0x7fffu + ((u >> 16) & 1u); Ow[(long)orow * ldo + d0 * 32 + r32] = (unsigned short)(u >> 16); } }
  __syncthreads();
#undef ATS_LOAD
#undef ATS_WRITE
}
}
namespace ssd {
typedef short bf16x8 __attribute__((ext_vector_type(8)));
typedef short v4i16_t __attribute__((ext_vector_type(4)));
typedef float f32x4 __attribute__((ext_vector_type(4)));
typedef unsigned u32x2v __attribute__((ext_vector_type(2)));
typedef unsigned u32x4v __attribute__((ext_vector_type(4)));
#define SSD_LAS __attribute__((address_space(3)))
constexpr int T = 128, LD_B = 136, LD_X = 72, LD_A = 136, LD_S = 136;
constexpr int OFF_B = 0, OFF_X = OFF_B + T * LD_B * 2, OFF_XW = OFF_X + T * LD_X * 2, OFF_A = OFF_XW + T * LD_X * 2, OFF_S = OFF_A + T * LD_A * 2, OFF_E = OFF_S + 64 * LD_S * 2, OFF_W = OFF_E + 512, OFF_DT = OFF_W + 512, OFF_MISC = OFF_DT + 512, LDS_BYTES = OFF_MISC + 64;
static_assert(LDS_BYTES <= 131072, "ssd LDS");
__device__ __forceinline__ unsigned cvt_pk(float lo, float hi) { typedef float f32x2_t_ __attribute__((ext_vector_type(2))); typedef __bf16 bf16x2_t_ __attribute__((ext_vector_type(2))); const f32x2_t_ v_ = {lo, hi}; const bf16x2_t_ b_ = __builtin_convertvector(v_, bf16x2_t_); return __builtin_bit_cast(unsigned, b_); }
__device__ __forceinline__ bf16x8 tr8(const SSD_LAS unsigned char* p, int rowstride_bytes) {
    const v4i16_t a = __builtin_amdgcn_ds_read_tr16_b64_v4i16((SSD_LAS v4i16_t*)p);
    const v4i16_t b = __builtin_amdgcn_ds_read_tr16_b64_v4i16((SSD_LAS v4i16_t*)(p + 4 * rowstride_bytes));
    return (bf16x8){a[0], a[1], a[2], a[3], b[0], b[1], b[2], b[3]};
}
__device__ __forceinline__ void ssd_unit(SSD_LAS unsigned char* lds, const unsigned short* __restrict__ XBC, const float* __restrict__ DT, unsigned short* __restrict__ Y,
                                         int row0, int nc, int h, int dir, float a_h, const float* __restrict__ h0, float* __restrict__ hout) {
    int tid_ = threadIdx.x; asm volatile("" : "+v"(tid_));
    const int tid = tid_, w = tid >> 6, lane = tid & 63, li = lane & 15, g = lane >> 4, grp = h >> 3;
    SSD_LAS float* Es = (SSD_LAS float*)(lds + OFF_E); SSD_LAS float* Ws = (SSD_LAS float*)(lds + OFF_W); SSD_LAS float* Dts = (SSD_LAS float*)(lds + OFF_DT); SSD_LAS float* Misc = (SSD_LAS float*)(lds + OFF_MISC);
    f32x4 st[4];
#pragma unroll
    for (int pt = 0; pt < 4; ++pt) st[pt] = h0 ? *(const f32x4*)(h0 + (size_t)(16 * pt + li) * 128 + 16 * w + 4 * g) : (f32x4){0.f, 0.f, 0.f, 0.f};
#pragma unroll
    for (int pt = 0; pt < 4; ++pt) { u32x2v pk; pk.x = cvt_pk(st[pt][0], st[pt][1]); pk.y = cvt_pk(st[pt][2], st[pt][3]); *(SSD_LAS u32x2v*)(lds + OFF_S + ((16 * pt + li) * LD_S + 16 * w + 4 * g) * 2) = pk; }
    u32x4v bv[4]; u32x4v xv[2]; float dtv = 0.f;
#define SSD_PREFETCH(tq) do { _Pragma("unroll") for (int i = 0; i < 4; ++i) { const int ch = tid + 512 * i, r = ch >> 4, cc = (ch & 15) * 8; bv[i] = *(const u32x4v*)(XBC + (size_t)((tq) + r) * 1536 + 1024 + grp * 128 + cc); } \
        _Pragma("unroll") for (int i = 0; i < 2; ++i) { const int ch = tid + 512 * i, r = ch >> 3, cc = (ch & 7) * 8; xv[i] = *(const u32x4v*)(XBC + (size_t)((tq) + r) * 1536 + h * 64 + cc); } \
        dtv = DT[(size_t)((tq) + (tid & 127)) * 32 + dir * 16 + h]; } while (0)
    SSD_PREFETCH(row0 + (dir ? nc - 1 : 0) * T);
    for (int ci = 0; ci < nc; ++ci) {
        const int c = dir ? nc - 1 - ci : ci; const int t0 = row0 + c * T;
        bf16x8 cf[4];
#pragma unroll
        for (int k = 0; k < 4; ++k) cf[k] = *(const bf16x8*)(XBC + (size_t)(t0 + 16 * w + li) * 1536 + 1280 + grp * 128 + 32 * k + 8 * g);
        __builtin_amdgcn_sched_barrier(0);
        if (tid < 128) {
            const float da = dtv * a_h; float p = da;
#pragma unroll
            for (int o = 1; o < 64; o <<= 1) { const float q = __shfl_up(p, o); if (lane >= o) p += q; }
            if (lane == 63) Misc[w] = p;
            Dts[tid] = dtv; Es[tid] = p; Ws[tid] = da;
        }
        __syncthreads();
        if (tid < 128) {
            const float tot0 = Misc[0], tot = tot0 + Misc[1]; float P = Es[tid] + (w == 1 ? tot0 : 0.f); const float da = Ws[tid];
            const float E = dir ? tot - P + da : P;
            Es[tid] = E; Ws[tid] = __expf(tot - E) * Dts[tid];
            if (tid == 0) Misc[2] = tot;
        }
        __syncthreads();
#pragma unroll
        for (int i = 0; i < 4; ++i) { const int ch = tid + 512 * i, r = ch >> 4, cc = (ch & 15) * 8; *(SSD_LAS u32x4v*)(lds + OFF_B + (r * LD_B + cc) * 2) = bv[i]; }
#pragma unroll
        for (int i = 0; i < 2; ++i) { const int ch = tid + 512 * i, r = ch >> 3, cc = (ch & 7) * 8; *(SSD_LAS u32x4v*)(lds + OFF_X + (r * LD_X + cc) * 2) = xv[i];
            const float ws = Ws[r]; u32x4v o; const unsigned* xi = (const unsigned*)&xv[i]; unsigned* oo = (unsigned*)&o;
#pragma unroll
            for (int q = 0; q < 4; ++q) oo[q] = cvt_pk(__uint_as_float(xi[q] << 16) * ws, __uint_as_float(xi[q] & 0xffff0000u) * ws);
            *(SSD_LAS u32x4v*)(lds + OFF_XW + (r * LD_X + cc) * 2) = o; }
        SSD_PREFETCH(row0 + (ci + 1 < nc ? (dir ? nc - 2 - ci : ci + 1) : c) * T);
        __syncthreads();
#define SSD_SB() __builtin_amdgcn_sched_barrier(0)
        const int l = 16 * w + li; const float El = Es[l];
#pragma unroll
        for (int sp = 0; sp < 8; sp += 2) {
            bf16x8 a[2][4]; float es[2][4], ds[2][4];
#pragma unroll
            for (int t = 0; t < 2; ++t) {
#pragma unroll
                for (int k = 0; k < 4; ++k) a[t][k] = *(const SSD_LAS bf16x8*)(lds + OFF_B + ((16 * (sp + t) + li) * LD_B + 32 * k + 8 * g) * 2);
                const f32x4 e4 = *(const SSD_LAS f32x4*)(Es + 16 * (sp + t) + 4 * g), d4 = *(const SSD_LAS f32x4*)(Dts + 16 * (sp + t) + 4 * g);
#pragma unroll
                for (int j = 0; j < 4; ++j) { es[t][j] = e4[j]; ds[t][j] = d4[j]; } }
            SSD_SB();
            f32x4 acc[2] = {{0.f, 0.f, 0.f, 0.f}, {0.f, 0.f, 0.f, 0.f}};
#pragma unroll
            for (int k = 0; k < 4; ++k)
#pragma unroll
                for (int t = 0; t < 2; ++t) acc[t] = __builtin_amdgcn_mfma_f32_16x16x32_bf16(a[t][k], cf[k], acc[t], 0, 0, 0);
#pragma unroll
            for (int t = 0; t < 2; ++t) { float v[4];
#pragma unroll
                for (int j = 0; j < 4; ++j) { const int s_ = 16 * (sp + t) + 4 * g + j; const bool ok = dir ? (s_ >= l) : (s_ <= l); const float e = __expf(El - es[t][j]) * ds[t][j]; v[j] = ok ? acc[t][j] * e : 0.f; }
                u32x2v pk; pk.x = cvt_pk(v[0], v[1]); pk.y = cvt_pk(v[2], v[3]);
                *(SSD_LAS u32x2v*)(lds + OFF_A + (l * LD_A + 16 * (sp + t) + 4 * g) * 2) = pk; }
            SSD_SB();
        }
        asm volatile("s_waitcnt lgkmcnt(0)" ::: "memory");
        float el4[4];
        { const f32x4 e4 = *(const SSD_LAS f32x4*)(Es + 16 * w + 4 * g);
#pragma unroll
          for (int j = 0; j < 4; ++j) el4[j] = __expf(e4[j]); }
        unsigned short* yrow = Y + (size_t)(t0 + 16 * w + 4 * g) * 1024 + h * 64 + li;
        bf16x8 af[4];
#pragma unroll
        for (int k = 0; k < 4; ++k) af[k] = *(const SSD_LAS bf16x8*)(lds + OFF_A + (l * LD_A + 32 * k + 8 * g) * 2);
#pragma unroll
        for (int pt = 0; pt < 4; ++pt) {
            bf16x8 xb[4], sb[4];
#pragma unroll
            for (int k = 0; k < 4; ++k) { xb[k] = tr8(lds + OFF_X + ((32 * k + 8 * g + (li >> 2)) * LD_X + 16 * pt + 4 * (li & 3)) * 2, LD_X * 2);
                sb[k] = *(const SSD_LAS bf16x8*)(lds + OFF_S + ((16 * pt + li) * LD_S + 32 * k + 8 * g) * 2); }
            SSD_SB();
            f32x4 ya = {0.f, 0.f, 0.f, 0.f}, yb = {0.f, 0.f, 0.f, 0.f};
#pragma unroll
            for (int k = 0; k < 4; ++k) { ya = __builtin_amdgcn_mfma_f32_16x16x32_bf16(af[k], xb[k], ya, 0, 0, 0); yb = __builtin_amdgcn_mfma_f32_16x16x32_bf16(cf[k], sb[k], yb, 0, 0, 0); }
#pragma unroll
            for (int j = 0; j < 4; ++j) { const float yv = ya[j] + el4[j] * yb[j]; unsigned u = __float_as_uint(yv); u += 0x7fffu + ((u >> 16) & 1u); yrow[(size_t)j * 1024 + 16 * pt] = (unsigned short)(u >> 16); }
            SSD_SB();
        }
        __syncthreads();
        const float etot = __expf(Misc[2]);
        bf16x8 ba[4];
#pragma unroll
        for (int k = 0; k < 4; ++k) ba[k] = tr8(lds + OFF_B + ((32 * k + 8 * g + (li >> 2)) * LD_B + 16 * w + 4 * (li & 3)) * 2, LD_B * 2);
#pragma unroll
        for (int pt = 0; pt < 4; ++pt) { bf16x8 xw[4];
#pragma unroll
            for (int k = 0; k < 4; ++k) xw[k] = tr8(lds + OFF_XW + ((32 * k + 8 * g + (li >> 2)) * LD_X + 16 * pt + 4 * (li & 3)) * 2, LD_X * 2);
            SSD_SB();
            st[pt] *= etot;
#pragma unroll
            for (int k = 0; k < 4; ++k) st[pt] = __builtin_amdgcn_mfma_f32_16x16x32_bf16(ba[k], xw[k], st[pt], 0, 0, 0);
            u32x2v pk; pk.x = cvt_pk(st[pt][0], st[pt][1]); pk.y = cvt_pk(st[pt][2], st[pt][3]); *(SSD_LAS u32x2v*)(lds + OFF_S + ((16 * pt + li) * LD_S + 16 * w + 4 * g) * 2) = pk;
            SSD_SB(); }
        __syncthreads();
    }
#undef SSD_SB
#undef SSD_PREFETCH
    if (hout) {
#pragma unroll
        for (int pt = 0; pt < 4; ++pt) *(f32x4*)(hout + (size_t)(16 * pt + li) * 128 + 16 * w + 4 * g) = st[pt];
    }
}
}
namespace s5 {
typedef short bf16x8 __attribute__((ext_vector_type(8)));
typedef short bf16x4 __attribute__((ext_vector_type(4)));
typedef float f32x4 __attribute__((ext_vector_type(4)));
typedef float f32x2 __attribute__((ext_vector_type(2)));
typedef unsigned u32x2 __attribute__((ext_vector_type(2)));
typedef unsigned u32x4 __attribute__((ext_vector_type(4)));
#define S5_LAS __attribute__((address_space(3)))
constexpr int LD_BU = 136, LD_HS = 136;
constexpr int OFF_HS = 16 * LD_BU * 2, OFF_YL = OFF_HS + 16 * LD_HS * 2;
constexpr int WAVE_LDS = OFF_YL + 16 * 16 * 16 * 2;
constexpr int CD_BYTES = 1024 + 4096, CG_BYTES = 4096;
__device__ __forceinline__ unsigned short f2bf(float f) { unsigned u = __float_as_uint(f); u += 0x7fffu + ((u >> 16) & 1u); return (unsigned short)(u >> 16); }
__device__ __forceinline__ unsigned pk(float lo, float hi) { typedef float f2_ __attribute__((ext_vector_type(2))); typedef __bf16 b2_ __attribute__((ext_vector_type(2))); const f2_ v = {lo, hi}; const b2_ b = __builtin_convertvector(v, b2_); return __builtin_bit_cast(unsigned, b); }

__device__ __forceinline__ void make_consts(unsigned char* cd, unsigned char* cg  , const float* lam_re, const float* lam_im, float stepsz, const float* b_re, const float* b_im, const float* c_re, const float* c_im, int lane) {
    const int li = lane & 15, g = lane >> 4;
    float ar, ai, kr, ki;
    { const float lr = lam_re[lane], lm = lam_im[lane]; const float mag = expf(lr * stepsz); float sn, cs; sincosf(lm * stepsz, &sn, &cs); ar = mag * cs; ai = mag * sn;
      const float den = lr * lr + lm * lm; kr = ((ar - 1.0f) * lr + ai * lm) / den; ki = (ai * lr - (ar - 1.0f) * lm) / den; }
    float zr = ar, zi = ai;
#pragma unroll
    for (int i = 0; i < 8; ++i) { const float nr = zr * zr - zi * zi, ni = 2.0f * zr * zi; zr = nr; zi = ni; }
    float* cf = (float*)cd; cf[lane] = ar; cf[64 + lane] = ai; cf[128 + lane] = zr; cf[192 + lane] = zi;
#pragma unroll
    for (int ct = 0; ct < 8; ++ct) { const int k = 16 * ct + li, p = k >> 1; const bool im = k & 1; const float kkr = __shfl(kr, p), kki = __shfl(ki, p);
        const f32x4 br = *(const f32x4*)(b_re + p * 16 + 4 * g), bi = *(const f32x4*)(b_im + p * 16 + 4 * g); float v[4];
#pragma unroll
        for (int j = 0; j < 4; ++j) v[j] = im ? kkr * bi[j] + kki * br[j] : kkr * br[j] - kki * bi[j];
        u32x2 w; w.x = pk(v[0], v[1]); w.y = pk(v[2], v[3]); *(u32x2*)(cd + 1024 + (ct * 64 + lane) * 8) = w; }
    if (cg) {
#pragma unroll
        for (int kk = 0; kk < 4; ++kk) { const f32x4 vr = *(const f32x4*)(c_re + li * 64 + 16 * kk + 4 * g), vi = *(const f32x4*)(c_im + li * 64 + 16 * kk + 4 * g);
            u32x4 w; w.x = pk(vr[0], -vi[0]); w.y = pk(vr[1], -vi[1]); w.z = pk(vr[2], -vi[2]); w.w = pk(vr[3], -vi[3]); *(u32x4*)(cg + (kk * 64 + lane) * 16) = w; } }
}
struct Ctx {
    float ar, ai;
    bf16x4 bfr[8];
    bf16x8 cfr[4];
};
__device__ __forceinline__ void load_ctx(Ctx& c, const unsigned char* cd, const unsigned char* cg, int lane, bool with_c) {
    const float* cf = (const float*)cd; c.ar = cf[lane]; c.ai = cf[64 + lane];
#pragma unroll
    for (int ct = 0; ct < 8; ++ct) c.bfr[ct] = __builtin_bit_cast(bf16x4, *(const u32x2*)(cd + 1024 + (ct * 64 + lane) * 8));
    if (with_c) {
#pragma unroll
        for (int kk = 0; kk < 4; ++kk) c.cfr[kk] = __builtin_bit_cast(bf16x8, *(const u32x4*)(cg + (kk * 64 + lane) * 16)); }
}
template <bool NEWT, bool CURT, bool HSW, bool OLDT, bool POST>
__device__ __forceinline__ void step(const Ctx& c, S5_LAS unsigned char* BU, S5_LAS unsigned char* HS, S5_LAS unsigned char* YL  , int lane, int li, int g, int dir, const u32x2 unew, float& hr, float& hi,
                                     const unsigned short* __restrict__ uold, int ldu, unsigned short* __restrict__ outp, float dch) {
    unsigned bu[16]; bf16x8 hf[4]; f32x4 acc[8]; unsigned hs[16]; unsigned short yprev[4]; unsigned short uo[4];
    if (CURT) {
#pragma unroll
        for (int i = 0; i < 16; ++i) { const int t = dir ? 15 - i : i; bu[i] = *(const S5_LAS unsigned*)(BU + t * (LD_BU * 2) + lane * 4); } }
    if (OLDT) {
#pragma unroll
        for (int kk = 0; kk < 4; ++kk) hf[kk] = *(const S5_LAS bf16x8*)(HS + li * (LD_HS * 2) + (32 * kk + 8 * g) * 2);
        if (POST) {
#pragma unroll
            for (int j = 0; j < 4; ++j) { yprev[j] = *(const S5_LAS unsigned short*)(YL + ((4 * g + j) * 16 + li) * 2); uo[j] = uold[(size_t)(4 * g + j) * ldu + li]; }
            __builtin_amdgcn_sched_barrier(0); } }
    if (NEWT) { const bf16x4 uf = __builtin_bit_cast(bf16x4, unew);
#pragma unroll
        for (int ct = 0; ct < 8; ++ct) { acc[ct] = (f32x4){0.f, 0.f, 0.f, 0.f}; acc[ct] = __builtin_amdgcn_mfma_f32_16x16x16bf16_1k(c.bfr[ct], uf, acc[ct], 0, 0, 0); } }
    if (CURT) {
#pragma unroll
        for (int i = 0; i < 16; ++i) { const float br = __uint_as_float(bu[i] << 16), bi = __uint_as_float(bu[i] & 0xffff0000u);
            const float nr = c.ar * hr - c.ai * hi + br, ni = c.ar * hi + c.ai * hr + bi; hr = nr; hi = ni; if (HSW) hs[i] = pk(hr, hi); } }
    if (OLDT) { f32x4 y = {0.f, 0.f, 0.f, 0.f};
#pragma unroll
        for (int kk = 0; kk < 4; ++kk) y = __builtin_amdgcn_mfma_f32_16x16x32_bf16(hf[kk], c.cfr[kk], y, 0, 0, 0);
        if (!POST) {
#pragma unroll
            for (int j = 0; j < 4; ++j) *(S5_LAS unsigned short*)(YL + ((4 * g + j) * 16 + li) * 2) = f2bf(y[j]); }
        else {
#pragma unroll
            for (int j = 0; j < 4; ++j) { const float v = y[j] + __uint_as_float((unsigned)yprev[j] << 16) + dch * __uint_as_float((unsigned)uo[j] << 16); const float tt = 0.7978845608028654f * (v + 0.044715f * v * v * v);
                outp[(size_t)(4 * g + j) * 1024 + li] = f2bf(v * (1.0f - 1.0f / (1.0f + __expf(2.0f * tt)))); } } }
    if (NEWT) {
#pragma unroll
        for (int ct = 0; ct < 8; ++ct) { u32x2 w; w.x = pk(acc[ct][0], acc[ct][1]); w.y = pk(acc[ct][2], acc[ct][3]); *(S5_LAS u32x2*)(BU + (li * LD_BU + 16 * ct + 4 * g) * 2) = w; } }
    if (CURT && HSW) {
#pragma unroll
        for (int i = 0; i < 16; ++i) { const int t = dir ? 15 - i : i; *(S5_LAS unsigned*)(HS + t * (LD_HS * 2) + lane * 4) = hs[i]; } }
}
template <bool POST>
__device__ __forceinline__ void s5_pass(const Ctx& c, S5_LAS unsigned char* wl, int lane, int dir, const unsigned short* __restrict__ U, int ldu, unsigned short* __restrict__ OUT, float dch, float& hr, float& hi) {
    const int li = lane & 15, g = lane >> 4; constexpr int L = 256, ntile = 16;
    S5_LAS unsigned char* BU = wl; S5_LAS unsigned char* HS = wl + OFF_HS; S5_LAS unsigned char* YL = wl + OFF_YL;
#define S5_TB(ti) (dir ? L - 16 * ((ti) + 1) : 16 * (ti))
#define S5_ULOAD(ti) (*(const u32x2*)(U + (size_t)(S5_TB(ti) + li) * ldu + 4 * g))
#define S5_ARGS(ti) YL + S5_TB(ti) * 32, lane, li, g, dir
#define S5_ARGS2(ti) U + (size_t)S5_TB(ti) * ldu, ldu, OUT + (size_t)S5_TB(ti) * 1024, dch
    u32x2 u0 = S5_ULOAD(0), u1 = S5_ULOAD(1), u2 = S5_ULOAD(2);
    step<true, false, true, false, POST>(c, BU, HS, S5_ARGS(0), u0, hr, hi, S5_ARGS2(0));
    step<true, true, true, false, POST>(c, BU, HS, S5_ARGS(0), u1, hr, hi, S5_ARGS2(0));
    u0 = u2; u1 = S5_ULOAD(3); u2 = S5_ULOAD(4);
#pragma clang loop unroll(disable)
    for (int ti = 2; ti < ntile; ++ti) {
        const u32x2 uc = u0; u0 = u1; u1 = u2; if (ti + 3 < ntile) u2 = S5_ULOAD(ti + 3);
        step<true, true, true, true, POST>(c, BU, HS, S5_ARGS(ti - 2), uc, hr, hi, S5_ARGS2(ti - 2));
    }
    step<false, true, true, true, POST>(c, BU, HS, S5_ARGS(ntile - 2), u0, hr, hi, S5_ARGS2(ntile - 2));
    step<false, false, true, true, POST>(c, BU, HS, S5_ARGS(ntile - 1), u0, hr, hi, S5_ARGS2(ntile - 1));
#undef S5_ARGS
#undef S5_ARGS2
}
__device__ __forceinline__ void s5_epass(const Ctx& c, S5_LAS unsigned char* wl, int lane, int dir, const unsigned short* __restrict__ U, int ldu, float& hr, float& hi) {
    const int li = lane & 15, g = lane >> 4; constexpr int L = 256, ntile = 16;
    S5_LAS unsigned char* BU = wl; S5_LAS unsigned char* HS = wl + OFF_HS;
    u32x2 uu[16];
#pragma unroll
    for (int ti = 0; ti < 16; ++ti) uu[ti] = S5_ULOAD(ti);
    step<true, false, false, false, false>(c, BU, HS, HS, lane, li, g, dir, uu[0], hr, hi, nullptr, 0, nullptr, 0.f);
#pragma unroll
    for (int ti = 1; ti < ntile; ++ti) step<true, true, false, false, false>(c, BU, HS, HS, lane, li, g, dir, uu[ti], hr, hi, nullptr, 0, nullptr, 0.f);
    step<false, true, false, false, false>(c, BU, HS, HS, lane, li, g, dir, uu[0], hr, hi, nullptr, 0, nullptr, 0.f);
#undef S5_ULOAD
#undef S5_TB
}
}
typedef unsigned short bf16;
typedef float f32x4 __attribute__((ext_vector_type(4)));
typedef unsigned u32x4 __attribute__((ext_vector_type(4)));
typedef unsigned u32x2 __attribute__((ext_vector_type(2)));
#define LAS __attribute__((address_space(3)))
constexpr int NWAVES = 8, NTHREADS = 512;
constexpr int DM = 2048, MROWS = 16384, MCTX = 8192, KROWS = 18432, NLAYER = 4;
constexpr int NIN = 14336;
constexpr int C_GATE = 0, C_GQ = 8192, C_GK = 9216, C_GV = 9472, C_SZ = 9728, C_XBC = 10752, C_S5U = 12288, C_MQD = 13312, C_CKV = 13824, C_KPE = 14080, C_SDT = 14144, C_END = 14176;
constexpr int FFN = 5632;
constexpr float EPS = 1e-6f;
constexpr size_t MiB = 1u << 20;
constexpr size_t WS_CTL = 0, CTL_ZERO_BYTES = 1 * MiB;
constexpr size_t WS_MOD = 1 * MiB;
constexpr size_t WS_TAB = 2 * MiB;
constexpr size_t WS_X = 4 * MiB;
constexpr size_t WS_H = 132 * MiB;
constexpr size_t WS_PROJ = 196 * MiB;
constexpr size_t WS_W = 644 * MiB;
constexpr size_t W_IN = 0, W_UQ = W_IN + (size_t)NIN * 2048 * 2, W_UKV = W_UQ + (size_t)1536 * 512 * 2, W_GLU = W_UKV + (size_t)2048 * 256 * 2, W_BR = W_GLU + (size_t)2048 * 1024 * 2,
                 W_OUT = W_BR + (size_t)4 * 2048 * 1024 * 2, W_FI = W_OUT + (size_t)2048 * 2048 * 2, W_FO = W_FI + (size_t)11264 * 2048 * 2, W_END = W_FO + (size_t)2048 * 5632 * 2;
static_assert(W_END <= 154 * MiB, "weights region");
constexpr size_t WS_Q = 798 * MiB, WS_KG = 830 * MiB, WS_VG = 839 * MiB, WS_AQ = 848 * MiB, WS_ACKV = 864 * MiB, WS_QM = 873 * MiB, WS_KM = 921 * MiB, WS_VM = 975 * MiB,
                 WS_XBC = 1011 * MiB, WS_DT = 1059 * MiB, WS_YF = 1061 * MiB, WS_YB = 1125 * MiB, WS_SF = 1189 * MiB, WS_SB = 1253 * MiB, WS_S5PRE = 1317 * MiB,
                 WS_O = 1349 * MiB, WS_GSF = 1477 * MiB, WS_GS = 1605 * MiB, WS_END = 1669 * MiB;
constexpr size_t WS_S5C = WS_GSF, WS_S5G = WS_GSF + 4 * MiB, WS_S5E = WS_GSF + 8 * MiB;
constexpr int CW_BAR = 4096;
constexpr size_t O_YP = 0, O_YS = 16777216, O_GK = 33554432, O_GV = 41943040, O_CKV = 50331648, O_KPE = 58720256, O_SSD = 60817408, O_S5 = 94371840, O_TOTAL = 96468992;
constexpr int RING_BYTES = 131072, LDSCTL_OFF = 135168  , MISC_OFF = LDSCTL_OFF + 320, LDS_BYTES = 147456;

#define VM_WAIT() asm volatile("s_waitcnt vmcnt(0)" ::: "memory")
__device__ __forceinline__ unsigned f2bf(float f) { unsigned u = __float_as_uint(f); return (u + 0x7fffu + ((u >> 16) & 1u)) >> 16; }
__device__ __forceinline__ unsigned pk2(float lo, float hi) { typedef float f32x2_t_ __attribute__((ext_vector_type(2))); typedef __bf16 bf16x2_t_ __attribute__((ext_vector_type(2))); const f32x2_t_ v_ = {lo, hi}; const bf16x2_t_ b_ = __builtin_convertvector(v_, bf16x2_t_); return __builtin_bit_cast(unsigned, b_); }
__device__ __forceinline__ float bflo(unsigned w) { return __uint_as_float(w << 16); }
__device__ __forceinline__ float bfhi(unsigned w) { return __uint_as_float(w & 0xffff0000u); }
__device__ __forceinline__ void unpack8(const u32x4 w, float* f) { f[0] = bflo(w.x); f[1] = bfhi(w.x); f[2] = bflo(w.y); f[3] = bfhi(w.y); f[4] = bflo(w.z); f[5] = bfhi(w.z); f[6] = bflo(w.w); f[7] = bfhi(w.w); }
__device__ __forceinline__ u32x4 pack8f(const float* f) { u32x4 w; w.x = pk2(f[0], f[1]); w.y = pk2(f[2], f[3]); w.z = pk2(f[4], f[5]); w.w = pk2(f[6], f[7]); return w; }
__device__ __forceinline__ float wave_sum(float v) {
#pragma unroll
    for (int o = 1; o < 64; o <<= 1) v += __shfl_xor(v, o);
    return v;
}
__device__ __forceinline__ float sigm(float x) { return 1.0f / (1.0f + __expf(-x)); }

struct Args { const float* in[41]; float* out; unsigned char* ws; int ph_lo, ph_hi, li, pad; };
struct Frame {
    LAS unsigned char* lds; int tid, lane, wave, G, bid, gw, NGW;
    const float* const* in; float* out; unsigned char* ws;
    const float* const* in0; float* out0; unsigned char* ws0;
};
enum { I_XP = 0, I_XS, I_CGK, I_CGV, I_CCKV, I_CKPE, I_SSSD, I_SS5, I_C, I_CCTX, I_N1G, I_N2G, I_WMOD, I_BMOD, I_WIN, I_QNG, I_KNG, I_CONVW, I_CONVB, I_ALOG, I_DTB, I_SSDD, I_SSDNG,
       I_MQNG, I_WUQ, I_MKVNG, I_WUKV, I_LRE, I_LIM, I_LSTEP, I_BRE, I_BIM, I_CRE, I_CIM, I_S5D, I_WGLU, I_WBR, I_WOUT, I_WFI, I_WFO, I_FING };

__device__ __forceinline__ void transpose_item(const float* W, int K, int N, bf16* WT, int dst_row0, int k0, int n0, LAS float* scr, int lane) {
#pragma unroll 8
    for (int i = 0; i < 32; ++i) { const int kk = 2 * i + (lane >> 5); scr[kk * 33 + (lane & 31)] = W[(size_t)(k0 + kk) * N + n0 + (lane & 31)]; }
    asm volatile("s_waitcnt lgkmcnt(0)" ::: "memory");
    const int c = lane & 7;
#pragma unroll
    for (int j = 0; j < 4; ++j) { const int n = (lane >> 3) + 8 * j; const LAS float* s = scr + (8 * c) * 33 + n;
        u32x4 o; o.x = pk2(s[0 * 33], s[1 * 33]); o.y = pk2(s[2 * 33], s[3 * 33]); o.z = pk2(s[4 * 33], s[5 * 33]); o.w = pk2(s[6 * 33], s[7 * 33]);
        *(u32x4*)(WT + (size_t)(dst_row0 + n) * K + k0 + 8 * c) = o; }
    asm volatile("s_waitcnt lgkmcnt(0)" ::: "memory");
}
__device__ __forceinline__ int map_in(int c) {
    if (c < 12288) return c; if (c < 12320) return C_SDT + (c - 12288); if (c < 12832) return C_MQD + (c - 12320); if (c < 13152) return C_CKV + (c - 12832); return C_S5U + (c - 13152);
}
__device__ __forceinline__ int map_pair(int c, int half) {
    return c < half ? 256 * (c >> 7) + (c & 127) : 256 * ((c - half) >> 7) + 128 + ((c - half) & 127);
}
__device__ __forceinline__ void phase_zero_pad(Frame& F) {
    bf16* Wi = (bf16*)((char*)(F.ws + WS_W) + W_IN); const u32x4 z = {0u, 0u, 0u, 0u};
    for (int r = F.gw; r < NIN - C_END; r += F.NGW) { u32x4* p = (u32x4*)(Wi + (size_t)(C_END + r) * 2048);
#pragma unroll
        for (int j = 0; j < 4; ++j) p[F.lane + 64 * j] = z; }
}
__device__ __forceinline__ void phase_prologue(Frame& F) {
    LAS float* sc = (LAS float*)F.lds;
    LAS float* part = (LAS float*)(F.lds + 40960);
    float* MOD = (float*)(F.ws + WS_MOD);
    for (int i = F.tid; i < 5 * 2048; i += NTHREADS) { const int v = i >> 11, k = i & 2047; const float x = v == 0 ? F.in[I_CCTX][k] : F.in[I_C][(v - 1) * 2048 + k]; sc[i] = x * sigm(x); }
    __syncthreads();
    for (int it = F.bid; it < 192; it += F.G) {
        const int l = it / 48, cg = it % 48; const float* W = F.in[I_WMOD] + (size_t)l * 2048 * 12288 + 256 * cg + 4 * F.lane;
        f32x4 acc[5];
#pragma unroll
        for (int v = 0; v < 5; ++v) acc[v] = (f32x4){0.f, 0.f, 0.f, 0.f};
        const int k0 = 256 * F.wave;
#pragma unroll 16
        for (int k = 0; k < 256; ++k) { const f32x4 w = *(const f32x4*)(W + (size_t)(k0 + k) * 12288);
#pragma unroll
            for (int v = 0; v < 5; ++v) acc[v] += sc[v * 2048 + k0 + k] * w; }
#pragma unroll
        for (int v = 0; v < 5; ++v) *(LAS f32x4*)(part + (F.wave * 5 + v) * 256 + 4 * F.lane) = acc[v];
        __syncthreads();
        for (int o = F.tid; o < 1280; o += NTHREADS) { const int v = o >> 8, col = o & 255; float s = F.in[I_BMOD][l * 12288 + 256 * cg + col];
#pragma unroll
            for (int w = 0; w < 8; ++w) s += part[(w * 5 + v) * 256 + col];
            MOD[((size_t)l * 5 + v) * 12288 + 256 * cg + col] = s; }
        __syncthreads();
    }
    for (int i = F.gw; i < NLAYER * 2 * 64; i += F.NGW) { const int layer = i >> 7, dir = (i >> 6) & 1, g = i & 63; const size_t pg = (size_t)(layer * 2 + dir) * 64 + g;
        s5::make_consts(F.ws + WS_S5C + (size_t)i * s5::CD_BYTES, dir == 0 ? F.ws + WS_S5G + ((size_t)layer * 64 + g) * s5::CG_BYTES : nullptr, F.in[I_LRE] + pg * 64, F.in[I_LIM] + pg * 64, expf(F.in[I_LSTEP][pg]),
                        F.in[I_BRE] + ((size_t)layer * 64 + g) * 1024, F.in[I_BIM] + ((size_t)layer * 64 + g) * 1024, F.in[I_CRE] + ((size_t)layer * 64 + g) * 1024, F.in[I_CIM] + ((size_t)layer * 64 + g) * 1024, F.lane); }
    if (F.bid == F.G - 1) {
        float2* tA = (float2*)(F.ws + WS_TAB); float2* tC = tA + 64 * 32;
        for (int i = F.tid; i < 64 * 32; i += NTHREADS) { const int pos = i >> 5, f = i & 31; const float a = (float)pos * expf(-(float)f * (9.210340371976184f / 32.0f)); float sn, cs; sincosf(a, &sn, &cs); tA[i] = make_float2(cs, sn); }
        for (int i = F.tid; i < 64 * 16; i += NTHREADS) { const int pos = i >> 4, f = i & 15; const float a = (float)pos * expf(-(float)f * (9.210340371976184f / 16.0f)); float sn, cs; sincosf(a, &sn, &cs); tC[i] = make_float2(cs, sn); }
    }
}
__device__ __forceinline__ void phase_norm(Frame& F, int layer, int which  , bool from_input) {
    float* X = (float*)(F.ws + WS_X); bf16* H = (bf16*)(F.ws + WS_H); const float* MOD = (const float*)(F.ws + WS_MOD) + (size_t)layer * 5 * 12288;
    const float* gw = F.in[which ? I_N2G : I_N1G] + layer * 2048;
    for (int m = F.gw; m < MROWS; m += F.NGW) {
        const float* src = from_input ? (m < MCTX ? F.in[I_XP] + (size_t)m * DM : F.in[I_XS] + (size_t)(m - MCTX) * DM) : X + (size_t)m * DM;
        const int mrow = m < MCTX ? 0 : 1 + ((m - MCTX) >> 11); const float* sh = MOD + mrow * 12288 + (which ? 3 : 0) * 2048; const float* scl = sh + 2048;
        f32x4 v[8]; float ss = 0.f;
#pragma unroll
        for (int j = 0; j < 8; ++j) { v[j] = *(const f32x4*)(src + 4 * F.lane + 256 * j); ss += v[j][0] * v[j][0] + v[j][1] * v[j][1] + v[j][2] * v[j][2] + v[j][3] * v[j][3]; }
        if (from_input) {
#pragma unroll
            for (int j = 0; j < 8; ++j) *(f32x4*)(X + (size_t)m * DM + 4 * F.lane + 256 * j) = v[j]; }
        const float rstd = rsqrtf(wave_sum(ss) * (1.0f / DM) + EPS);
#pragma unroll
        for (int j = 0; j < 8; ++j) { const int c = 4 * F.lane + 256 * j; const f32x4 g = *(const f32x4*)(gw + c), s1 = *(const f32x4*)(scl + c), s0 = *(const f32x4*)(sh + c);
            const f32x4 o = v[j] * rstd * g * (1.0f + s1) + s0; u32x2 w; w.x = pk2(o[0], o[1]); w.y = pk2(o[2], o[3]); *(u32x2*)(H + (size_t)m * DM + c) = w; }
    }
}
__device__ __forceinline__ void phase_final_norm(Frame& F) {
    const float* X = (const float*)(F.ws + WS_X); const float* gw = F.in[I_FING];
    for (int m = F.gw; m < MROWS; m += F.NGW) {
        f32x4 v[8]; float ss = 0.f;
#pragma unroll
        for (int j = 0; j < 8; ++j) { v[j] = *(const f32x4*)(X + (size_t)m * DM + 4 * F.lane + 256 * j); ss += v[j][0] * v[j][0] + v[j][1] * v[j][1] + v[j][2] * v[j][2] + v[j][3] * v[j][3]; }
        const float rstd = rsqrtf(wave_sum(ss) * (1.0f / DM) + EPS);
#pragma unroll
        for (int j = 0; j < 8; ++j) { const int c = 4 * F.lane + 256 * j; *(f32x4*)(F.out + O_YP + (size_t)m * DM + c) = v[j] * rstd * *(const f32x4*)(gw + c); }
    }
}
__device__ __forceinline__ void phase_prep(Frame& F, int layer) {
    const bf16* PROJ = (const bf16*)(F.ws + WS_PROJ);
    bf16* Q = (bf16*)(F.ws + WS_Q); bf16* KG = (bf16*)(F.ws + WS_KG); bf16* VG = (bf16*)(F.ws + WS_VG); bf16* AQ = (bf16*)(F.ws + WS_AQ); bf16* ACKV = (bf16*)(F.ws + WS_ACKV);
    bf16* KM = (bf16*)(F.ws + WS_KM); bf16* XBC = (bf16*)(F.ws + WS_XBC); float* DT = (float*)(F.ws + WS_DT);
    const float2* tA = (const float2*)(F.ws + WS_TAB); const float2* tC = tA + 64 * 32;
    const int lane = F.lane;
    for (int vr = F.gw; vr < KROWS; vr += F.NGW) {
        if (vr >= MROWS) {
            const int c = vr - MROWS, b = c >> 9, j = c & 511; const size_t kr = MCTX + (size_t)b * 2560 + 2048 + j; const size_t ci = ((size_t)b * 4 + layer) * 512 + j;
            { const f32x4 a = *(const f32x4*)(F.in[I_CGK] + ci * 256 + 4 * lane); u32x2 w; w.x = pk2(a[0], a[1]); w.y = pk2(a[2], a[3]); *(u32x2*)(KG + kr * 256 + 4 * lane) = w; }
            { const f32x4 a = *(const f32x4*)(F.in[I_CGV] + ci * 256 + 4 * lane); u32x2 w; w.x = pk2(a[0], a[1]); w.y = pk2(a[2], a[3]); *(u32x2*)(VG + kr * 256 + 4 * lane) = w; }
            { const f32x4 a = *(const f32x4*)(F.in[I_CCKV] + ci * 256 + 4 * lane); u32x2 w; w.x = pk2(a[0], a[1]); w.y = pk2(a[2], a[3]); *(u32x2*)(ACKV + kr * 256 + 4 * lane) = w; }
            { const bf16 kp = (bf16)f2bf(F.in[I_CKPE][ci * 64 + lane]);
#pragma unroll
              for (int hh = 0; hh < 8; ++hh) KM[kr * 1536 + hh * 192 + 128 + lane] = kp; }
            continue;
        }
        const int m = vr; const bool lat = m >= MCTX; const int bb = lat ? (m - MCTX) >> 11 : m >> 8; const int t = lat ? (m - MCTX) & 2047 : m & 255; const int L = lat ? 2048 : 256;
        const size_t kr = lat ? MCTX + (size_t)bb * 2560 + t : (size_t)m; const int rowpos = t >> 6, colpos = t & 63;
        const bf16* pr = PROJ + (size_t)m * NIN; const size_t orow = ((size_t)bb * 4 + layer) * 256 + t;
        const int j8 = lane & 7, ax = j8 >> 2, fo = (j8 & 3) * 8;
        const u32x4 ldq0 = *(const u32x4*)(pr + C_GQ + (lane >> 3) * 128 + ax * 64 + fo), ldq1 = *(const u32x4*)(pr + C_GQ + (lane >> 3) * 128 + ax * 64 + fo + 32);
        const u32x4 ldk0 = *(const u32x4*)(pr + C_GK + ((lane >> 3) & 1) * 128 + ax * 64 + fo), ldk1 = *(const u32x4*)(pr + C_GK + ((lane >> 3) & 1) * 128 + ax * 64 + fo + 32);
        const u32x4 ldv = *(const u32x4*)(pr + C_GV + 8 * (lane & 31));
        const u32x4 ldqd = *(const u32x4*)(pr + C_MQD + 8 * lane);
        const u32x4 ldck = *(const u32x4*)(pr + C_CKV + 8 * (lane & 31));
        const int axp = (lane >> 1) & 1, fop = (lane & 1) * 8;
        const u32x4 ldp0 = *(const u32x4*)(pr + C_KPE + axp * 32 + fop), ldp1 = *(const u32x4*)(pr + C_KPE + axp * 32 + fop + 16);
        u32x4 ldc[3][5];
#pragma unroll
        for (int i = 0; i < 3; ++i)
#pragma unroll
            for (int k = 0; k < 5; ++k) { const int tt = t + k - 2; const bool ok = tt >= 0 && tt < L; ldc[i][k] = *(const u32x4*)(pr + (ok ? (ptrdiff_t)(k - 2) * NIN : 0) + C_XBC + 8 * lane + 512 * i); if (!ok) ldc[i][k] = (u32x4){0u, 0u, 0u, 0u}; }
        const unsigned short lddt = pr[C_SDT + (lane & 31)];
        { const float2* tp = tA + (ax ? colpos : rowpos) * 32 + fo;
          { const int hq = lane >> 3; float x0[8], x1[8]; unpack8(ldq0, x0); unpack8(ldq1, x1);
            float ss = 0.f;
#pragma unroll
            for (int e = 0; e < 8; ++e) ss += x0[e] * x0[e] + x1[e] * x1[e];
            ss += __shfl_xor(ss, 1); ss += __shfl_xor(ss, 2); ss += __shfl_xor(ss, 4);
            const float rstd = rsqrtf(ss * (1.0f / 128.0f) + EPS); const float* gq = F.in[I_QNG] + layer * 128 + ax * 64 + fo;
#pragma unroll
            for (int e = 0; e < 8; ++e) { float a = x0[e] * rstd * gq[e], b = x1[e] * rstd * gq[32 + e]; if (lat) { const float2 cs = tp[e]; const float a2 = a * cs.x - b * cs.y; b = a * cs.y + b * cs.x; a = a2; } x0[e] = a; x1[e] = b; }
            bf16* q = Q + (size_t)m * 1024 + hq * 128 + ax * 64 + fo; *(u32x4*)q = pack8f(x0); *(u32x4*)(q + 32) = pack8f(x1); }
          { const int kh = (lane >> 3) & 1; float x0[8], x1[8]; unpack8(ldk0, x0); unpack8(ldk1, x1);
            float ss = 0.f;
#pragma unroll
            for (int e = 0; e < 8; ++e) ss += x0[e] * x0[e] + x1[e] * x1[e];
            ss += __shfl_xor(ss, 1); ss += __shfl_xor(ss, 2); ss += __shfl_xor(ss, 4);
            const float rstd = rsqrtf(ss * (1.0f / 128.0f) + EPS); const float* gk = F.in[I_KNG] + layer * 128 + ax * 64 + fo;
#pragma unroll
            for (int e = 0; e < 8; ++e) { x0[e] *= rstd * gk[e]; x1[e] *= rstd * gk[32 + e]; }
            if (lane < 16) {
            if (!lat) { float* o = F.out + O_GK + orow * 256 + kh * 128 + ax * 64 + fo; *(f32x4*)o = (f32x4){x0[0], x0[1], x0[2], x0[3]}; *(f32x4*)(o + 4) = (f32x4){x0[4], x0[5], x0[6], x0[7]};
                        *(f32x4*)(o + 32) = (f32x4){x1[0], x1[1], x1[2], x1[3]}; *(f32x4*)(o + 36) = (f32x4){x1[4], x1[5], x1[6], x1[7]}; }
            else {
#pragma unroll
                for (int e = 0; e < 8; ++e) { const float2 cs = tp[e]; const float a = x0[e], b = x1[e]; x0[e] = a * cs.x - b * cs.y; x1[e] = a * cs.y + b * cs.x; } }
            bf16* k = KG + kr * 256 + kh * 128 + ax * 64 + fo; *(u32x4*)k = pack8f(x0); *(u32x4*)(k + 32) = pack8f(x1); } }
          if (lane < 32) { *(u32x4*)(VG + kr * 256 + 8 * lane) = ldv;
            if (!lat) { float x[8]; unpack8(ldv, x); float* o = F.out + O_GV + orow * 256 + 8 * lane; *(f32x4*)o = (f32x4){x[0], x[1], x[2], x[3]}; *(f32x4*)(o + 4) = (f32x4){x[4], x[5], x[6], x[7]}; } }
        }
        { float x[8]; unpack8(ldqd, x); float ss = 0.f;
#pragma unroll
          for (int e = 0; e < 8; ++e) ss += x[e] * x[e];
          const float rstd = rsqrtf(wave_sum(ss) * (1.0f / 512.0f) + EPS); const float* g = F.in[I_MQNG] + layer * 512 + 8 * lane;
#pragma unroll
          for (int e = 0; e < 8; ++e) x[e] *= rstd * g[e];
          *(u32x4*)(AQ + (size_t)m * 512 + 8 * lane) = pack8f(x); }
        { float x[8]; float ss = 0.f; unpack8(ldck, x);
          if (lane < 32) {
#pragma unroll
            for (int e = 0; e < 8; ++e) ss += x[e] * x[e]; }
          ss = wave_sum(ss);
          if (lane < 32) { const float rstd = rsqrtf(ss * (1.0f / 256.0f) + EPS); const float* g = F.in[I_MKVNG] + layer * 256 + 8 * lane;
#pragma unroll
            for (int e = 0; e < 8; ++e) x[e] *= rstd * g[e];
            *(u32x4*)(ACKV + kr * 256 + 8 * lane) = pack8f(x);
            if (!lat) { float* o = F.out + O_CKV + orow * 256 + 8 * lane; *(f32x4*)o = (f32x4){x[0], x[1], x[2], x[3]}; *(f32x4*)(o + 4) = (f32x4){x[4], x[5], x[6], x[7]}; } }
          if (lane < 4) { float x0[8], x1[8]; unpack8(ldp0, x0); unpack8(ldp1, x1);
            if (!lat) { float* o = F.out + O_KPE + orow * 64 + axp * 32 + fop; *(f32x4*)o = (f32x4){x0[0], x0[1], x0[2], x0[3]}; *(f32x4*)(o + 4) = (f32x4){x0[4], x0[5], x0[6], x0[7]};
                        *(f32x4*)(o + 16) = (f32x4){x1[0], x1[1], x1[2], x1[3]}; *(f32x4*)(o + 20) = (f32x4){x1[4], x1[5], x1[6], x1[7]}; }
            else { const float2* tp = tC + (axp ? colpos : rowpos) * 16 + fop;
#pragma unroll
                for (int e = 0; e < 8; ++e) { const float2 cs = tp[e]; const float a = x0[e], b = x1[e]; x0[e] = a * cs.x - b * cs.y; x1[e] = a * cs.y + b * cs.x; } }
            const u32x4 w0 = pack8f(x0), w1 = pack8f(x1);
#pragma unroll
            for (int hh = 0; hh < 8; ++hh) { bf16* k = KM + kr * 1536 + hh * 192 + 128 + axp * 32 + fop; *(u32x4*)k = w0; *(u32x4*)(k + 16) = w1; } }
        }
        { const float* cw = F.in[I_CONVW] + (size_t)layer * 5 * 1536; const float* cb = F.in[I_CONVB] + layer * 1536;
#pragma unroll
          for (int i = 0; i < 3; ++i) { const int ch = 8 * lane + 512 * i; float acc[8];
            { const f32x4 b0 = *(const f32x4*)(cb + ch), b1 = *(const f32x4*)(cb + ch + 4); acc[0] = b0[0]; acc[1] = b0[1]; acc[2] = b0[2]; acc[3] = b0[3]; acc[4] = b1[0]; acc[5] = b1[1]; acc[6] = b1[2]; acc[7] = b1[3]; }
#pragma unroll
            for (int k = 0; k < 5; ++k) { float x[8]; unpack8(ldc[i][k], x);
                const f32x4 w0 = *(const f32x4*)(cw + k * 1536 + ch), w1 = *(const f32x4*)(cw + k * 1536 + ch + 4);
                acc[0] += w0[0] * x[0]; acc[1] += w0[1] * x[1]; acc[2] += w0[2] * x[2]; acc[3] += w0[3] * x[3]; acc[4] += w1[0] * x[4]; acc[5] += w1[1] * x[5]; acc[6] += w1[2] * x[6]; acc[7] += w1[3] * x[7]; }
#pragma unroll
            for (int e = 0; e < 8; ++e) acc[e] = acc[e] * sigm(acc[e]);
            *(u32x4*)(XBC + (size_t)m * 1536 + ch) = pack8f(acc); }
          if (lane < 32) { const float raw = __uint_as_float((unsigned)lddt << 16) + F.in[I_DTB][layer * 32 + lane]; const float ey = __expf(raw); DT[(size_t)m * 32 + lane] = raw > 20.f ? raw : (ey < 1e-3f ? ey * (1.0f - 0.5f * ey) : __logf(1.0f + ey)); }
        }
    }
    { LAS unsigned char* wl = F.lds + F.wave * s5::WAVE_LDS; float* S5E = (float*)(F.ws + WS_S5E);
      for (int e = F.gw; e < 4096; e += F.NGW) { const int b = e >> 10, seg = (e >> 7) & 7, g = (e >> 1) & 63, dir = e & 1;
        s5::Ctx c; s5::load_ctx(c, F.ws + WS_S5C + (size_t)((layer * 2 + dir) * 64 + g) * s5::CD_BYTES, nullptr, lane, false);
        float hr = 0.f, hi = 0.f;
        s5::s5_epass(c, wl, lane, dir, PROJ + (size_t)(MCTX + b * 2048 + seg * 256) * NIN + C_S5U + g * 16, NIN, hr, hi);
        float* eo = S5E + ((((size_t)b * 8 + seg) * 64 + g) * 2 + dir) * 128; eo[lane] = hr; eo[64 + lane] = hi; } }
}
__device__ __forceinline__ void phase_ssd_finish(Frame& F, int layer) {
    const bf16* PROJ = (const bf16*)(F.ws + WS_PROJ); const bf16* XBC = (const bf16*)(F.ws + WS_XBC); const bf16* YF = (const bf16*)(F.ws + WS_YF); const bf16* YB = (const bf16*)(F.ws + WS_YB);
    bf16* OB = (bf16*)(F.ws + WS_O) + (size_t)1 * MROWS * 1024; const int lane = F.lane;
    const float dh = F.in[I_SSDD][layer * 16 + (lane >> 2)]; const float* g = F.in[I_SSDNG] + layer * 1024 + 16 * lane;
    for (int m = F.gw; m < MROWS; m += F.NGW) {
        float x[16], z[16], y[16]; unpack8(*(const u32x4*)(XBC + (size_t)m * 1536 + 16 * lane), x); unpack8(*(const u32x4*)(XBC + (size_t)m * 1536 + 16 * lane + 8), x + 8);
        unpack8(*(const u32x4*)(PROJ + (size_t)m * NIN + C_SZ + 16 * lane), z); unpack8(*(const u32x4*)(PROJ + (size_t)m * NIN + C_SZ + 16 * lane + 8), z + 8);
        float ss = 0.f; float yf[16], yb[16];
        unpack8(*(const u32x4*)(YF + (size_t)m * 1024 + 16 * lane), yf); unpack8(*(const u32x4*)(YF + (size_t)m * 1024 + 16 * lane + 8), yf + 8);
        unpack8(*(const u32x4*)(YB + (size_t)m * 1024 + 16 * lane), yb); unpack8(*(const u32x4*)(YB + (size_t)m * 1024 + 16 * lane + 8), yb + 8);
#pragma unroll
        for (int i = 0; i < 16; ++i) { const float v = (yf[i] + yb[i] + dh * x[i]) * (z[i] * sigm(z[i])); y[i] = v; ss += v * v; }
        const float rstd = rsqrtf(wave_sum(ss) * (1.0f / 1024.0f) + EPS);
#pragma unroll
        for (int i = 0; i < 16; ++i) y[i] *= rstd * g[i];
        *(u32x4*)(OB + (size_t)m * 1024 + 16 * lane) = pack8f(y); *(u32x4*)(OB + (size_t)m * 1024 + 16 * lane + 8) = pack8f(y + 8);
    }
}
struct ConvItem { const float* src; bf16* dst; int K, N, mode, half, k0, n0; };
typedef float cvf4 __attribute__((ext_vector_type(4)));
__device__ __forceinline__ const float* conv_ptr(const ConvItem& c, int lane) { const int n4 = c.n0 + 4 * (lane & 15); return c.src + (size_t)(c.k0 + 8 * (lane >> 4)) * c.N + (n4 < c.N ? n4 : c.N - 4); }
__device__ __forceinline__ void conv_load1(const float* p, size_t N, int i, float (&w)[32]) { const cvf4 v = *(const cvf4*)(p + (size_t)i * N); w[4 * i] = v[0]; w[4 * i + 1] = v[1]; w[4 * i + 2] = v[2]; w[4 * i + 3] = v[3]; }
__device__ __forceinline__ void conv_load(const ConvItem& c, int lane, float (&w)[32]) {
    const float* p = conv_ptr(c, lane);
#pragma unroll
    for (int i = 0; i < 8; ++i) conv_load1(p, (size_t)c.N, i, w);
}
__device__ __forceinline__ void conv_store(const ConvItem& c, int lane, const float (&w)[32]) {
    const int n4 = c.n0 + 4 * (lane & 15);
    if (n4 < c.N) {
#pragma unroll
        for (int j = 0; j < 4; ++j) { const int n = n4 + j; const int row = c.mode == 0 ? n : (c.mode == 1 ? map_in(n) : map_pair(n, c.half)); bf16* d = c.dst + (size_t)row * c.K + c.k0 + 8 * (lane >> 4);
            u32x4 o; o.x = pk2(w[j], w[4 + j]); o.y = pk2(w[8 + j], w[12 + j]); o.z = pk2(w[16 + j], w[20 + j]); o.w = pk2(w[24 + j], w[28 + j]); *(u32x4*)d = o; } }
}
constexpr int CV_A0 = 64 * 176, CV_A1 = CV_A0 + 176 * 32, CV_A2 = CV_A1 + 64 * 32, CV_A3 = CV_A2 + 4 * 32 * 32, CV_A4 = CV_A3 + 32 * 32;
constexpr int CV_B0 = 64 * 222, CV_B1 = CV_B0 + 16 * 24, CV_B2 = CV_B1 + 8 * 32;
__device__ __forceinline__ ConvItem conv_decode(int set, int it, int layer, const float* const* in, unsigned char* ws) {
    ConvItem c; char* WB = (char*)(ws + WS_W);
    if (set == 0) {
        if (it < CV_A0) { c.src = in[I_WFI] + (size_t)layer * 2048 * 11264; c.dst = (bf16*)(WB + W_FI); c.K = 2048; c.N = 11264; c.mode = 2; c.half = 5632; c.k0 = 32 * (it / 176); c.n0 = 64 * (it % 176); }
        else if (it < CV_A1) { const int r = it - CV_A0; c.src = in[I_WFO] + (size_t)layer * 5632 * 2048; c.dst = (bf16*)(WB + W_FO); c.K = 5632; c.N = 2048; c.mode = 0; c.half = 0; c.k0 = 32 * (r / 32); c.n0 = 64 * (r % 32); }
        else if (it < CV_A2) { const int r = it - CV_A1; c.src = in[I_WOUT] + (size_t)layer * 2048 * 2048; c.dst = (bf16*)(WB + W_OUT); c.K = 2048; c.N = 2048; c.mode = 0; c.half = 0; c.k0 = 32 * (r / 32); c.n0 = 64 * (r % 32); }
        else if (it < CV_A3) { const int r = it - CV_A2, br = r >> 10, q = r & 1023; c.src = in[I_WBR] + ((size_t)layer * 4 + br) * 1024 * 2048; c.dst = (bf16*)(WB + W_BR) + (size_t)br * 2048 * 1024; c.K = 1024; c.N = 2048; c.mode = 0; c.half = 0; c.k0 = 32 * (q / 32); c.n0 = 64 * (q % 32); }
        else { const int r = it - CV_A3; c.src = in[I_WGLU] + (size_t)layer * 1024 * 2048; c.dst = (bf16*)(WB + W_GLU); c.K = 1024; c.N = 2048; c.mode = 2; c.half = 1024; c.k0 = 32 * (r / 32); c.n0 = 64 * (r % 32); }
    } else {
        if (it < CV_B0) { c.src = in[I_WIN] + (size_t)layer * 2048 * 14176; c.dst = (bf16*)(WB + W_IN); c.K = 2048; c.N = 14176; c.mode = 1; c.half = 0; c.k0 = 32 * (it / 222); c.n0 = 64 * (it % 222); }
        else if (it < CV_B1) { const int r = it - CV_B0; c.src = in[I_WUQ] + (size_t)layer * 512 * 1536; c.dst = (bf16*)(WB + W_UQ); c.K = 512; c.N = 1536; c.mode = 0; c.half = 0; c.k0 = 32 * (r / 24); c.n0 = 64 * (r % 24); }
        else { const int r = it - CV_B1; c.src = in[I_WUKV] + (size_t)layer * 256 * 2048; c.dst = (bf16*)(WB + W_UKV); c.K = 256; c.N = 2048; c.mode = 0; c.half = 0; c.k0 = 32 * (r / 32); c.n0 = 64 * (r % 32); }
    }
    return c;
}
__device__ __forceinline__ void conv_run(int set, int layer, int first, int stride, const float* const* in, unsigned char* ws, int lane) {
    const int total = set == 0 ? CV_A4 : CV_B2;
    for (int it = first; it < total; it += stride) { const ConvItem c = conv_decode(set, it, layer, in, ws); float w[32]; conv_load(c, lane, w); conv_store(c, lane, w); }
}
struct AttnConv {
    const float* const* in; unsigned char* ws; int layer, gw, NGW, total, cnt, lane;
    ConvItem c; bool on;
    __device__ __forceinline__ void begin(float (&w)[32]) {
        const int it = cnt * NGW + gw; on = it < total;
        if (on) { ++cnt; c = it < CV_A4 ? conv_decode(0, it, layer, in, ws) : conv_decode(1, it - CV_A4, layer + 1, in, ws); conv_load(c, lane, w); }
    }
    __device__ __forceinline__ void end(const float (&w)[32]) { if (on) { conv_store(c, lane, w); on = false; } }
    __device__ __forceinline__ bool pending() const { return on; }
    static constexpr bool RIDES = true;
    __device__ __forceinline__ void decode() { const int it = cnt * NGW + gw; on = it < total; const int ic = on ? it : total - 1; cnt += on ? 1 : 0; c = ic < CV_A4 ? conv_decode(0, ic, layer, in, ws) : conv_decode(1, ic - CV_A4, layer + 1, in, ws); }
    __device__ __forceinline__ void part(float (&w)[32], int i) { conv_load1(conv_ptr(c, lane), (size_t)c.N, i, w); }
    __device__ __forceinline__ void rest(float (&w)[32]) { const float* p = conv_ptr(c, lane);
#pragma unroll
        for (int i = 4; i < 8; ++i) conv_load1(p, (size_t)c.N, i, w); }
    __device__ __forceinline__ void finish() { for (int it = cnt * NGW + gw; it < total; it += NGW) { const ConvItem ci = it < CV_A4 ? conv_decode(0, it, layer, in, ws) : conv_decode(1, it - CV_A4, layer + 1, in, ws); float w[32]; conv_load(ci, lane, w); conv_store(ci, lane, w); } }
};
struct NoConv { static constexpr bool RIDES = false; __device__ __forceinline__ void begin(float (&)[32]) {} __device__ __forceinline__ void end(const float (&)[32]) {} __device__ __forceinline__ bool pending() const { return false; }
    __device__ __forceinline__ void decode() {} __device__ __forceinline__ void part(float (&)[32], int) {} __device__ __forceinline__ void rest(float (&)[32]) {} };
template <class Epi> struct EpiConv {
    static constexpr bool PERM = Epi::PERM, AFTER_DRAIN = false;
    Epi e; const float* const* in; unsigned char* ws; int layer, set, gw, NGW, total, first; mutable int cnt;
    __device__ __forceinline__ bool keep(const pg8::Unit& u) const { return e.keep(u); }
    template <class ACC> __device__ __forceinline__ void operator()(ACC& acc, const pg8::Unit& u, int wr, int wc, int fr, int fq) const {
        const int it = first + cnt * NGW + gw; ++cnt; const bool on = it < total; const int lane = threadIdx.x & 63;
        ConvItem c; float w[32];
        if (on) { c = conv_decode(set, it, layer, in, ws); conv_load(c, lane, w); }
        e(acc, u, wr, wc, fr, fq);
        if (on) conv_store(c, lane, w);
    }
};
#define XB_TMO      128
#define XB_XCNT(j)  (256  + 64 * (j))
#define XB_XSUB(j)  (1280 + 64 * (j))
#define XB_XGEN(j)  (2304 + 64 * (j))
#define XB_TOP      3328
#define XB_TOPGEN   3392
#define XCD_BAR_WORDS 3456
#define XB_SPIN_CAP (1u << 18)

__device__ __forceinline__ unsigned xb_ld(unsigned* p)              { return __hip_atomic_load(p, __ATOMIC_RELAXED, __HIP_MEMORY_SCOPE_AGENT); }
__device__ __forceinline__ unsigned xb_add(unsigned* p, unsigned v) { return __hip_atomic_fetch_add(p, v, __ATOMIC_RELAXED, __HIP_MEMORY_SCOPE_AGENT); }
__device__ __forceinline__ unsigned xb_xcc_id() { return (unsigned)__builtin_amdgcn_s_getreg((3 << 11) | 20) & 0xFu; }
#define XB_SPIN(cond, bar) do { unsigned _sp = 0; while (cond) { __builtin_amdgcn_s_sleep(1); \
    if ((++_sp & 255u) == 0u) { if (xb_ld(&(bar)[XB_TMO])) break; if (_sp > XB_SPIN_CAP) { atomicAdd(&(bar)[XB_TMO], 1u); break; } } } } while (0)

struct XcdBarrier {
    unsigned* bar; unsigned x;
    volatile LAS unsigned* st;
};

__device__ __forceinline__ XcdBarrier xcd_barrier_post(unsigned* bar, volatile LAS unsigned* st) {
    XcdBarrier b; b.bar = bar; b.x = xb_xcc_id(); b.st = st;
    if (threadIdx.x == 0) (void)xb_add(&bar[XB_XCNT(b.x)], 1u);
    return b;
}
__device__ __forceinline__ void xcd_barrier_complete(unsigned* bar, unsigned x, unsigned& nloc, unsigned& nx) {
    const unsigned G = gridDim.x * gridDim.y * gridDim.z;
    unsigned sum, cnt, mine, sp = 0u;
    for (;;) {
        sum = 0u; cnt = 0u; mine = 0u;
#pragma unroll
        for (unsigned j = 0; j < 16; ++j) { const unsigned c = xb_ld(&bar[XB_XCNT(j)]); sum += c; cnt += (c > 0u) ? 1u : 0u; mine = (j == x) ? c : mine; }
        if (sum == G) break;
        __builtin_amdgcn_s_sleep(1);
        if ((++sp & 255u) == 0u) { if (xb_ld(&bar[XB_TMO])) break; if (sp > XB_SPIN_CAP) { atomicAdd(&bar[XB_TMO], 1u); break; } }
    }
    nloc = mine > 0u ? mine : 1u; nx = cnt > 0u ? cnt : 1u;
}

__device__ __forceinline__ void xcd_barrier(const XcdBarrier& b) {
    asm volatile("s_waitcnt vmcnt(0)" ::: "memory");
    __syncthreads();
    if (threadIdx.x == 0) {
        unsigned* bar = b.bar;
        __builtin_amdgcn_s_waitcnt(0);
        unsigned nloc = b.st[0], nx = b.st[1];
        if (nloc == 0u) { xcd_barrier_complete(bar, b.x, nloc, nx); b.st[0] = nloc; b.st[1] = nx; }
        const unsigned old = xb_add(&bar[XB_XSUB(b.x)], 1u);
        const unsigned gen = old / nloc;
        if (old + 1u == (gen + 1u) * nloc) {
            __builtin_amdgcn_fence(__ATOMIC_RELEASE, "agent");
            asm volatile("s_waitcnt vmcnt(0)" ::: "memory");
            const unsigned og = xb_add(&bar[XB_TOP], 1u);
            const unsigned tg = og / nx;
            if (og + 1u == (tg + 1u) * nx) xb_add(&bar[XB_TOPGEN], 1u);
            else XB_SPIN(xb_ld(&bar[XB_TOPGEN]) == tg, bar);
            __builtin_amdgcn_fence(__ATOMIC_ACQUIRE, "agent");
            xb_add(&bar[XB_XGEN(b.x)], 1u);
            asm volatile("s_waitcnt vmcnt(0)" ::: "memory");
        } else {
            XB_SPIN(xb_ld(&bar[XB_XGEN(b.x)]) == gen, bar);
            __builtin_amdgcn_fence(__ATOMIC_ACQUIRE, "agent");
            asm volatile("s_waitcnt vmcnt(0)" ::: "memory");
        }
    }
    __syncthreads();
}
#ifndef MLA_SDEPTH
#define MLA_SDEPTH 1
#endif
constexpr int NPHASE = 42;
#ifndef MK_N_LAUNCHES
#define MK_N_LAUNCHES 1
#endif
__device__ __forceinline__ void run_attn_gqa(Frame& F, int layer) {
    AttnConv cv; cv.in = F.in; cv.ws = F.ws; cv.layer = layer; cv.gw = F.gw; cv.NGW = F.NGW; cv.total = CV_A4 + (layer + 1 < NLAYER ? CV_B0 : 0); cv.cnt = 0; cv.lane = F.lane; cv.on = false;
    const bf16* Q = (const bf16*)(F.ws + WS_Q); const bf16* KG = (const bf16*)(F.ws + WS_KG); const bf16* VG = (const bf16*)(F.ws + WS_VG); bf16* OA = (bf16*)(F.ws + WS_O);
    for (int u = F.bid; u < 512; u += F.G) {
        size_t qrow, krow; int hq, seq;
        if (u < 256) { const int b = u >> 6, qb = u & 7; hq = (u >> 3) & 7; qrow = MCTX + (size_t)b * 2048 + qb * 256; krow = MCTX + (size_t)b * 2560; seq = 2560; }
        else { const int v = u - 256, b = v >> 3; hq = v & 7; qrow = (size_t)b * 256; krow = qrow; seq = 256; }
        att::attn_body_simple<128, 1024, 256, 256, 1024>(Q + qrow * 1024 + hq * 128, KG + krow * 256 + (hq >> 2) * 128, VG + krow * 256 + (hq >> 2) * 128, OA + qrow * 1024 + hq * 128, seq, (char*)F.lds, cv);
    }
    cv.finish();
}
__device__ __forceinline__ void run_attn_mla(Frame& F) {
    const bf16* QM = (const bf16*)(F.ws + WS_QM); const bf16* KM = (const bf16*)(F.ws + WS_KM); const bf16* VM = (const bf16*)(F.ws + WS_VM); bf16* OC = (bf16*)(F.ws + WS_O) + (size_t)2 * MROWS * 1024;
    for (int u = F.bid; u < 512; u += F.G) {
        size_t qrow, krow; int hq, seq;
        if (u < 256) { const int b = u >> 6, qb = u & 7; hq = (u >> 3) & 7; qrow = MCTX + (size_t)b * 2048 + qb * 256; krow = MCTX + (size_t)b * 2560; seq = 2560; }
        else { const int v = u - 256, b = v >> 3; hq = v & 7; qrow = (size_t)b * 256; krow = qrow; seq = 256; }
        NoConv nc; att::attn_body_simple<192, 1536, 1536, 1024, 1024>(QM + qrow * 1536 + hq * 192, KM + krow * 1536 + hq * 192, VM + krow * 1024 + hq * 128, OC + qrow * 1024 + hq * 128, seq, (char*)F.lds, nc);
    }
}
__device__ __forceinline__ void run_ssd(Frame& F, int layer) {
    const bf16* XBC = (const bf16*)(F.ws + WS_XBC); const float* DT = (const float*)(F.ws + WS_DT); bf16* YF = (bf16*)(F.ws + WS_YF); bf16* YB = (bf16*)(F.ws + WS_YB);
    for (int u = F.bid; u < 128; u += F.G) { const int b = u >> 5, h = (u >> 1) & 15, dir = u & 1;
        const float a_h = -expf(F.in[I_ALOG][(layer * 2 + dir) * 16 + h]);
        ssd::ssd_unit(F.lds, XBC, DT, dir ? YB : YF, MCTX + b * 2048, 16, h, dir, a_h, F.in[I_SSSD] + ((((size_t)b * 4 + layer) * 2 + dir) * 16 + h) * 8192, nullptr); }
    const int c0 = F.G > 128 ? F.bid - 128 : F.bid, cs = F.G > 128 ? F.G - 128 : F.G;
    if (c0 >= 0) for (int v = c0; v < 1024; v += cs) { const int b = v >> 5, h = (v >> 1) & 15, dir = v & 1;
        const float a_h = -expf(F.in[I_ALOG][(layer * 2 + dir) * 16 + h]);
        ssd::ssd_unit(F.lds, XBC, DT, dir ? YB : YF, b * 256, 2, h, dir, a_h, nullptr, F.out + O_SSD + ((((size_t)b * 4 + layer) * 2 + dir) * 16 + h) * 8192); }
}
__device__ __forceinline__ void s5_entry_state(Frame& F, const unsigned char* cd, const float* S5E, int b, int seg, int g, int layer, int dir, int lane, float& hr, float& hi) {
    const float* h0 = F.in[I_SS5] + ((((size_t)b * 4 + layer) * 2 + dir) * 2) * 4096 + g * 64; hr = h0[lane]; hi = h0[4096 + lane];
    const float zr = ((const float*)cd)[128 + lane], zi = ((const float*)cd)[192 + lane];
    const int n = dir ? 7 - seg : seg;
    float er[7], ei[7];
#pragma unroll
    for (int q = 0; q < 7; ++q) { const int qq = q < n ? q : 0; const int sp = dir ? 7 - qq : qq; const float* e = S5E + ((((size_t)b * 8 + sp) * 64 + g) * 2 + dir) * 128; er[q] = e[lane]; ei[q] = e[64 + lane]; }
#pragma unroll
    for (int q = 0; q < 7; ++q) { const float nr = zr * hr - zi * hi + er[q], ni = zr * hi + zi * hr + ei[q]; if (q < n) { hr = nr; hi = ni; } }
}
__device__ __forceinline__ void run_s5(Frame& F, int layer) {
    const bf16* PROJ = (const bf16*)(F.ws + WS_PROJ); bf16* S5PRE = (bf16*)(F.ws + WS_S5PRE); const float* S5E = (const float*)(F.ws + WS_S5E);
    LAS unsigned char* wl = F.lds + F.wave * s5::WAVE_LDS;
    for (int u = F.gw; u < 4096; u += F.NGW) {
        int lane_ = F.lane; asm volatile("" : "+v"(lane_)); const int lane = lane_;
        const int s = u >> 6, g = u & 63; const bool lat = s >= 32; const int b = lat ? (s - 32) >> 3 : s, seg = lat ? (s - 32) & 7 : 0;
        const size_t row0 = lat ? MCTX + (size_t)b * 2048 + seg * 256 : (size_t)b * 256;
        const unsigned char* cd0 = F.ws + WS_S5C + (size_t)((layer * 2 + 0) * 64 + g) * s5::CD_BYTES; const unsigned char* cd1 = cd0 + 64 * s5::CD_BYTES; const unsigned char* cg = F.ws + WS_S5G + ((size_t)layer * 64 + g) * s5::CG_BYTES;
        const bf16* U = PROJ + row0 * NIN + C_S5U + g * 16; bf16* outp = S5PRE + row0 * 1024 + g * 16;
        const float dch = F.in[I_S5D][layer * 1024 + g * 16 + (lane & 15)];
        s5::Ctx c;
        float hfr = 0.f, hfi = 0.f, hbr = 0.f, hbi = 0.f;
        if (lat) { s5_entry_state(F, cd0, S5E, b, seg, g, layer, 0, lane, hfr, hfi); s5_entry_state(F, cd1, S5E, b, seg, g, layer, 1, lane, hbr, hbi); }
        { s5::load_ctx(c, cd0, cg, lane, true);
          s5::s5_pass<false>(c, wl, lane, 0, U, NIN, outp, dch, hfr, hfi);
          if (!lat) { float* ho = F.out + O_S5 + ((((size_t)b * 4 + layer) * 2 + 0) * 2) * 4096 + g * 64; ho[lane] = hfr; ho[4096 + lane] = hfi; } }
        { s5::load_ctx(c, cd1, cg, lane, false);
          s5::s5_pass<true>(c, wl, lane, 1, U, NIN, outp, dch, hbr, hbi);
          if (!lat) { float* ho = F.out + O_S5 + ((((size_t)b * 4 + layer) * 2 + 1) * 2) * 4096 + g * 64; ho[lane] = hbr; ho[4096 + lane] = hbi; } }
    }
}
__device__ __forceinline__ bool launder(Frame& F) {
    asm volatile("" : "+v"(F.tid), "+v"(F.lane)); return true; }
__global__ void __launch_bounds__(NTHREADS, 2) skel_fwd(Args args) {
    extern __shared__ __attribute__((aligned(16))) unsigned char lds_raw[];
    Frame F;
    F.lds = (LAS unsigned char*)lds_raw;
    F.tid = threadIdx.x; F.lane = F.tid & 63; F.wave = __builtin_amdgcn_readfirstlane(F.tid >> 6);
    F.G = gridDim.x; F.bid = blockIdx.x; F.gw = F.bid * NWAVES + F.wave; F.NGW = F.G * NWAVES;
    F.in0 = args.in; F.out0 = args.out; F.ws0 = args.ws; F.in = F.in0; F.out = F.out0; F.ws = F.ws0;
    for (int u = F.tid; u < (LDS_BYTES - LDSCTL_OFF) / 4; u += NTHREADS) ((LAS unsigned*)(F.lds + LDSCTL_OFF))[u] = 0u;
    __syncthreads();
    const int lo = args.ph_lo, hi = args.ph_hi;
    unsigned* barw = (unsigned*)(F.ws + WS_CTL) + CW_BAR + args.li * XCD_BAR_WORDS;
    XcdBarrier bar; bar.bar = barw; bar.x = 0; bar.st = nullptr;
    if (hi - lo > 1) bar = xcd_barrier_post(barw, (volatile LAS unsigned*)(F.lds + MISC_OFF) + 8);
#ifndef SUB_MASK
#define SUB_MASK 0xffu
#endif
#define SUBON(b) (((SUB_MASK) >> (b)) & 1u)
#ifndef REP_MASK
#define REP_MASK 0u
#endif
#define REP(b) for (int rep_ = 0; rep_ < 1 + (int)(((REP_MASK) >> (b)) & 1u); ++rep_)
#ifndef PH_MASK
#define PH_MASK 0xffffffffu
#endif
#define IN(k) (lo <= (k) && (k) < hi)
#define INJ(j) ((((PH_MASK) >> (j)) & 1u) && IN(pb + (j)) && launder(F))
#define SEAM(k) do { if (IN(k) && IN((k) + 1)) xcd_barrier(bar); } while (0)
    bf16* WB = (bf16*)(F.ws + WS_W);
    bf16* const Win = (bf16*)((char*)WB + W_IN); bf16* const Wuq = (bf16*)((char*)WB + W_UQ); bf16* const Wukv = (bf16*)((char*)WB + W_UKV); bf16* const Wglu = (bf16*)((char*)WB + W_GLU);
    bf16* const Wbr = (bf16*)((char*)WB + W_BR); bf16* const Wout = (bf16*)((char*)WB + W_OUT); bf16* const Wfi = (bf16*)((char*)WB + W_FI); bf16* const Wfo = (bf16*)((char*)WB + W_FO);
    bf16* const H = (bf16*)(F.ws + WS_H); bf16* const PROJ = (bf16*)(F.ws + WS_PROJ); float* const X = (float*)(F.ws + WS_X);

    if (((PH_MASK >> 11) & 1u) && IN(0)) { phase_prologue(F); conv_run(1, 0, F.gw, F.NGW, F.in, F.ws, F.lane); phase_zero_pad(F); } SEAM(0);
    for (int layer = 0; layer < NLAYER; ++layer) {
        const int pb = 1 + 10 * layer; const float* MODL = (const float*)(F.ws + WS_MOD) + (size_t)layer * 5 * 12288;
        if (INJ(0)) { REP(9) phase_norm(F, layer, 0, layer == 0); } SEAM(pb + 0);
        if (INJ(1)) { pg8::Gemm g{H, Win, MROWS, NIN, 2048}; pg8::StaticOrder S; S.init(MROWS, NIN, F.G, F.bid);
            pg8::EpiInProj E{PROJ, NIN, 32};
            pg8::gemm_phase<pg8::EpiInProj, pg8::StaticOrder, true, true>(F.lds, g, S, E); } SEAM(pb + 1);
        if (INJ(2)) { REP(10) phase_prep(F, layer); } SEAM(pb + 2);
        if (INJ(3)) {
            if (SUBON(0)) { pg8::Gemm g{(bf16*)(F.ws + WS_AQ), Wuq, MROWS, 1536, 512}; pg8::StaticOrder S; S.init(MROWS, 1536, F.G, F.bid); pg8::EpiMlaQ E{(bf16*)(F.ws + WS_QM), (const float2*)(F.ws + WS_TAB) + 64 * 32};
              REP(15) pg8::gemm_phase<pg8::EpiMlaQ, pg8::StaticOrder, true, true>(F.lds, g, S, E); }
            if (SUBON(1)) { pg8::Gemm g{(bf16*)(F.ws + WS_ACKV), Wukv, KROWS, 2048, 256}; pg8::StaticOrder S; S.init(KROWS, 2048, F.G, (F.bid + (F.G >> 2)) % F.G  ); pg8::EpiMlaKV E{(bf16*)(F.ws + WS_KM), (bf16*)(F.ws + WS_VM)};
              REP(15) pg8::gemm_phase<pg8::EpiMlaKV, pg8::StaticOrder, true, true>(F.lds, g, S, E); }
            if (SUBON(2)) run_attn_gqa(F, layer);
            if (SUBON(3)) REP(3) run_ssd(F, layer);
            if (SUBON(4)) REP(4) run_s5(F, layer);
        } SEAM(pb + 3);
        if (INJ(4)) { if (SUBON(5)) REP(5) run_attn_mla(F); if (SUBON(6)) REP(6) phase_ssd_finish(F, layer);
            { pg8::Gemm g{(bf16*)(F.ws + WS_S5PRE), Wglu, MROWS, 2048, 1024}; pg8::StaticOrder S; S.init(MROWS, 2048, F.G, F.bid); pg8::EpiGated<0> E{(bf16*)(F.ws + WS_O) + (size_t)3 * MROWS * 1024, 1024};
              REP(15) pg8::gemm_phase<pg8::EpiGated<0>, pg8::StaticOrder, true, true>(F.lds, g, S, E); } } SEAM(pb + 4);
        if (INJ(5)) { pg8::Gemm g{(bf16*)(F.ws + WS_O), Wbr, 4 * MROWS, 4 * 2048, 1024}; pg8::BranchOrder S; S.so.init(MROWS, 2048, F.G, F.bid); pg8::EpiBranch E{PROJ, NIN, (bf16*)(F.ws + WS_GS)};
            REP(13) pg8::gemm_phase<pg8::EpiBranch, pg8::BranchOrder, true, true>(F.lds, g, S, E); } SEAM(pb + 5);
        if (INJ(6)) { pg8::Gemm g{(bf16*)(F.ws + WS_GS), Wout, MROWS, 2048, 2048}; pg8::StaticOrder S; S.init(MROWS, 2048, F.G, F.bid); pg8::EpiResid E{X, MODL, 4096, 1.0f};
            if ((REP_MASK >> 14) & 1u) { pg8::EpiResid E0{X, MODL, 4096, 0.0f}; pg8::gemm_phase<pg8::EpiResid, pg8::StaticOrder, true, true>(F.lds, g, S, E0); }
            pg8::gemm_phase<pg8::EpiResid, pg8::StaticOrder, true, true>(F.lds, g, S, E); } SEAM(pb + 6);
        if (INJ(7)) { REP(9) phase_norm(F, layer, 1, false); } SEAM(pb + 7);
        if (INJ(8)) { pg8::Gemm g{H, Wfi, MROWS, 11264, 2048}; pg8::StaticOrder S; S.init(MROWS, 11264, F.G, F.bid);
            EpiConv<pg8::EpiGated<1>> E{pg8::EpiGated<1>{PROJ  , FFN}, F.in, F.ws, layer + 1, 1, F.gw, F.NGW, layer + 1 < NLAYER ? CV_B2 : 0, CV_B0, 0};
            pg8::gemm_phase<EpiConv<pg8::EpiGated<1>>, pg8::StaticOrder, true, true>(F.lds, g, S, E);
            if (layer + 1 < NLAYER) conv_run(1, layer + 1, CV_B0 + E.cnt * F.NGW + F.gw, F.NGW, F.in, F.ws, F.lane); } SEAM(pb + 8);
        if (INJ(9)) { pg8::Gemm g{PROJ, Wfo, MROWS, 2048, FFN}; pg8::StaticOrder S; S.init(MROWS, 2048, F.G, F.bid); pg8::EpiResid E{X, MODL, 10240, 1.0f};
            if ((REP_MASK >> 14) & 1u) { pg8::EpiResid E0{X, MODL, 10240, 0.0f}; pg8::gemm_phase<pg8::EpiResid, pg8::StaticOrder, true, true>(F.lds, g, S, E0); }
            pg8::gemm_phase<pg8::EpiResid, pg8::StaticOrder, true, true>(F.lds, g, S, E); } SEAM(pb + 9);
    }
    if (((PH_MASK >> 12) & 1u) && IN(41)) phase_final_norm(F);
#undef IN
#undef INJ
#undef SEAM
}

extern "C" void kernel_launch(void* const* d_in, const int* in_sizes, int n_in, void* d_out, int out_size, void* d_ws, size_t ws_size, hipStream_t stream) {
    static int grid = 0;
    if (grid == 0) {
        if (n_in != 41 || out_size != (int)O_TOTAL || ws_size < WS_END) { fprintf(stderr, "kernel_launch: expected 41 inputs, %zu outputs, >= %zu bytes of workspace; got n_in %d out %d ws %zu\n", (size_t)O_TOTAL, (size_t)WS_END, n_in, out_size, ws_size); grid = -1; return; }
        int dev = 0, cus = 0, per_cu = 0;
        if (hipGetDevice(&dev) != hipSuccess || hipDeviceGetAttribute(&cus, hipDeviceAttributeMultiprocessorCount, dev) != hipSuccess) { grid = -1; return; }
        if (hipFuncSetAttribute((const void*)skel_fwd, hipFuncAttributeMaxDynamicSharedMemorySize, LDS_BYTES) != hipSuccess) { fprintf(stderr, "kernel_launch: hipFuncSetAttribute failed\n"); grid = -1; return; }
        if (hipOccupancyMaxActiveBlocksPerMultiprocessor(&per_cu, (const void*)skel_fwd, NTHREADS, LDS_BYTES) != hipSuccess || per_cu < 1) fprintf(stderr, "kernel_launch: occupancy query reports %d\n", per_cu);
        (void)hipGetLastError();
        grid = cus;
    }
    if (grid < 0) return;
    if (hipMemsetAsync((char*)d_ws + WS_CTL, 0, CTL_ZERO_BYTES, stream) != hipSuccess) return;
    Args a{};
    for (int i = 0; i < 41; ++i) a.in[i] = (const float*)d_in[i];
    a.out = (float*)d_out; a.ws = (unsigned char*)d_ws;
    constexpr int NL = MK_N_LAUNCHES;
    for (int li = 0; li < NL; ++li) {
        a.li = li; a.ph_lo = (int)((long)NPHASE * li / NL); a.ph_hi = (int)((long)NPHASE * (li + 1) / NL);
        hipLaunchKernelGGL(skel_fwd, dim3(grid), dim3(NTHREADS), LDS_BYTES, stream, a);
        const hipError_t le = hipPeekAtLastError();
        if (le != hipSuccess) { fprintf(stderr, "kernel_launch: launch %d failed: %s\n", li, hipGetErrorName(le)); break; }
    }
}
```
